# Optimizing an MI355X kernel written in HIP

```python
import math
import jax, jax.numpy as jnp
from jax import lax
import numpy as np

D_MODEL = 1024
BATCH = 8
SEQ = 4096
DEPTH = 4

N_MIXERS = 4
HEAD_DIM = 64
Q_BLOCK = 128
ROPE_THETA = 500000.0
ROT_DIM = HEAD_DIM // 4
NORM_EPS = 1e-6
D_FF = 128 * ((8 * D_MODEL // 3 + 127) // 128)
PLE_DIM = 256
FOX_HEADS = D_MODEL // HEAD_DIM
DIL_HEADS = D_MODEL // HEAD_DIM
DIL_CONFIGS = ((128, 1), (512, 4), (2048, 16))
DIL_GROUPS = len(DIL_CONFIGS)
DIL_BAND = 128
DIFF_HEADS = D_MODEL // (2 * HEAD_DIM)
DIFF_SUBLN_EPS = 1e-5
SGU_HALF = 2 * D_MODEL
SGU_GROUPS = 8
SGU_GROUP_DIM = SGU_HALF // SGU_GROUPS
SGU_CHUNK = 128
N_FOX = (DEPTH + 3) // 4
N_DIL = (DEPTH + 2) // 4
N_DIFF = (DEPTH + 1) // 4
N_SGU = DEPTH // 4

kernel_name = "hybrid_interleaved_fox_dilated_diff_sgu"


def rms_norm(x, g, eps=NORM_EPS):
    xf = x.astype(jnp.float32)
    y = xf * lax.rsqrt(jnp.mean(xf * xf, axis=-1, keepdims=True) + eps)
    return (y * g.astype(jnp.float32)).astype(x.dtype)


def swiglu(h, w_in, w_out):
    gate, up = jnp.split(h @ w_in, 2, axis=-1)
    return (jax.nn.silu(gate) * up) @ w_out


def partial_rope(t, pos):
    half = ROT_DIM // 2
    inv_freq = ROPE_THETA ** (-jnp.arange(0, ROT_DIM, 2, dtype=jnp.float32) / ROT_DIM)
    ang = pos.astype(jnp.float32)[:, None] * inv_freq[None, :]
    bshape = (pos.shape[0],) + (1,) * (t.ndim - 3) + (half,)
    cos = jnp.cos(ang).reshape(bshape)
    sin = jnp.sin(ang).reshape(bshape)
    tf = t[..., :ROT_DIM].astype(jnp.float32)
    x1, x2 = tf[..., :half], tf[..., half:]
    rot = jnp.concatenate([x1 * cos - x2 * sin, x2 * cos + x1 * sin], axis=-1)
    return jnp.concatenate([rot.astype(t.dtype), t[..., ROT_DIM:]], axis=-1)


def to_blocks(t):
    b, s = t.shape[:2]
    return jnp.swapaxes(t.reshape((b, s // Q_BLOCK, Q_BLOCK) + t.shape[2:]), 0, 1)


def from_blocks(t):
    nb, b = t.shape[:2]
    return jnp.swapaxes(t, 0, 1).reshape((b, nb * Q_BLOCK) + t.shape[3:])


def causal_probs(q_blk, k, start, bias=None):
    s = jnp.einsum('bqhd,bkhd->bhqk', q_blk, k, preferred_element_type=jnp.float32)
    s = s * (q_blk.shape[-1] ** -0.5)
    if bias is not None:
        s = s + bias
    qpos = start + jnp.arange(q_blk.shape[1])
    kpos = jnp.arange(k.shape[1])
    s = jnp.where(kpos[None, :] <= qpos[:, None], s, -jnp.inf)
    return jax.nn.softmax(s, axis=-1)


def fox_attention(h, w_in, b_f, w_out):
    b, s, _ = h.shape
    proj = h @ w_in
    q = proj[..., :D_MODEL].reshape(b, s, FOX_HEADS, HEAD_DIM)
    k = proj[..., D_MODEL:2 * D_MODEL].reshape(b, s, FOX_HEADS, HEAD_DIM)
    v = proj[..., 2 * D_MODEL:3 * D_MODEL].reshape(b, s, FOX_HEADS, HEAD_DIM)
    log_f = jax.nn.log_sigmoid((proj[..., 3 * D_MODEL:] + b_f).astype(jnp.float32))
    c = jnp.cumsum(log_f, axis=1)
    c_k = jnp.transpose(c, (0, 2, 1))

    def block(args):
        q_blk, c_blk, start = args
        bias = jnp.transpose(c_blk, (0, 2, 1))[..., None] - c_k[:, :, None, :]
        probs = causal_probs(q_blk, k, start, bias)
        return jnp.einsum('bhqk,bkhd->bqhd', probs.astype(v.dtype), v)

    starts = jnp.arange(s // Q_BLOCK, dtype=jnp.int32) * Q_BLOCK
    o = from_blocks(lax.map(block, (to_blocks(q), to_blocks(c), starts)))
    return o.reshape(b, s, D_MODEL) @ w_out


def dilated_group(q, k, v, dilation, n_steps):
    b, s, nh, dh = q.shape
    span = dilation * DIL_BAND
    s_pad = -(-s // span) * span
    n_sub = s_pad // dilation
    nb = n_sub // DIL_BAND

    def to_res(t):
        t = jnp.pad(t, ((0, 0), (0, s_pad - s), (0, 0), (0, 0)))
        t = jnp.transpose(t.reshape(b, n_sub, dilation, nh, dh), (0, 2, 1, 3, 4))
        return t.reshape(b * dilation, nb, DIL_BAND, nh, dh)

    def with_prev(t):
        prev = jnp.pad(t, ((0, 0), (1, 0), (0, 0), (0, 0), (0, 0)))[:, :-1]
        return jnp.concatenate([prev, t], axis=2)

    qr = to_res(q)
    kk = with_prev(to_res(k))
    vv = with_prev(to_res(v))
    sc = jnp.einsum('xnqhd,xnkhd->xnhqk', qr, kk, preferred_element_type=jnp.float32) * (dh ** -0.5)
    q_idx = jnp.arange(DIL_BAND)
    k_idx = jnp.arange(2 * DIL_BAND) - DIL_BAND
    steps = q_idx[:, None] - k_idx[None, :]
    in_band = (steps >= 0) & (steps <= n_steps)
    has_prev = (jnp.arange(nb) > 0)[:, None, None] | (k_idx >= 0)[None, None, :]
    mask = in_band[None] & has_prev
    sc = jnp.where(mask[None, :, None], sc, -jnp.inf)
    lse = jax.nn.logsumexp(sc, axis=-1)
    probs = jnp.exp(sc - lse[..., None])
    o = jnp.einsum('xnhqk,xnkhd->xnqhd', probs.astype(v.dtype), vv)
    o = jnp.transpose(o.reshape(b, dilation, n_sub, nh, dh), (0, 2, 1, 3, 4)).reshape(b, s_pad, nh, dh)[:, :s]
    lse = jnp.transpose(lse, (0, 1, 3, 2)).reshape(b, dilation, n_sub, nh)
    lse = jnp.transpose(lse, (0, 2, 1, 3)).reshape(b, s_pad, nh)[:, :s]
    return o, lse


def dilated_attention(h, w_in, w_out, pos):
    b, s, _ = h.shape
    proj = (h @ w_in).reshape(b, s, DIL_GROUPS + 2, DIL_HEADS, HEAD_DIM)
    q = partial_rope(proj[:, :, :DIL_GROUPS], pos)
    k = partial_rope(proj[:, :, DIL_GROUPS], pos)
    v = proj[:, :, DIL_GROUPS + 1]
    outs, lses = [], []
    for g, (window, dilation) in enumerate(DIL_CONFIGS):
        o_g, l_g = dilated_group(q[:, :, g], k, v, dilation, window // dilation)
        outs.append(o_g)
        lses.append(l_g)
    w = jax.nn.softmax(jnp.stack(lses), axis=0)
    o = jnp.einsum('gbsh,gbshd->bshd', w.astype(v.dtype), jnp.stack(outs))
    return o.reshape(b, s, D_MODEL) @ w_out


def diff_attention(h, w_in, lam_params, subln_g, w_out, pos, layer_idx):
    b, s, _ = h.shape
    proj = h @ w_in
    q = partial_rope(proj[..., :D_MODEL].reshape(b, s, DIFF_HEADS, 2, HEAD_DIM), pos)
    k = partial_rope(proj[..., D_MODEL:2 * D_MODEL].reshape(b, s, DIFF_HEADS, 2, HEAD_DIM), pos)
    v = proj[..., 2 * D_MODEL:].reshape(b, s, DIFF_HEADS, 2 * HEAD_DIM)
    lam_init = 0.8 - 0.6 * math.exp(-0.3 * layer_idx)
    lp = lam_params.astype(jnp.float32)
    lam = jnp.exp(jnp.sum(lp[0] * lp[1])) - jnp.exp(jnp.sum(lp[2] * lp[3])) + lam_init
    k1, k2 = k[:, :, :, 0], k[:, :, :, 1]

    def block(args):
        q_blk, start = args
        p1 = causal_probs(q_blk[:, :, :, 0], k1, start)
        p2 = causal_probs(q_blk[:, :, :, 1], k2, start)
        return jnp.einsum('bhqk,bkhd->bqhd', (p1 - lam * p2).astype(v.dtype), v)

    starts = jnp.arange(s // Q_BLOCK, dtype=jnp.int32) * Q_BLOCK
    o = from_blocks(lax.map(block, (to_blocks(q), starts)))
    o = rms_norm(o, subln_g, DIFF_SUBLN_EPS) * (1.0 - lam_init)
    return o.reshape(b, s, D_MODEL) @ w_out


def chunked_sgu(h, w_in, norm_v, w_s, b_s, w_out):
    b, s, _ = h.shape
    u, v = jnp.split(jax.nn.gelu(h @ w_in, approximate=False), 2, axis=-1)
    v = rms_norm(v, norm_v).reshape(b, s // SGU_CHUNK, SGU_CHUNK, SGU_GROUPS, SGU_GROUP_DIM)
    causal = jnp.tril(jnp.ones((SGU_CHUNK, SGU_CHUNK), dtype=bool))
    w = jnp.where(causal[None], w_s, 0)
    mixed = jnp.einsum('gts,bnsgc->bntgc', w.astype(v.dtype), v) + jnp.transpose(b_s)[None, None, :, :, None]
    return (u * mixed.reshape(b, s, SGU_HALF)) @ w_out


def setup_inputs(seed: int = 0) -> dict:
    key = jax.random.key(seed)
    ks = iter(jax.random.split(key, 40))
    D = D_MODEL

    def nrm(shape, scale):
        return scale * jax.random.normal(next(ks), shape, jnp.float32)

    def gain(shape):
        return 1.0 + nrm(shape, 0.05)

    return {
        "x": nrm((BATCH, SEQ, D), 1.0),
        "p": nrm((DEPTH, BATCH, SEQ, PLE_DIM), 1.0),
        "norm_ffn1": gain((DEPTH, D)),
        "w_ffn1_in": nrm((DEPTH, D, 2 * D_FF), D ** -0.5),
        "w_ffn1_out": nrm((DEPTH, D_FF, D), D_FF ** -0.5),
        "norm_mix": gain((DEPTH, D)),
        "norm_ffn2": gain((DEPTH, D)),
        "w_ffn2_in": nrm((DEPTH, D, 2 * D_FF), D ** -0.5),
        "w_ffn2_out": nrm((DEPTH, D_FF, D), D_FF ** -0.5),
        "norm_ple": gain((DEPTH, D)),
        "w_ple_gate": nrm((DEPTH, D, D), D ** -0.5),
        "b_ple_gate": nrm((DEPTH, D), 0.02),
        "w_ple_proj": nrm((DEPTH, PLE_DIM, D), PLE_DIM ** -0.5),
        "fox_w_in": nrm((N_FOX, D, 3 * D + FOX_HEADS), D ** -0.5),
        "fox_b_f": jax.random.uniform(next(ks), (N_FOX, FOX_HEADS), jnp.float32, 1.0, 5.0),
        "fox_w_out": nrm((N_FOX, D, D), D ** -0.5),
        "dil_w_in": nrm((N_DIL, D, (DIL_GROUPS + 2) * DIL_HEADS * HEAD_DIM), D ** -0.5),
        "dil_w_out": nrm((N_DIL, DIL_HEADS * HEAD_DIM, D), D ** -0.5),
        "diff_w_in": nrm((N_DIFF, D, 3 * D), D ** -0.5),
        "diff_lambda": nrm((N_DIFF, 4, HEAD_DIM), 0.1),
        "diff_subln": gain((N_DIFF, 2 * HEAD_DIM)),
        "diff_w_out": nrm((N_DIFF, D, D), D ** -0.5),
        "sgu_w_in": nrm((N_SGU, D, 2 * SGU_HALF), D ** -0.5),
        "sgu_norm_v": gain((N_SGU, SGU_HALF)),
        "sgu_w_s": nrm((N_SGU, SGU_GROUPS, SGU_CHUNK, SGU_CHUNK), SGU_CHUNK ** -0.5),
        "sgu_b_s": 1.0 + nrm((N_SGU, SGU_GROUPS, SGU_CHUNK), 0.1),
        "sgu_w_out": nrm((N_SGU, SGU_HALF, D), SGU_HALF ** -0.5),
        "norm_final": gain((D,)),
    }


def reference(x, p, norm_ffn1, w_ffn1_in, w_ffn1_out, norm_mix, norm_ffn2, w_ffn2_in, w_ffn2_out,
              norm_ple, w_ple_gate, b_ple_gate, w_ple_proj, fox_w_in, fox_b_f, fox_w_out,
              dil_w_in, dil_w_out, diff_w_in, diff_lambda, diff_subln, diff_w_out,
              sgu_w_in, sgu_norm_v, sgu_w_s, sgu_b_s, sgu_w_out, norm_final):
    pos = jnp.arange(x.shape[1], dtype=jnp.int32)
    h = x
    for i in range(DEPTH):
        kind, j = i % N_MIXERS, i // N_MIXERS
        h = h + 0.5 * swiglu(rms_norm(h, norm_ffn1[i]), w_ffn1_in[i], w_ffn1_out[i])
        hn = rms_norm(h, norm_mix[i])
        if kind == 0:
            y = fox_attention(hn, fox_w_in[j], fox_b_f[j], fox_w_out[j])
        elif kind == 1:
            y = dilated_attention(hn, dil_w_in[j], dil_w_out[j], pos)
        elif kind == 2:
            y = diff_attention(hn, diff_w_in[j], diff_lambda[j], diff_subln[j], diff_w_out[j], pos, i)
        else:
            y = chunked_sgu(hn, sgu_w_in[j], sgu_norm_v[j], sgu_w_s[j], sgu_b_s[j], sgu_w_out[j])
        h = h + y
        h = h + 0.5 * swiglu(rms_norm(h, norm_ffn2[i]), w_ffn2_in[i], w_ffn2_out[i])
        gate = jax.nn.sigmoid(rms_norm(h, norm_ple[i]) @ w_ple_gate[i] + b_ple_gate[i])
        h = h + gate * (p[i] @ w_ple_proj[i])
    return rms_norm(h, norm_final)
```

```cpp
#include <hip/hip_runtime.h>
#include <hip/hip_cooperative_groups.h>
#include <cstdint>
#include <cstdio>
namespace cg = cooperative_groups;

#define LAS __attribute__((address_space(3)))
typedef unsigned short bf16_t;
typedef short bf16x8 __attribute__((ext_vector_type(8)));
typedef short s16x4 __attribute__((ext_vector_type(4)));
typedef float f32x4 __attribute__((ext_vector_type(4)));
typedef float f32x2 __attribute__((ext_vector_type(2)));
typedef float f32x16 __attribute__((ext_vector_type(16)));
typedef unsigned u32x4 __attribute__((ext_vector_type(4)));
typedef unsigned u32x2 __attribute__((ext_vector_type(2)));
typedef __bf16 bf16x2_t __attribute__((ext_vector_type(2)));
typedef __attribute__((address_space(1))) unsigned char gbyte_t;

constexpr int MTOK = 32768, SEQ = 4096, DM = 1024, DFF = 2816, PLE = 256;
constexpr float NORM_EPS = 1e-6f;
constexpr float LOG2E = 1.4426950408889634f, LN2 = 0.6931471805599453f;
constexpr float QSCALE = 0.125f * LOG2E;
constexpr float LAM_INIT = 0.47071301834358414f;

constexpr size_t MiB = 1u << 20;
constexpr size_t WS_SSQX = 0, WS_SSQY = 2 * MiB, WS_SSQV = 4 * MiB, WS_LSE = 8 * MiB, WS_FLOG = 14 * MiB, WS_ROPE = 16 * MiB, WS_MISC = 16 * MiB + 512 * 1024, WS_BAR = 16 * MiB + 768 * 1024;
constexpr size_t WS_PBF = 17 * MiB, WS_HB = 33 * MiB, WS_W = 97 * MiB, WS_S1 = 280 * MiB, WS_END = 600 * MiB;
constexpr size_t L_FFN1IN = 0, L_FFN1OUT = 5767168, L_FFN2IN = 8650752, L_FFN2OUT = 14417920, L_PLEG = 17301504, L_PLEP = 18350080, L_SIZE = 18612224;
constexpr size_t W_FOXIN = 4 * L_SIZE, W_FOXOUT = W_FOXIN + 3407872, W_DILIN = W_FOXOUT + 1048576, W_DILOUT = W_DILIN + 5242880, W_DIFFIN = W_DILOUT + 1048576,
                 W_DIFFOUT = W_DIFFIN + 3145728, W_SGUIN = W_DIFFOUT + 1048576, W_SGUOUT = W_SGUIN + 4194304, W_TOTAL = W_SGUOUT + 2097152;
static_assert(WS_W + W_TOTAL * 2 <= WS_S1, "weights fit");

#ifndef PROBE_REP
#define PROBE_REP 0
#endif
constexpr unsigned BARMUL = (PROBE_REP == 9) ? 2u : 1u;
constexpr int NSLOTS = (PROBE_REP == 1) ? 11 : (PROBE_REP == 7 || PROBE_REP == 8) ? 10 : 9;
constexpr int LDS_BYTES = 139264;

__device__ __forceinline__ unsigned cvtpk(float lo, float hi) { f32x2 v = {lo, hi}; bf16x2_t b = __builtin_convertvector(v, bf16x2_t); return __builtin_bit_cast(unsigned, b); }
__device__ __forceinline__ float bf_lo(unsigned w) { return __uint_as_float(w << 16); }
__device__ __forceinline__ float bf_hi(unsigned w) { return __uint_as_float(w & 0xffff0000u); }
__device__ __forceinline__ float sx(float v, int o, int lane) { return __int_as_float(__builtin_amdgcn_ds_bpermute((lane ^ o) << 2, __float_as_int(v))); }
__device__ __forceinline__ float wave_sum(float v, int lane) {
#pragma unroll
    for (int o = 1; o < 64; o <<= 1) v += sx(v, o, lane);
    return v;
}
__device__ __forceinline__ float fast_exp2(float x) { return __builtin_amdgcn_exp2f(x); }
__device__ __forceinline__ float fast_rcp(float x) { return __builtin_amdgcn_rcpf(x); }
__device__ __forceinline__ float sigmoidf_(float x) { return fast_rcp(1.0f + fast_exp2(-x * LOG2E)); }

namespace pg8 {
constexpr int BM = 256, BK = 64, HALF = 128, HTB = HALF * BK * 2, STAGE_BYTES = 8 * HTB, NXCD = 8, WGM = 8;
__host__ __device__ __forceinline__ int lds_byte(int r, int c) { const int st = (r >> 4) * 2 + (c >> 5), rr = r & 15, cc = c & 31, ob = rr * 64 + cc * 2; return st * 1024 + (ob ^ (((ob >> 9) & 1) << 5)); }
__host__ __device__ __forceinline__ void stage_rc(int b, int& R, int& C) { const int st = b / 1024, sb = b % 1024, swz = sb ^ (((sb >> 9) & 1) << 5); R = (st >> 1) * 16 + swz / 64; C = (st & 1) * 32 + (swz % 64) / 2; }
__host__ __device__ __forceinline__ int perm32(int rho) { const int n = rho >> 4, i = rho & 15; return 8 * (i >> 2) + 4 * n + (i & 3); }
struct Unit { int pm, pn; };
struct Gemm { const bf16_t* A; const bf16_t* Bt; int M, N, K, lda; };
struct StaticOrder {
    int nM, nN, nwg, G, c;
    __device__ void init(int M, int N, int G_, int c_) { nM = M / BM; nN = N / BM; nwg = nM * nN; G = G_; c = c_; }
    __device__ bool next(int i, Unit& u) const {
        const long L = (long)i * G + c; if (L >= nwg) return false;
        int wgid = (int)L; { const int q = nwg / NXCD, r = nwg % NXCD, xcd = wgid % NXCD, off = wgid / NXCD; wgid = (xcd < r ? xcd * (q + 1) : r * (q + 1) + (xcd - r) * q) + off; }
        const int nig = WGM * nN, gid = wgid / nig, fm = gid * WGM, gsz = (nM - fm) < WGM ? (nM - fm) : WGM;
        u.pm = fm + ((wgid % nig) % gsz); u.pn = (wgid % nig) / gsz; return true;
    }
};
template <class Epi>
__device__ __forceinline__ void gemm_phase(LAS unsigned char* lds, const int tid, const Gemm g, const StaticOrder& S, const Epi& E) {
    const int wid = __builtin_amdgcn_readfirstlane(tid >> 6), lane = tid & 63, wr = wid >> 2, wc = wid & 3, fr = lane & 15, fq = lane >> 4;
    const int K = g.K, nt = K / BK, lda = g.lda;
    unsigned voffA[2], voffB[2];
#pragma unroll
    for (int i = 0; i < 2; ++i) { int R, C; stage_rc(tid * 16 + i * 8192, R, C); const int Rb = Epi::PERM ? ((R & ~31) + perm32(R & 31)) : R;
        voffA[i] = (unsigned)(R * lda + C) * 2u; voffB[i] = (unsigned)(Rb * K + C) * 2u; }
    const size_t kstep = (size_t)(BK * 2);
    const size_t hstepA = (size_t)HALF * lda * 2, hstepB = (size_t)HALF * K * 2;
    const size_t tstepA = 2 * hstepA, tstepB = 2 * hstepB;
    const unsigned ldsw = (unsigned)wid * 1024u;
    const int aoff = lds_byte(wr * 64 + fr, fq * 8), boff = lds_byte(wc * 32 + fr, fq * 8);
#define PG8_SA(b, h) (((b) * 2 + (h)) * HTB)
#define PG8_SB(b, h) ((4 + (b) * 2 + (h)) * HTB)
#define PG8_STAGE(bufoff, gbase, voff) do { _Pragma("unroll") for (int _i = 0; _i < 2; ++_i) \
        __builtin_amdgcn_global_load_lds((const unsigned*)((const char*)(gbase) + (voff)[_i]), (LAS unsigned*)(lds + (bufoff) + ldsw + _i * 8192), 16, 0, 0); } while (0)
#define PG8_LDA(dst, b, h) do { _Pragma("unroll") for (int m = 0; m < 4; ++m) _Pragma("unroll") for (int k = 0; k < 2; ++k) dst[m][k] = *(const LAS bf16x8*)(lds + PG8_SA(b, h) + aoff + m * 2048 + k * 1024); } while (0)
#define PG8_LDB(dst, b, h) do { _Pragma("unroll") for (int n = 0; n < 2; ++n) _Pragma("unroll") for (int k = 0; k < 2; ++k) dst[n][k] = *(const LAS bf16x8*)(lds + PG8_SB(b, h) + boff + n * 2048 + k * 1024); } while (0)
#define PG8_MMA(ai, bj, At, Bt) do { __builtin_amdgcn_s_setprio(1); _Pragma("unroll") for (int m = 0; m < 4; ++m) _Pragma("unroll") for (int n = 0; n < 2; ++n) _Pragma("unroll") for (int k = 0; k < 2; ++k) \
        acc[ai][bj][m][n] = __builtin_amdgcn_mfma_f32_16x16x32_bf16(Bt[n][k], At[m][k], acc[ai][bj][m][n], 0, 0, 0); __builtin_amdgcn_s_setprio(0); } while (0)
#define PG8_WAIT_V(n) asm volatile("s_waitcnt vmcnt(" #n ")" ::: "memory")
#define PG8_WAIT_L(n) asm volatile("s_waitcnt lgkmcnt(" #n ")" ::: "memory")
#define PG8_BAR __builtin_amdgcn_s_barrier()
#define PG8_SCHED __builtin_amdgcn_sched_barrier(0)
    Unit cur, nxt; int ui = 0;
    if (!S.next(0, cur)) return;
    f32x4 acc[2][2][4][2];
#pragma unroll
    for (int a = 0; a < 2; ++a)
#pragma unroll
        for (int b = 0; b < 2; ++b)
#pragma unroll
            for (int m = 0; m < 4; ++m)
#pragma unroll
                for (int n = 0; n < 2; ++n) acc[a][b][m][n] = (f32x4){0.f, 0.f, 0.f, 0.f};
    bf16x8 At[4][2], B0[2][2], B1[2][2];
    const char* cA = (const char*)g.A + (size_t)cur.pm * tstepA; const char* cB = (const char*)g.Bt + (size_t)cur.pn * tstepB;
    PG8_STAGE(PG8_SB(0, 0), cB, voffB); PG8_STAGE(PG8_SB(0, 1), cB + hstepB, voffB); PG8_STAGE(PG8_SA(0, 0), cA, voffA); PG8_STAGE(PG8_SA(0, 1), cA + hstepA, voffA);
    if (wr == 1) PG8_BAR;
    PG8_WAIT_V(2); PG8_BAR;
    PG8_STAGE(PG8_SB(1, 0), cB + kstep, voffB); PG8_STAGE(PG8_SA(1, 0), cA + kstep, voffA); PG8_STAGE(PG8_SB(1, 1), cB + hstepB + kstep, voffB);
    PG8_WAIT_V(6); PG8_BAR;
    for (;;) {
        const bool has_next = S.next(ui + 1, nxt);
        const char* nA = has_next ? (const char*)g.A + (size_t)nxt.pm * tstepA : cA; const char* nB = has_next ? (const char*)g.Bt + (size_t)nxt.pn * tstepB : cB;
        for (int t = 0; t < nt; t += 2) {
            const bool last = (t == nt - 2);
            const char* a1 = cA + (size_t)(t + 1) * kstep;
            const char* a2 = last ? nA : cA + (size_t)(t + 2) * kstep; const char* b2 = last ? nB : cB + (size_t)(t + 2) * kstep;
            const char* a3 = a2 + kstep; const char* b3 = b2 + kstep;
            PG8_LDB(B0, 0, 0); PG8_LDB(B1, 0, 1); PG8_SCHED; PG8_LDA(At, 0, 0); PG8_STAGE(PG8_SA(1, 1), a1 + hstepA, voffA);
            PG8_WAIT_V(8); PG8_WAIT_L(0); PG8_BAR; PG8_MMA(0, 0, At, B0); PG8_MMA(0, 1, At, B1); PG8_BAR; PG8_SCHED;
            PG8_LDA(At, 0, 1); PG8_STAGE(PG8_SB(0, 0), b2, voffB); PG8_STAGE(PG8_SB(0, 1), b2 + hstepB, voffB); PG8_STAGE(PG8_SA(0, 0), a2, voffA);
            PG8_WAIT_V(8); PG8_WAIT_L(0); PG8_BAR; PG8_MMA(1, 0, At, B0); PG8_MMA(1, 1, At, B1); PG8_BAR; PG8_SCHED;
            PG8_LDB(B0, 1, 0); PG8_LDB(B1, 1, 1); PG8_SCHED; PG8_LDA(At, 1, 0); PG8_STAGE(PG8_SA(0, 1), a2 + hstepA, voffA);
            PG8_WAIT_V(8); PG8_WAIT_L(0); PG8_BAR; PG8_MMA(0, 0, At, B0); PG8_MMA(0, 1, At, B1); PG8_BAR; PG8_SCHED;
            PG8_LDA(At, 1, 1); PG8_STAGE(PG8_SB(1, 0), b3, voffB); PG8_STAGE(PG8_SB(1, 1), b3 + hstepB, voffB); PG8_STAGE(PG8_SA(1, 0), a3, voffA);
            PG8_WAIT_V(8); PG8_WAIT_L(0); PG8_BAR; PG8_MMA(1, 0, At, B0); PG8_MMA(1, 1, At, B1); PG8_BAR; PG8_SCHED;
        }
        if (wr == 0) PG8_BAR;
        E(acc, cur, wr, wc, fr, fq);
        if (!has_next) break;
#pragma unroll
        for (int a = 0; a < 2; ++a)
#pragma unroll
            for (int b = 0; b < 2; ++b)
#pragma unroll
                for (int m = 0; m < 4; ++m)
#pragma unroll
                    for (int n = 0; n < 2; ++n) acc[a][b][m][n] = (f32x4){0.f, 0.f, 0.f, 0.f};
        cur = nxt; cA = nA; cB = nB; ++ui;
        if (wr == 1) PG8_BAR;
    }
    PG8_WAIT_V(0);
    PG8_BAR;
#undef PG8_SA
#undef PG8_SB
#undef PG8_STAGE
#undef PG8_LDA
#undef PG8_LDB
#undef PG8_MMA
#undef PG8_WAIT_V
#undef PG8_WAIT_L
#undef PG8_BAR
#undef PG8_SCHED
}
}
using pg8::Unit;

__device__ __forceinline__ void row_rstd8(const float* ssq, int row0, int fq, int lane, float (&rs)[8]) {
#pragma unroll
    for (int ai = 0; ai < 2; ++ai)
#pragma unroll
        for (int m = 0; m < 4; ++m) {
            const f32x4 v = *(const f32x4*)(ssq + (size_t)(row0 + 128 * ai + 16 * m) * 16 + 4 * fq);
            float s = (v[0] + v[1]) + (v[2] + v[3]); s += sx(s, 16, lane); s += sx(s, 32, lane);
            rs[ai * 4 + m] = 1.0f / sqrtf(s * (1.0f / DM) + NORM_EPS);
        }
}
__device__ __forceinline__ float gelu_erf(float v) {
    const float av = fabsf(v), t = fast_rcp(av * 0.2316418882f + 1.0f);
    float q = t * 0.5307027145f + (-0.7265760135f); q = q * t + 0.7107068705f; q = q * t + (-0.142248368f); q = q * t + 0.127414796f; q = q * t;
    const float e = fast_exp2((v * v) * (-0.72134752044f));
    const float m = v * (q * e);
    return v < 0.f ? m : v - m;
}

struct EpiSwiglu {
    static constexpr bool PERM = true;
    const float* ssq; bf16_t* H;
    __device__ __forceinline__ void operator()(const f32x4 (&acc)[2][2][4][2], const Unit& u, int wr, int wc, int fr_, int fq_) const {
        int lane = fq_ * 16 + fr_; asm volatile("" : "+v"(lane)); const int fr = lane & 15, fq = lane >> 4;
        const int row0 = u.pm * 256 + wr * 64 + fr, col0 = u.pn * 128 + wc * 32 + 8 * fq;
        float rs[8]; row_rstd8(ssq, row0, fq, fq * 16 + fr, rs);
#pragma unroll
        for (int ai = 0; ai < 2; ++ai)
#pragma unroll
            for (int m = 0; m < 4; ++m) {
                const float r = rs[ai * 4 + m]; float o[8];
#pragma unroll
                for (int n = 0; n < 2; ++n)
#pragma unroll
                    for (int i = 0; i < 4; ++i) { const float gt = acc[ai][0][m][n][i] * r, up = acc[ai][1][m][n][i] * r; o[n * 4 + i] = gt * sigmoidf_(gt) * up; }
                u32x4 w; w.x = cvtpk(o[0], o[1]); w.y = cvtpk(o[2], o[3]); w.z = cvtpk(o[4], o[5]); w.w = cvtpk(o[6], o[7]);
                *(u32x4*)(H + (size_t)(row0 + 128 * ai + 16 * m) * DFF + col0) = w;
            }
    }
};
struct EpiResid {
    static constexpr bool PERM = false;
    const float* base; float* out; bf16_t* hb; float* ssq; float scale;
    __device__ __forceinline__ void operator()(const f32x4 (&acc)[2][2][4][2], const Unit& u, int wr, int wc, int fr_, int fq_) const {
        int lane = fq_ * 16 + fr_; asm volatile("" : "+v"(lane)); const int fr = lane & 15, fq = lane >> 4;
        const int row0 = u.pm * 256 + wr * 64 + fr, col0 = u.pn * 256 + wc * 32 + 4 * fq;
#pragma unroll
        for (int ai = 0; ai < 2; ++ai)
#pragma unroll
            for (int m = 0; m < 4; ++m) {
                const int row = row0 + 128 * ai + 16 * m; const size_t off = (size_t)row * DM + col0; float ss = 0.f;
#pragma unroll
                for (int bj = 0; bj < 2; ++bj)
#pragma unroll
                    for (int n = 0; n < 2; ++n) {
                        const size_t o2 = off + bj * 128 + n * 16;
                        const f32x4 b = *(const f32x4*)(base + o2); const f32x4 o = b + acc[ai][bj][m][n] * scale;
                        *(f32x4*)(out + o2) = o; ss += (o[0] * o[0] + o[1] * o[1]) + (o[2] * o[2] + o[3] * o[3]);
                        u32x2 w; w.x = cvtpk(o[0], o[1]); w.y = cvtpk(o[2], o[3]); *(u32x2*)(hb + o2) = w;
                    }
                ss += sx(ss, 16, lane); ss += sx(ss, 32, lane);
                if (fq == 0) ssq[(size_t)row * 16 + u.pn * 4 + wc] = ss;
            }
    }
};
struct EpiPleGate {
    static constexpr bool PERM = false;
    const float* ssq_in; const float* h; float* hout; bf16_t* hb; float* ssq_out; const float* bg; const bf16_t* pp;
    __device__ __forceinline__ void operator()(const f32x4 (&acc)[2][2][4][2], const Unit& u, int wr, int wc, int fr_, int fq_) const {
        int lane = fq_ * 16 + fr_; asm volatile("" : "+v"(lane)); const int fr = lane & 15, fq = lane >> 4;
        const int row0 = u.pm * 256 + wr * 64 + fr, col0 = u.pn * 256 + wc * 32 + 4 * fq;
        float rs[8]; row_rstd8(ssq_in, row0, fq, fq * 16 + fr, rs);
#pragma unroll
        for (int ai = 0; ai < 2; ++ai)
#pragma unroll
            for (int m = 0; m < 4; ++m) {
                const int row = row0 + 128 * ai + 16 * m; const size_t off = (size_t)row * DM + col0; float ss = 0.f; const float r = rs[ai * 4 + m];
#pragma unroll
                for (int bj = 0; bj < 2; ++bj)
#pragma unroll
                    for (int n = 0; n < 2; ++n) {
                        const size_t o2 = off + bj * 128 + n * 16; const int col = col0 + bj * 128 + n * 16;
                        const f32x4 b = *(const f32x4*)(h + o2); const f32x4 bb = *(const f32x4*)(bg + col); const u32x2 pw = *(const u32x2*)(pp + o2);
                        f32x4 o;
                        o[0] = b[0] + sigmoidf_(acc[ai][bj][m][n][0] * r + bb[0]) * bf_lo(pw.x);
                        o[1] = b[1] + sigmoidf_(acc[ai][bj][m][n][1] * r + bb[1]) * bf_hi(pw.x);
                        o[2] = b[2] + sigmoidf_(acc[ai][bj][m][n][2] * r + bb[2]) * bf_lo(pw.y);
                        o[3] = b[3] + sigmoidf_(acc[ai][bj][m][n][3] * r + bb[3]) * bf_hi(pw.y);
                        *(f32x4*)(hout + o2) = o; ss += (o[0] * o[0] + o[1] * o[1]) + (o[2] * o[2] + o[3] * o[3]);
                        u32x2 w; w.x = cvtpk(o[0], o[1]); w.y = cvtpk(o[2], o[3]); *(u32x2*)(hb + o2) = w;
                    }
                ss += sx(ss, 16, lane); ss += sx(ss, 32, lane);
                if (fq == 0) ssq_out[(size_t)row * 16 + u.pn * 4 + wc] = ss;
            }
    }
};
struct EpiBf16 {
    static constexpr bool PERM = true;
    bf16_t* O; int ldo;
    __device__ __forceinline__ void operator()(const f32x4 (&acc)[2][2][4][2], const Unit& u, int wr, int wc, int fr_, int fq_) const {
        int lane = fq_ * 16 + fr_; asm volatile("" : "+v"(lane)); const int fr = lane & 15, fq = lane >> 4;
        const int row0 = u.pm * 256 + wr * 64 + fr, col0 = u.pn * 256 + wc * 32 + 8 * fq;
#pragma unroll
        for (int ai = 0; ai < 2; ++ai)
#pragma unroll
            for (int m = 0; m < 4; ++m)
#pragma unroll
                for (int bj = 0; bj < 2; ++bj) {
                    const f32x4 v0 = acc[ai][bj][m][0], v1 = acc[ai][bj][m][1];
                    u32x4 w; w.x = cvtpk(v0[0], v0[1]); w.y = cvtpk(v0[2], v0[3]); w.z = cvtpk(v1[0], v1[1]); w.w = cvtpk(v1[2], v1[3]);
                    *(u32x4*)(O + (size_t)(row0 + 128 * ai + 16 * m) * ldo + col0 + bj * 128) = w;
                }
    }
};
struct EpiQkv {
    static constexpr bool PERM = true;
    const float* ssq; bf16_t* O; int ldo; int qs_end, rope_end, fg_tile; const f32x2* rope; const float* bf; float* flog;
    __device__ __forceinline__ void operator()(const f32x4 (&acc)[2][2][4][2], const Unit& u, int wr, int wc, int fr_, int fq_) const {
        int lane = fq_ * 16 + fr_; asm volatile("" : "+v"(lane)); const int fr = lane & 15, fq = lane >> 4;
        const int row0 = u.pm * 256 + wr * 64 + fr, colt = u.pn * 256;
        float rs[8]; row_rstd8(ssq, row0, fq, fq * 16 + fr, rs);
        if (u.pn == fg_tile) {
            if (wc == 0 && fq < 2) {
                const f32x4 b0 = *(const f32x4*)(bf + 8 * fq), b1 = *(const f32x4*)(bf + 8 * fq + 4);
#pragma unroll
                for (int ai = 0; ai < 2; ++ai)
#pragma unroll
                    for (int m = 0; m < 4; ++m) {
                        const float r = rs[ai * 4 + m]; f32x4 o0, o1;
#pragma unroll
                        for (int i = 0; i < 4; ++i) {
                            const float x0 = acc[ai][0][m][0][i] * r + b0[i], x1 = acc[ai][0][m][1][i] * r + b1[i];
                            o0[i] = fminf(x0, 0.f) - logf(1.0f + expf(-fabsf(x0))); o1[i] = fminf(x1, 0.f) - logf(1.0f + expf(-fabsf(x1)));
                        }
                        float* p = flog + (size_t)(row0 + 128 * ai + 16 * m) * 16 + 8 * fq;
                        *(f32x4*)p = o0; *(f32x4*)(p + 4) = o1;
                    }
            }
            return;
        }
        const float sc = colt < qs_end ? QSCALE : 1.0f;
        const bool do_rope = (colt < rope_end) && ((wc & 1) == 0);
        const float sgn = fq == 0 ? -1.0f : 1.0f;
#pragma unroll
        for (int ai = 0; ai < 2; ++ai)
#pragma unroll
            for (int m = 0; m < 4; ++m) {
                const int row = row0 + 128 * ai + 16 * m; const float r = rs[ai * 4 + m] * sc;
                f32x4 cs[4];
                if (do_rope) { const f32x4* tp = (const f32x4*)(rope + (size_t)(row & (SEQ - 1)) * 8);
#pragma unroll
                    for (int j = 0; j < 4; ++j) cs[j] = tp[j]; }
#pragma unroll
                for (int bj = 0; bj < 2; ++bj) {
                    f32x4 v0 = acc[ai][bj][m][0] * r, v1 = acc[ai][bj][m][1] * r;
                    if (do_rope) {
                        f32x4 p0, p1;
#pragma unroll
                        for (int i = 0; i < 4; ++i) { p0[i] = sx(v0[i], 16, lane); p1[i] = sx(v1[i], 16, lane); }
                        if (fq < 2) {
                            v0[0] = v0[0] * cs[0][0] + sgn * p0[0] * cs[0][1]; v0[1] = v0[1] * cs[0][2] + sgn * p0[1] * cs[0][3];
                            v0[2] = v0[2] * cs[1][0] + sgn * p0[2] * cs[1][1]; v0[3] = v0[3] * cs[1][2] + sgn * p0[3] * cs[1][3];
                            v1[0] = v1[0] * cs[2][0] + sgn * p1[0] * cs[2][1]; v1[1] = v1[1] * cs[2][2] + sgn * p1[1] * cs[2][3];
                            v1[2] = v1[2] * cs[3][0] + sgn * p1[2] * cs[3][1]; v1[3] = v1[3] * cs[3][2] + sgn * p1[3] * cs[3][3];
                        }
                    }
                    u32x4 w; w.x = cvtpk(v0[0], v0[1]); w.y = cvtpk(v0[2], v0[3]); w.z = cvtpk(v1[0], v1[1]); w.w = cvtpk(v1[2], v1[3]);
                    *(u32x4*)(O + (size_t)row * ldo + colt + bj * 128 + wc * 32 + 8 * fq) = w;
                }
            }
    }
};
struct EpiSguIn {
    static constexpr bool PERM = true;
    const float* ssq; bf16_t* O; float* ssqv;
    __device__ __forceinline__ void operator()(const f32x4 (&acc)[2][2][4][2], const Unit& u, int wr, int wc, int fr_, int fq_) const {
        int lane = fq_ * 16 + fr_; asm volatile("" : "+v"(lane)); const int fr = lane & 15, fq = lane >> 4;
        const int row0 = u.pm * 256 + wr * 64 + fr, col0 = u.pn * 256 + wc * 32 + 8 * fq;
        float rs[8]; row_rstd8(ssq, row0, fq, fq * 16 + fr, rs);
#pragma unroll
        for (int ai = 0; ai < 2; ++ai)
#pragma unroll
            for (int m = 0; m < 4; ++m) {
                const int row = row0 + 128 * ai + 16 * m; const float r = rs[ai * 4 + m]; float ss = 0.f;
#pragma unroll
                for (int bj = 0; bj < 2; ++bj) {
                    float o[8];
#pragma unroll
                    for (int n = 0; n < 2; ++n)
#pragma unroll
                        for (int i = 0; i < 4; ++i) { const float gv = gelu_erf(acc[ai][bj][m][n][i] * r); o[n * 4 + i] = gv; ss += gv * gv; }
                    u32x4 w; w.x = cvtpk(o[0], o[1]); w.y = cvtpk(o[2], o[3]); w.z = cvtpk(o[4], o[5]); w.w = cvtpk(o[6], o[7]);
                    *(u32x4*)(O + (size_t)row * 4096 + col0 + bj * 128) = w;
                }
                if (u.pn >= 8) { ss += sx(ss, 16, lane); ss += sx(ss, 32, lane); if (fq == 0) ssqv[(size_t)row * 32 + (u.pn - 8) * 4 + wc] = ss; }
            }
    }
};

struct AttnJob {
    const bf16_t* Q; const bf16_t* K; const bf16_t* V; bf16_t* O;
    long pitch, opitch;
    const float* bias; int bstride;
    float* lse; int lstride;
    int q0, window;
};
constexpr int A_K = 0, A_V = 18432, A_B = 34816, A_WS = 35328, A_OST = 40960;
__device__ __forceinline__ int crow(int r, int hi) { return (r & 3) + 8 * (r >> 2) + 4 * hi; }

__device__ __forceinline__ void attn_unit(LAS unsigned char* lds, const int tid, const AttnJob& J) {
    const int lane = tid & 63, r32 = lane & 31, hi = lane >> 5; const int wid = __builtin_amdgcn_readfirstlane(tid >> 6);
    const int q0 = J.q0, W = J.window;
    const int t_lo = (q0 - W > 0 ? q0 - W : 0) >> 6, t_hi = (q0 + 255) >> 6, nt = t_hi - t_lo + 1;
    const int qw = q0 + 32 * wid;
    const int tw_lo = (qw - W > 0 ? qw - W : 0) >> 6, tw_hi = (qw + 31) >> 6;
    const int qrow = qw + r32;
    bf16x8 qr[4];
    { const bf16_t* qp = J.Q + (long)qrow * J.pitch + hi * 8;
#pragma unroll
      for (int d0 = 0; d0 < 4; ++d0) qr[d0] = *(const bf16x8*)(qp + d0 * 16); }
    const int srow = tid >> 3, sch = tid & 7;
    const bf16_t* kg = J.K + (long)srow * J.pitch + sch * 8; const bf16_t* vg = J.V + (long)srow * J.pitch + sch * 8;
    const long tstride = 64 * J.pitch;
    const int kdst = A_K + srow * 144 + sch * 16, vdst = A_V + (srow >> 2) * 512 + (sch >> 2) * 256 + (srow & 3) * 64 + (sch & 3) * 16;
    LAS float* wsf = (LAS float*)(lds + A_WS) + wid * 64;
    u32x4 kreg, vreg; float breg = 0.f;
    kreg = *(const u32x4*)(kg + (long)t_lo * tstride); vreg = *(const u32x4*)(vg + (long)t_lo * tstride);
    if (J.bias && tid < 64) breg = J.bias[(long)(t_lo * 64 + tid) * J.bstride];
    *(LAS u32x4*)(lds + kdst) = kreg; *(LAS u32x4*)(lds + vdst) = vreg; if (J.bias && tid < 64) *(LAS float*)(lds + A_B + tid * 4) = breg;
    __syncthreads();
    float m_run = -1e30f, l_run = 0.f; f32x16 o0 = {}, o1 = {};
    const int g16 = (lane >> 4) & 1, i16 = lane & 15;
    const int vrd = A_V + hi * 512 + (i16 >> 2) * 64 + g16 * 32 + (i16 & 3) * 8;
    for (int it = 0; it < nt; ++it) {
        const int t = t_lo + it, cur = it & 1;
        if (it + 1 < nt) { kreg = *(const u32x4*)(kg + (long)(t + 1) * tstride); vreg = *(const u32x4*)(vg + (long)(t + 1) * tstride);
            if (J.bias && tid < 64) breg = J.bias[(long)((t + 1) * 64 + tid) * J.bstride]; }
        if (t >= tw_lo && t <= tw_hi) {
            const LAS unsigned char* Kb = lds + A_K + cur * 9216; const LAS unsigned char* Vb = lds + cur * 8192;
            f32x16 p0 = {}, p1 = {};
#pragma unroll
            for (int d0 = 0; d0 < 4; ++d0) {
                const bf16x8 k0 = *(const LAS bf16x8*)(Kb + r32 * 144 + d0 * 32 + hi * 16);
                const bf16x8 k1 = *(const LAS bf16x8*)(Kb + (32 + r32) * 144 + d0 * 32 + hi * 16);
                p0 = __builtin_amdgcn_mfma_f32_32x32x16_bf16(k0, qr[d0], p0, 0, 0, 0);
                p1 = __builtin_amdgcn_mfma_f32_32x32x16_bf16(k1, qr[d0], p1, 0, 0, 0);
            }
            if (J.bias) {
                const LAS float* bb = (const LAS float*)(lds + A_B + cur * 256);
#pragma unroll
                for (int g = 0; g < 4; ++g) { const f32x4 b0 = *(const LAS f32x4*)(bb + 8 * g + 4 * hi), b1 = *(const LAS f32x4*)(bb + 32 + 8 * g + 4 * hi);
#pragma unroll
                    for (int i = 0; i < 4; ++i) { p0[4 * g + i] -= b0[i]; p1[4 * g + i] -= b1[i]; } }
            }
            const int kv0 = t * 64;
            const bool need_mask = (kv0 + 63 > qw) || (qw + 31 - kv0 > W);
            if (need_mask) {
#pragma unroll
                for (int r = 0; r < 16; ++r) { const int kv = kv0 + crow(r, hi);
                    if (kv > qrow || qrow - kv > W) p0[r] = -INFINITY;
                    if (kv + 32 > qrow || qrow - kv - 32 > W) p1[r] = -INFINITY; }
            }
            float mx = fmaxf(p0[0], p1[0]);
#pragma unroll
            for (int r = 1; r < 16; ++r) mx = fmaxf(mx, fmaxf(p0[r], p1[r]));
            mx = fmaxf(mx, sx(mx, 32, lane));
            const float m_new = fmaxf(m_run, mx), alpha = fast_exp2(m_run - m_new); m_run = m_new;
            float ls = 0.f;
#pragma unroll
            for (int r = 0; r < 16; ++r) { p0[r] = fast_exp2(p0[r] - m_new); p1[r] = fast_exp2(p1[r] - m_new); ls += p0[r] + p1[r]; }
            l_run = l_run * alpha + ls;
            if (__any(alpha != 1.0f)) {
                if (hi == 0) wsf[r32] = alpha;
#pragma unroll
                for (int g = 0; g < 4; ++g) { const f32x4 a = *(const LAS f32x4*)(wsf + 8 * g + 4 * hi);
#pragma unroll
                    for (int i = 0; i < 4; ++i) { o0[4 * g + i] *= a[i]; o1[4 * g + i] *= a[i]; } }
            }
            bf16x8 pa[4];
#pragma unroll
            for (int s = 0; s < 2; ++s) {
                u32x4 w0, w1;
                w0.x = cvtpk(p0[8 * s + 0], p0[8 * s + 1]); w0.y = cvtpk(p0[8 * s + 2], p0[8 * s + 3]); w0.z = cvtpk(p0[8 * s + 4], p0[8 * s + 5]); w0.w = cvtpk(p0[8 * s + 6], p0[8 * s + 7]);
                w1.x = cvtpk(p1[8 * s + 0], p1[8 * s + 1]); w1.y = cvtpk(p1[8 * s + 2], p1[8 * s + 3]); w1.z = cvtpk(p1[8 * s + 4], p1[8 * s + 5]); w1.w = cvtpk(p1[8 * s + 6], p1[8 * s + 7]);
                pa[s] = __builtin_bit_cast(bf16x8, w0); pa[2 + s] = __builtin_bit_cast(bf16x8, w1);
            }
#pragma unroll
            for (int s = 0; s < 4; ++s) {
#pragma unroll
                for (int db = 0; db < 2; ++db) {
                    const LAS unsigned char* vp = lds + vrd + cur * 8192 + s * 2048 + db * 256;
                    const s16x4 lo = __builtin_bit_cast(s16x4, __builtin_amdgcn_ds_read_tr16_b64_v4i16((LAS s16x4*)vp));
                    const s16x4 hh = __builtin_bit_cast(s16x4, __builtin_amdgcn_ds_read_tr16_b64_v4i16((LAS s16x4*)(vp + 1024)));
                    const bf16x8 vf = (bf16x8){lo[0], lo[1], lo[2], lo[3], hh[0], hh[1], hh[2], hh[3]};
                    if (db == 0) o0 = __builtin_amdgcn_mfma_f32_32x32x16_bf16(pa[s], vf, o0, 0, 0, 0);
                    else         o1 = __builtin_amdgcn_mfma_f32_32x32x16_bf16(pa[s], vf, o1, 0, 0, 0);
                }
            }
            (void)Vb;
        }
        if (it + 1 < nt) { const int nb = cur ^ 1;
            *(LAS u32x4*)(lds + kdst + nb * 9216) = kreg; *(LAS u32x4*)(lds + vdst + nb * 8192) = vreg; if (J.bias && tid < 64) *(LAS float*)(lds + A_B + nb * 256 + tid * 4) = breg; }
        __syncthreads();
    }
    const float l_tot = l_run + sx(l_run, 32, lane);
    if (J.lse && hi == 0) J.lse[(long)qrow * J.lstride] = (m_run + log2f(l_tot)) * LN2;
    if (hi == 0) wsf[r32] = 1.0f / l_tot;
    LAS bf16_t* stg = (LAS bf16_t*)(lds + A_OST) + wid * 2048;
#pragma unroll
    for (int g = 0; g < 4; ++g) { const f32x4 a = *(const LAS f32x4*)(wsf + 8 * g + 4 * hi);
#pragma unroll
        for (int i = 0; i < 4; ++i) { const int orow = 8 * g + 4 * hi + i;
            stg[orow * 64 + r32] = (bf16_t)(cvtpk(o0[4 * g + i] * a[i], 0.f) & 0xffffu);
            stg[orow * 64 + 32 + r32] = (bf16_t)(cvtpk(o1[4 * g + i] * a[i], 0.f) & 0xffffu); } }
    bf16_t* Ow = J.O + (long)qw * J.opitch;
#pragma unroll
    for (int i = 0; i < 4; ++i) { const int row = i * 8 + (lane >> 3), ch = lane & 7; const u32x4 v = *(const LAS u32x4*)(stg + row * 64 + ch * 8); *(u32x4*)(Ow + (long)row * J.opitch + ch * 8) = v; }
    __syncthreads();
}

__device__ __forceinline__ void grid_bar(unsigned* bw, unsigned G, int tid, unsigned k) {
    asm volatile("s_waitcnt vmcnt(0)" ::: "memory");
    __syncthreads();
    if (tid == 0) {
        __builtin_amdgcn_fence(__ATOMIC_RELEASE, "agent");
        asm volatile("s_waitcnt vmcnt(0)" ::: "memory");
        const unsigned old = __hip_atomic_fetch_add(bw, 1u, __ATOMIC_RELAXED, __HIP_MEMORY_SCOPE_AGENT);
        if (old + 1u == G * (k + 1u)) __hip_atomic_store(bw + 64, k + 1u, __ATOMIC_RELAXED, __HIP_MEMORY_SCOPE_AGENT);
        else { unsigned sp = 0; while (__hip_atomic_load(bw + 64, __ATOMIC_RELAXED, __HIP_MEMORY_SCOPE_AGENT) <= k) { __builtin_amdgcn_s_sleep(1); if (++sp > (1u << 27)) break; } }
        __builtin_amdgcn_fence(__ATOMIC_ACQUIRE, "agent");
        asm volatile("s_waitcnt vmcnt(0)" ::: "memory");
    }
    __syncthreads();
}

struct Args {
    const float *x, *p, *norm_ffn1, *w_ffn1_in, *w_ffn1_out, *norm_mix, *norm_ffn2, *w_ffn2_in, *w_ffn2_out, *norm_ple, *w_ple_gate, *b_ple_gate, *w_ple_proj,
        *fox_w_in, *fox_b_f, *fox_w_out, *dil_w_in, *dil_w_out, *diff_w_in, *diff_lambda, *diff_subln, *diff_w_out, *sgu_w_in, *sgu_norm_v, *sgu_w_s, *sgu_b_s, *sgu_w_out, *norm_final;
    float* out; unsigned char* ws;
};

__device__ __forceinline__ void transpose_item(const float* W, int K, int N, bf16_t* WT, const float* gain, int mode, LAS float* scr, int item, int lane) {
    const int nblk = (N + 31) / 32, kb = item / nblk, nb = item % nblk, k0 = 64 * kb, n0 = 32 * nb;
    const int ncol = n0 + (lane & 31); const bool okc = ncol < N;
#pragma unroll 8
    for (int i = 0; i < 32; ++i) { const int kk = 2 * i + (lane >> 5); float v = okc ? W[(size_t)(k0 + kk) * N + ncol] : 0.f; if (gain) v *= gain[k0 + kk]; scr[kk * 33 + (lane & 31)] = v; }
    asm volatile("s_waitcnt lgkmcnt(0)" ::: "memory");
    int d0 = n0;
    if (mode == 1) { if (n0 < DFF) d0 = (n0 / 128) * 256 + (n0 % 128); else { const int mm = n0 - DFF; d0 = (mm / 128) * 256 + 128 + (mm % 128); } }
    const int c = lane & 7;
#pragma unroll
    for (int j = 0; j < 4; ++j) { const int n = (lane >> 3) + 8 * j; const LAS float* s = scr + (8 * c) * 33 + n;
        u32x4 o; o.x = cvtpk(s[0 * 33], s[1 * 33]); o.y = cvtpk(s[2 * 33], s[3 * 33]); o.z = cvtpk(s[4 * 33], s[5 * 33]); o.w = cvtpk(s[6 * 33], s[7 * 33]);
        *(u32x4*)(WT + (size_t)(d0 + n) * K + k0 + 8 * c) = o; }
    asm volatile("s_waitcnt lgkmcnt(0)" ::: "memory");
}

__device__ __forceinline__ void get_mat(const Args& a, bf16_t* Wt, int mi, const float*& src, int& K, int& N, bf16_t*& dst, const float*& gain, int& mode) {
    gain = nullptr; mode = 0;
    if (mi < 24) {
        const int L = mi / 6, k = mi % 6; bf16_t* wl = Wt + (size_t)L * L_SIZE;
        if (k == 0)      { src = a.w_ffn1_in + (size_t)L * DM * 2 * DFF; K = DM; N = 2 * DFF; dst = wl + L_FFN1IN; gain = a.norm_ffn1 + L * DM; mode = 1; }
        else if (k == 1) { src = a.w_ffn1_out + (size_t)L * DFF * DM; K = DFF; N = DM; dst = wl + L_FFN1OUT; }
        else if (k == 2) { src = a.w_ffn2_in + (size_t)L * DM * 2 * DFF; K = DM; N = 2 * DFF; dst = wl + L_FFN2IN; gain = a.norm_ffn2 + L * DM; mode = 1; }
        else if (k == 3) { src = a.w_ffn2_out + (size_t)L * DFF * DM; K = DFF; N = DM; dst = wl + L_FFN2OUT; }
        else if (k == 4) { src = a.w_ple_gate + (size_t)L * DM * DM; K = DM; N = DM; dst = wl + L_PLEG; gain = a.norm_ple + L * DM; }
        else             { src = a.w_ple_proj + (size_t)L * PLE * DM; K = PLE; N = DM; dst = wl + L_PLEP; }
    } else {
        const int k = mi - 24;
        if (k == 0)      { src = a.fox_w_in; K = DM; N = 3 * DM + 16; dst = Wt + W_FOXIN; gain = a.norm_mix; }
        else if (k == 1) { src = a.fox_w_out; K = DM; N = DM; dst = Wt + W_FOXOUT; }
        else if (k == 2) { src = a.dil_w_in; K = DM; N = 5 * DM; dst = Wt + W_DILIN; gain = a.norm_mix + DM; }
        else if (k == 3) { src = a.dil_w_out; K = DM; N = DM; dst = Wt + W_DILOUT; }
        else if (k == 4) { src = a.diff_w_in; K = DM; N = 3 * DM; dst = Wt + W_DIFFIN; gain = a.norm_mix + 2 * DM; }
        else if (k == 5) { src = a.diff_w_out; K = DM; N = DM; dst = Wt + W_DIFFOUT; }
        else if (k == 6) { src = a.sgu_w_in; K = DM; N = 4 * DM; dst = Wt + W_SGUIN; gain = a.norm_mix + 3 * DM; }
        else             { src = a.sgu_w_out; K = 2 * DM; N = DM; dst = Wt + W_SGUOUT; }
    }
}

__global__ void __launch_bounds__(512, 2) mega(Args a) {
    extern __shared__ __attribute__((aligned(16))) unsigned char lds_raw[];
    LAS unsigned char* lds = (LAS unsigned char*)lds_raw;
    cg::this_grid().sync();
    const int wave0 = __builtin_amdgcn_readfirstlane((int)threadIdx.x >> 6);
#define PHASE_VARS \
    int wave_ = wave0; asm volatile("" : "+s"(wave_)); \
    unsigned ones_ = ~0u; asm volatile("" : "+s"(ones_)); \
    int tid = wave_ * 64 + (int)__builtin_amdgcn_mbcnt_hi(ones_, __builtin_amdgcn_mbcnt_lo(ones_, 0u)); asm volatile("" : "+v"(tid)); \
    int bid = blockIdx.x; asm volatile("" : "+s"(bid)); \
    int G = gridDim.x; asm volatile("" : "+s"(G)); \
    const int lane = tid & 63, wave = wave_; \
    const int gw = bid * 8 + wave, NGW = G * 8; \
    const long gt = (long)bid * 512 + tid, NGT = (long)G * 512; \
    gbyte_t* wsg_ = (gbyte_t*)a.ws; asm volatile("" : "+s"(wsg_)); unsigned char* ws = (unsigned char*)wsg_; \
    float* ssqX = (float*)(ws + WS_SSQX); float* ssqY = (float*)(ws + WS_SSQY); float* ssqV = (float*)(ws + WS_SSQV); \
    float* lseb = (float*)(ws + WS_LSE); float* flog = (float*)(ws + WS_FLOG); f32x2* rope = (f32x2*)(ws + WS_ROPE); float* misc = (float*)(ws + WS_MISC); \
    bf16_t* pbf = (bf16_t*)(ws + WS_PBF); bf16_t* hb = (bf16_t*)(ws + WS_HB); bf16_t* Wt = (bf16_t*)(ws + WS_W); bf16_t* S1 = (bf16_t*)(ws + WS_S1); \
    float* h = a.out; \
    (void)lane; (void)wave; (void)gw; (void)NGW; (void)gt; (void)NGT; (void)ssqX; (void)ssqY; (void)ssqV; (void)lseb; (void)flog; (void)rope; (void)misc; (void)pbf; (void)hb; (void)Wt; (void)S1; (void)h;

    {
        PHASE_VARS
        LAS float* scr = (LAS float*)(lds + wave * 16384);
#pragma unroll 1
        for (int rep = 0; rep < (PROBE_REP == 6 ? 2 : 1); ++rep) {
        int it0 = 0;
#pragma unroll 1
        for (int mi = 0; mi < 32; ++mi) {
            const float* src; int K_, N_; bf16_t* dst; const float* gain; int mode;
            get_mat(a, Wt, mi, src, K_, N_, dst, gain, mode);
            const int nitems = (K_ / 64) * ((N_ + 31) / 32);
            const int first = it0 + (((gw - it0) % NGW) + NGW) % NGW;
#pragma unroll 1
            for (int gi = first; gi < it0 + nitems; gi += NGW) transpose_item(src, K_, N_, dst, gain, mode, scr, gi - it0, lane);
            it0 += nitems;
        }
#pragma unroll 1
        for (int m = gw; m < MTOK; m += NGW) {
            const f32x4* xr = (const f32x4*)(a.x + (size_t)m * DM) + lane; u32x2* o8 = (u32x2*)(hb + (size_t)m * DM) + lane; float ss = 0.f;
#pragma unroll
            for (int j = 0; j < 4; ++j) { const f32x4 v = xr[64 * j]; ss += (v[0] * v[0] + v[1] * v[1]) + (v[2] * v[2] + v[3] * v[3]); u32x2 w; w.x = cvtpk(v[0], v[1]); w.y = cvtpk(v[2], v[3]); o8[64 * j] = w; }
            ss = wave_sum(ss, lane);
            if (lane < 16) ssqX[(size_t)m * 16 + lane] = ss * (1.0f / 16.0f);
        }
#pragma unroll 1
        for (long i = gt; i < (long)MTOK * PLE / 4; i += NGT) { const f32x4 v = ((const f32x4*)a.p)[i]; u32x2 w; w.x = cvtpk(v[0], v[1]); w.y = cvtpk(v[2], v[3]); ((u32x2*)pbf)[i] = w; }
        if (gt < SEQ * 8) {
            const int pos = (int)(gt >> 3), j = (int)(gt & 7);
            const float invf = j == 0 ? 1.0f : j == 1 ? 0.1939227432012558f : j == 2 ? 0.03760603070259094f : j == 3 ? 0.007292664609849453f : j == 4 ? 0.0014142135623842478f
                             : j == 5 ? 0.00027424818836152554f : j == 6 ? 5.318296098266728e-05f : 1.0313386155758053e-05f;
            const float angf = (float)pos * invf; const double ang = (double)angf;
            const double kk = rint(ang * 0.15915494309189535); const double r = (ang - kk * 6.283185307179586) - kk * 2.4492935982947064e-16; const double r2 = r * r;
            double s = 1.0, c = 1.0;
#pragma unroll
            for (int n = 13; n >= 1; --n) { s = 1.0 - s * r2 * (1.0 / (double)((2 * n) * (2 * n + 1))); c = 1.0 - c * r2 * (1.0 / (double)((2 * n - 1) * (2 * n))); }
            rope[gt] = (f32x2){(float)c, (float)(r * s)};
        }
        if (gt == 0) {
            float s1 = 0.f, s2 = 0.f;
#pragma unroll 1
            for (int i = 0; i < 64; ++i) { s1 += a.diff_lambda[i] * a.diff_lambda[64 + i]; s2 += a.diff_lambda[128 + i] * a.diff_lambda[192 + i]; }
            misc[0] = expf(s1) - expf(s2) + LAM_INIT;
        }
        }
        grid_bar((unsigned*)(ws + WS_BAR), (unsigned)G, tid, 0u);
    }

#pragma unroll 1
    for (int qq = 0; qq < 4 * NSLOTS; ++qq) {
        PHASE_VARS
        pg8::StaticOrder SO;
        bf16_t* const pp = S1 + (size_t)96 * MiB;
        bf16_t* const hb2 = S1 + (size_t)128 * MiB;
        const int L = qq / NSLOTS, sl = qq % NSLOTS;
#if PROBE_REP == 1
        const int s = (sl <= 1) ? 0 : (sl <= 7) ? sl - 1 : (sl == 8) ? 6 : sl - 2;
#elif PROBE_REP == 7
        const int s = (sl <= 2) ? sl : sl - 1;
#elif PROBE_REP == 8
        const int s = (sl <= 8) ? sl : 8;
#else
        const int s = sl;
#endif
        const bf16_t* wl = Wt + (size_t)L * L_SIZE;
        if (s == 0 || s == 6) {
            pg8::Gemm g{hb, wl + (s == 0 ? L_FFN1IN : L_FFN2IN), MTOK, 2 * DFF, DM, DM}; SO.init(MTOK, 2 * DFF, G, bid); EpiSwiglu E{ssqX, S1}; pg8::gemm_phase(lds, tid, g, SO, E);

        } else if (s == 1 || s == 5 || s == 7) {
            const bf16_t* Bt; int K_, lda_; float sc; float* sq;
            if (s == 1) { Bt = wl + L_FFN1OUT; K_ = DFF; lda_ = DFF; sc = 0.5f; sq = ssqY; }
            else if (s == 7) { Bt = wl + L_FFN2OUT; K_ = DFF; lda_ = DFF; sc = 0.5f; sq = ssqY; }
            else { sc = 1.0f; sq = ssqX; K_ = DM;
                if (L == 0) { Bt = Wt + W_FOXOUT; lda_ = 3072; } else if (L == 1) { Bt = Wt + W_DILOUT; lda_ = 5120; } else if (L == 2) { Bt = Wt + W_DIFFOUT; lda_ = 3072; } else { Bt = Wt + W_SGUOUT; K_ = 2 * DM; lda_ = 4096; } }
#if PROBE_REP == 2 || PROBE_REP == 4
            if ((PROBE_REP == 2) == (s != 5)) { pg8::Gemm g{S1, Bt, MTOK, DM, K_, lda_}; SO.init(MTOK, DM, G, bid); EpiResid E{(L == 0 && s == 1) ? a.x : h, (float*)(S1 + (size_t)96 * MiB), s == 7 ? hb2 : hb, sq, sc}; pg8::gemm_phase(lds, tid, g, SO, E); }
#endif
            { pg8::Gemm g{S1, Bt, MTOK, DM, K_, lda_}; SO.init(MTOK, DM, G, bid); EpiResid E{(L == 0 && s == 1) ? a.x : h, h, s == 7 ? hb2 : hb, sq, sc}; pg8::gemm_phase(lds, tid, g, SO, E); }
            if (s == 7) { pg8::Gemm g{pbf, wl + L_PLEP, MTOK, DM, PLE, PLE}; SO.init(MTOK, DM, G, bid); EpiBf16 E{pp, DM}; pg8::gemm_phase(lds, tid, g, SO, E); }
        } else if (s == 2) {
            if (L < 3) {
                const bf16_t* Bt; int N_, ldo, qs, re, fg;
                if (L == 0) { Bt = Wt + W_FOXIN; N_ = 3328; ldo = 3072; qs = 1024; re = 0; fg = 12; }
                else if (L == 1) { Bt = Wt + W_DILIN; N_ = 5120; ldo = 5120; qs = 3072; re = 4096; fg = -1; }
                else { Bt = Wt + W_DIFFIN; N_ = 3072; ldo = 3072; qs = 1024; re = 2048; fg = -1; }
                pg8::Gemm g{hb, Bt, MTOK, N_, DM, DM}; SO.init(MTOK, N_, G, bid); EpiQkv E{ssqY, S1, ldo, qs, re, fg, rope, a.fox_b_f, flog}; pg8::gemm_phase(lds, tid, g, SO, E);
            } else {
                pg8::Gemm g{hb, Wt + W_SGUIN, MTOK, 4096, DM, DM}; SO.init(MTOK, 4096, G, bid); EpiSguIn E{ssqY, S1, ssqV}; pg8::gemm_phase(lds, tid, g, SO, E);
            }
        } else if (s == 8) {
            { pg8::Gemm g{hb2, wl + L_PLEG, MTOK, DM, DM, DM}; SO.init(MTOK, DM, G, bid); EpiPleGate E{ssqY, h, (PROBE_REP == 8 && sl == 8) ? (float*)S1 : h, hb, ssqX, a.b_ple_gate + L * DM, pp}; pg8::gemm_phase(lds, tid, g, SO, E); }
            if (L < 3) {
                const f32x4* ps = (const f32x4*)(a.p + (size_t)(L + 1) * MTOK * PLE);
#pragma unroll 1
                for (long i = gt; i < (long)MTOK * PLE / 4; i += NGT) { const f32x4 v = ps[i]; u32x2 w; w.x = cvtpk(v[0], v[1]); w.y = cvtpk(v[2], v[3]); ((u32x2*)pbf)[i] = w; }
            }
        } else if ((s == 4 && L == 0) || (s == 3 && (L == 1 || L == 2))) {
            const int total = L == 0 ? 2048 : L == 1 ? 6144 : 4096;
#pragma unroll 1
            for (int n = bid; n < total; n += G) {
                AttnJob J;
                if (L == 0) {
                    const int v = n & 255, i = n >> 8, bh = v >> 1, s2 = (v & 1) * 4 + (i >> 1), qb = (i & 1) ? 15 - s2 : s2, b = bh >> 4, hh = bh & 15;
                    bf16_t* base = S1 + (size_t)b * SEQ * 3072 + hh * 64;
                    J = AttnJob{base, base + 1024, base + 2048, base, 3072, 3072, flog + (size_t)b * SEQ * 16 + hh, 16, nullptr, 0, qb * 256, 1 << 20};
                } else if (L == 1) {
                    const int gi = n / 2048, idx = n % 2048, bh = idx & 127, sub = idx >> 7, b = bh >> 4, hh = bh & 15;
                    const int d = gi == 0 ? 1 : gi == 1 ? 4 : 16; const int res = sub % d, ub = sub / d;
                    bf16_t* base = S1 + ((size_t)b * SEQ + res) * 5120 + hh * 64;
                    J = AttnJob{base + gi * 1024, base + 3072, base + 4096, base + gi * 1024, (long)5120 * d, (long)5120 * d, nullptr, 0,
                                lseb + (size_t)gi * MTOK * 16 + ((size_t)b * SEQ + res) * 16 + hh, 16 * d, ub * 256, 128};
                } else {
                    const int v = n & 255, i = n >> 8, b = v >> 5, ph2 = v & 31, mm = ph2 >> 1, vh = ph2 & 1, qb = (i & 1) ? 15 - (i >> 1) : (i >> 1);
                    bf16_t* base = S1 + (size_t)b * SEQ * 3072; bf16_t* OM = S1 + (size_t)MTOK * 3072;
                    J = AttnJob{base + mm * 64, base + 1024 + mm * 64, base + 2048 + (mm >> 1) * 128 + vh * 64, OM + (size_t)b * SEQ * 2048 + mm * 128 + vh * 64, 3072, 2048, nullptr, 0, nullptr, 0, qb * 256, 1 << 20};
                }
#if PROBE_REP == 3
                if (L != 1) { AttnJob J2 = J; if (L == 0) { const size_t off = (size_t)(J.Q - S1); J2.O = S1 + (size_t)96 * MiB + (off / ((size_t)SEQ * 3072)) * SEQ * 1024 + (off % 3072); J2.opitch = 1024; } attn_unit(lds, tid, J2); }
#endif
                attn_unit(lds, tid, J);
            }
        } else if (s == 3 && L == 0) {
            if (bid < 8) {
                const int hh = tid & 15, seg = tid >> 4; float* fp = flog + ((size_t)bid * SEQ + seg * 128) * 16 + hh; float sm = 0.f;
#pragma unroll 8
                for (int i = 0; i < 128; ++i) sm += fp[i * 16];
                LAS float* sc = (LAS float*)lds; sc[tid] = sm; __syncthreads();
                float pre = 0.f;
#pragma unroll 1
                for (int j = 0; j < seg; ++j) pre += sc[j * 16 + hh];
                float run = pre;
#pragma unroll 8
                for (int i = 0; i < 128; ++i) { run += fp[i * 16]; fp[i * 16] = run * LOG2E; }
                __syncthreads();
            }
        } else if (s == 4 && L == 1) {
#pragma unroll 1
            for (long it = gt; it < (long)MTOK * 128; it += NGT) {
                const long row = it >> 7; const int hh = (int)(it >> 3) & 15, ch = (int)it & 7;
                const float l0 = lseb[row * 16 + hh], l1 = lseb[(size_t)MTOK * 16 + row * 16 + hh], l2 = lseb[(size_t)2 * MTOK * 16 + row * 16 + hh];
                const float mx = fmaxf(l0, fmaxf(l1, l2)); float w0 = expf(l0 - mx), w1 = expf(l1 - mx), w2 = expf(l2 - mx); const float inv = 1.0f / (w0 + w1 + w2); w0 *= inv; w1 *= inv; w2 *= inv;
                bf16_t* p0 = S1 + row * 5120 + hh * 64 + ch * 8;
                const u32x4 a0 = *(const u32x4*)p0, a1 = *(const u32x4*)(p0 + 1024), a2 = *(const u32x4*)(p0 + 2048); u32x4 o;
#pragma unroll
                for (int k = 0; k < 4; ++k) o[k] = cvtpk(w0 * bf_lo(a0[k]) + w1 * bf_lo(a1[k]) + w2 * bf_lo(a2[k]), w0 * bf_hi(a0[k]) + w1 * bf_hi(a1[k]) + w2 * bf_hi(a2[k]));
                *(u32x4*)p0 = o;
            }
        } else if (s == 4 && L == 2) {
            const float lam = misc[0]; const bf16_t* OM = S1 + (size_t)MTOK * 3072;
#pragma unroll 1
            for (long it = gt; it < (long)MTOK * 128; it += NGT) {
                const long row = it >> 7; const int hh = (int)(it >> 4) & 7, c16 = (int)it & 15;
                const bf16_t* p1 = OM + row * 2048 + (2 * hh) * 128 + c16 * 8;
                const u32x4 a1 = *(const u32x4*)p1, a2 = *(const u32x4*)(p1 + 128); float o[8]; float ss = 0.f;
#pragma unroll
                for (int k = 0; k < 4; ++k) { o[2 * k] = bf_lo(a1[k]) - lam * bf_lo(a2[k]); o[2 * k + 1] = bf_hi(a1[k]) - lam * bf_hi(a2[k]); ss += o[2 * k] * o[2 * k] + o[2 * k + 1] * o[2 * k + 1]; }
                ss += sx(ss, 1, lane); ss += sx(ss, 2, lane); ss += sx(ss, 4, lane); ss += sx(ss, 8, lane);
                const float r = (1.0f - LAM_INIT) / sqrtf(ss * (1.0f / 128.0f) + 1e-5f);
                const f32x4 g0 = *(const f32x4*)(a.diff_subln + c16 * 8), g1 = *(const f32x4*)(a.diff_subln + c16 * 8 + 4);
                u32x4 w; w.x = cvtpk(o[0] * r * g0[0], o[1] * r * g0[1]); w.y = cvtpk(o[2] * r * g0[2], o[3] * r * g0[3]); w.z = cvtpk(o[4] * r * g1[0], o[5] * r * g1[1]); w.w = cvtpk(o[6] * r * g1[2], o[7] * r * g1[3]);
                *(u32x4*)(S1 + row * 3072 + hh * 128 + c16 * 8) = w;
            }
        } else if (s == 3 && L == 3) {
#pragma unroll 1
            for (int n = bid; n < 2048; n += G) {
                const int chunk = n >> 3, gg = n & 7; const size_t row0 = (size_t)chunk * 128;
                LAS float* rsv = (LAS float*)(lds + 65536);
                if (tid < 128) { const f32x4* sp = (const f32x4*)(ssqV + (row0 + tid) * 32); float sm = 0.f;
#pragma unroll
                    for (int j = 0; j < 8; ++j) { const f32x4 v = sp[j]; sm += (v[0] + v[1]) + (v[2] + v[3]); }
                    rsv[tid] = 1.0f / sqrtf(sm * (1.0f / 2048.0f) + NORM_EPS); }
                __syncthreads();
#pragma unroll 2
                for (int k = 0; k < 8; ++k) {
                    const int item = tid + 512 * k, sr = item >> 5, ch = item & 31;
                    const u32x4 vv = *(const u32x4*)(S1 + (row0 + sr) * 4096 + 2048 + gg * 256 + ch * 8);
                    const f32x4 n0 = *(const f32x4*)(a.sgu_norm_v + gg * 256 + ch * 8), n1 = *(const f32x4*)(a.sgu_norm_v + gg * 256 + ch * 8 + 4); const float r = rsv[sr];
                    u32x4 w; w.x = cvtpk(bf_lo(vv.x) * r * n0[0], bf_hi(vv.x) * r * n0[1]); w.y = cvtpk(bf_lo(vv.y) * r * n0[2], bf_hi(vv.y) * r * n0[3]);
                    w.z = cvtpk(bf_lo(vv.z) * r * n1[0], bf_hi(vv.z) * r * n1[1]); w.w = cvtpk(bf_lo(vv.w) * r * n1[2], bf_hi(vv.w) * r * n1[3]);
                    *(LAS u32x4*)(lds + (sr >> 2) * 2048 + (ch >> 2) * 256 + (sr & 3) * 64 + (ch & 3) * 16) = w;
                }
                __syncthreads();
                {
                    const int r32 = lane & 31, hi = lane >> 5, tb = wave & 3, chalf = wave >> 2, g16 = (lane >> 4) & 1, i16 = lane & 15;
                    const int trow = 32 * tb + r32; const float* wrow = a.sgu_w_s + ((size_t)gg * 128 + trow) * 128;
                    f32x16 acc[4] = {};
                    const int vrd = (2 * hi) * 2048 + (i16 >> 2) * 64 + g16 * 32 + (i16 & 3) * 8;
#pragma unroll 1
                    for (int ks = 0; ks <= 2 * tb + 1; ++ks) {
                        const int s0 = 16 * ks + 8 * hi; const f32x4 w0 = *(const f32x4*)(wrow + s0), w1 = *(const f32x4*)(wrow + s0 + 4); float wv[8];
#pragma unroll
                        for (int j = 0; j < 4; ++j) { wv[j] = (s0 + j <= trow) ? w0[j] : 0.f; wv[4 + j] = (s0 + 4 + j <= trow) ? w1[j] : 0.f; }
                        u32x4 pw; pw.x = cvtpk(wv[0], wv[1]); pw.y = cvtpk(wv[2], wv[3]); pw.z = cvtpk(wv[4], wv[5]); pw.w = cvtpk(wv[6], wv[7]);
                        const bf16x8 pa = __builtin_bit_cast(bf16x8, pw);
#pragma unroll
                        for (int cbl = 0; cbl < 4; ++cbl) {
                            const LAS unsigned char* vp = lds + vrd + ks * 8192 + (chalf * 4 + cbl) * 256;
                            const s16x4 lo = __builtin_bit_cast(s16x4, __builtin_amdgcn_ds_read_tr16_b64_v4i16((LAS s16x4*)vp));
                            const s16x4 hh = __builtin_bit_cast(s16x4, __builtin_amdgcn_ds_read_tr16_b64_v4i16((LAS s16x4*)(vp + 2048)));
                            const bf16x8 vf = (bf16x8){lo[0], lo[1], lo[2], lo[3], hh[0], hh[1], hh[2], hh[3]};
                            acc[cbl] = __builtin_amdgcn_mfma_f32_32x32x16_bf16(pa, vf, acc[cbl], 0, 0, 0);
                        }
                    }
#pragma unroll
                    for (int cbl = 0; cbl < 4; ++cbl)
#pragma unroll
                        for (int r = 0; r < 16; ++r) {
                            const int t = 32 * tb + crow(r, hi); bf16_t* up = S1 + (row0 + t) * 4096 + gg * 256 + (chalf * 4 + cbl) * 32 + r32;
                            const float uval = __uint_as_float((unsigned)(*up) << 16); const float mixed = acc[cbl][r] + a.sgu_b_s[gg * 128 + t];
                            *up = (bf16_t)(cvtpk(uval * mixed, 0.f) & 0xffffu);
                        }
                }
                __syncthreads();
            }
        }
        grid_bar((unsigned*)(ws + WS_BAR), (unsigned)G, tid, (unsigned)qq + 1u);
    }
    PHASE_VARS
#pragma unroll 1
    for (int m = gw; m < MTOK; m += NGW) {
        float sm = lane < 16 ? ssqX[(size_t)m * 16 + lane] : 0.f; sm = wave_sum(sm, lane);
        const float r = 1.0f / sqrtf(sm * (1.0f / DM) + NORM_EPS);
        f32x4* xr = (f32x4*)(h + (size_t)m * DM) + lane; const f32x4* gr = (const f32x4*)a.norm_final + lane;
#pragma unroll
        for (int j = 0; j < 4; ++j) { const f32x4 v = xr[64 * j]; const f32x4 gg = gr[64 * j]; xr[64 * j] = v * r * gg; }
    }
}

extern "C" void kernel_launch(void* const* d_in, const int* in_sizes, int n_in, void* d_out, int out_size, void* d_ws, size_t ws_size, hipStream_t stream) {
    static int grid = 0;
    if (grid == 0) {
        int dev = 0, cus = 0, per_cu = 0;
        hipGetDevice(&dev);
        hipDeviceGetAttribute(&cus, hipDeviceAttributeMultiprocessorCount, dev);
        hipFuncSetAttribute((const void*)mega, hipFuncAttributeMaxDynamicSharedMemorySize, LDS_BYTES);
        hipOccupancyMaxActiveBlocksPerMultiprocessor(&per_cu, (const void*)mega, 512, LDS_BYTES);
        if (per_cu < 1) per_cu = 1;
        grid = cus * per_cu;
        if (ws_size < WS_END) fprintf(stderr, "kernel_launch: workspace too small: %zu < %zu\n", ws_size, (size_t)WS_END);
    }
    hipMemsetAsync((unsigned char*)d_ws + WS_BAR, 0, 1024, stream);
    Args a{};
    const float** pa = (const float**)&a;
    for (int i = 0; i < 28; ++i) pa[i] = (const float*)d_in[i];
    a.out = (float*)d_out; a.ws = (unsigned char*)d_ws;
    void* args[] = {&a};
    hipError_t e = hipLaunchCooperativeKernel((const void*)mega, dim3(grid), dim3(512), args, LDS_BYTES, stream);
    if (e != hipSuccess) fprintf(stderr, "cooperative launch failed: %s (grid %d)\n", hipGetErrorString(e), grid);
}
```

```cpp
#include <hip/hip_runtime.h>
#include <hip/hip_cooperative_groups.h>
#include <cstdint>
#include <cstdio>
namespace cg = cooperative_groups;

#define LAS __attribute__((address_space(3)))
typedef unsigned short bf16_t;
typedef short bf16x8 __attribute__((ext_vector_type(8)));
typedef short s16x4 __attribute__((ext_vector_type(4)));
typedef float f32x4 __attribute__((ext_vector_type(4)));
typedef float f32x2 __attribute__((ext_vector_type(2)));
typedef float f32x16 __attribute__((ext_vector_type(16)));
typedef unsigned u32x4 __attribute__((ext_vector_type(4)));
typedef unsigned u32x2 __attribute__((ext_vector_type(2)));
typedef __bf16 bf16x2_t __attribute__((ext_vector_type(2)));
typedef __attribute__((address_space(1))) unsigned char gbyte_t;

constexpr int MTOK = 32768, SEQ = 4096, DM = 1024, DFF = 2816, PLE = 256;
constexpr float NORM_EPS = 1e-6f;
constexpr float LOG2E = 1.4426950408889634f, LN2 = 0.6931471805599453f;
constexpr float QSCALE = 0.125f * LOG2E;
constexpr float LAM_INIT = 0.47071301834358414f;

constexpr size_t MiB = 1u << 20;
constexpr size_t WS_SSQX = 0, WS_SSQY = 2 * MiB, WS_SSQV = 4 * MiB, WS_LSE = 8 * MiB, WS_FLOG = 14 * MiB, WS_ROPE = 16 * MiB, WS_MISC = 16 * MiB + 512 * 1024, WS_BAR = 16 * MiB + 768 * 1024;
constexpr size_t WS_PBF = 17 * MiB, WS_HB = 33 * MiB, WS_W = 97 * MiB, WS_S1 = 280 * MiB, WS_END = 600 * MiB;
constexpr size_t L_FFN1IN = 0, L_FFN1OUT = 5767168, L_FFN2IN = 8650752, L_FFN2OUT = 14417920, L_PLEG = 17301504, L_PLEP = 18350080, L_SIZE = 18612224;
constexpr size_t W_FOXIN = 4 * L_SIZE, W_FOXOUT = W_FOXIN + 3407872, W_DILIN = W_FOXOUT + 1048576, W_DILOUT = W_DILIN + 5242880, W_DIFFIN = W_DILOUT + 1048576,
                 W_DIFFOUT = W_DIFFIN + 3145728, W_SGUIN = W_DIFFOUT + 1048576, W_SGUOUT = W_SGUIN + 4194304, W_TOTAL = W_SGUOUT + 2097152;
static_assert(WS_W + W_TOTAL * 2 <= WS_S1, "weights fit");

#ifndef PROBE_REP
#define PROBE_REP 0
#endif
constexpr unsigned BARMUL = (PROBE_REP == 9) ? 2u : 1u;
constexpr int NSLOTS = (PROBE_REP == 1) ? 11 : (PROBE_REP == 7 || PROBE_REP == 8) ? 10 : 9;
constexpr int LDS_BYTES = 139264;

__device__ __forceinline__ unsigned cvtpk(float lo, float hi) { f32x2 v = {lo, hi}; bf16x2_t b = __builtin_convertvector(v, bf16x2_t); return __builtin_bit_cast(unsigned, b); }
__device__ __forceinline__ float bf_lo(unsigned w) { return __uint_as_float(w << 16); }
__device__ __forceinline__ float bf_hi(unsigned w) { return __uint_as_float(w & 0xffff0000u); }
__device__ __forceinline__ float sx(float v, int o, int lane) { return __int_as_float(__builtin_amdgcn_ds_bpermute((lane ^ o) << 2, __float_as_int(v))); }
__device__ __forceinline__ float wave_sum(float v, int lane) {
#pragma unroll
    for (int o = 1; o < 64; o <<= 1) v += sx(v, o, lane);
    return v;
}
__device__ __forceinline__ float fast_exp2(float x) { return __builtin_amdgcn_exp2f(x); }
__device__ __forceinline__ float fast_rcp(float x) { return __builtin_amdgcn_rcpf(x); }
__device__ __forceinline__ float sigmoidf_(float x) { return fast_rcp(1.0f + fast_exp2(-x * LOG2E)); }

namespace pg8 {
constexpr int BM = 256, BK = 64, HALF = 128, HTB = HALF * BK * 2, STAGE_BYTES = 8 * HTB, NXCD = 8, WGM = 8;
__host__ __device__ __forceinline__ int lds_byte(int r, int c) { const int st = (r >> 4) * 2 + (c >> 5), rr = r & 15, cc = c & 31, ob = rr * 64 + cc * 2; return st * 1024 + (ob ^ (((ob >> 9) & 1) << 5)); }
__host__ __device__ __forceinline__ void stage_rc(int b, int& R, int& C) { const int st = b / 1024, sb = b % 1024, swz = sb ^ (((sb >> 9) & 1) << 5); R = (st >> 1) * 16 + swz / 64; C = (st & 1) * 32 + (swz % 64) / 2; }
__host__ __device__ __forceinline__ int perm32(int rho) { const int n = rho >> 4, i = rho & 15; return 8 * (i >> 2) + 4 * n + (i & 3); }
struct Unit { int pm, pn; };
struct Gemm { const bf16_t* A; const bf16_t* Bt; int M, N, K, lda; };
struct StaticOrder {
    int nM, nN, nwg, G, c;
    __device__ void init(int M, int N, int G_, int c_) { nM = M / BM; nN = N / BM; nwg = nM * nN; G = G_; c = c_; }
    __device__ bool next(int i, Unit& u) const {
        const long L = (long)i * G + c; if (L >= nwg) return false;
        int wgid = (int)L; { const int q = nwg / NXCD, r = nwg % NXCD, xcd = wgid % NXCD, off = wgid / NXCD; wgid = (xcd < r ? xcd * (q + 1) : r * (q + 1) + (xcd - r) * q) + off; }
        const int nig = WGM * nN, gid = wgid / nig, fm = gid * WGM, gsz = (nM - fm) < WGM ? (nM - fm) : WGM;
        u.pm = fm + ((wgid % nig) % gsz); u.pn = (wgid % nig) / gsz; return true;
    }
};
template <class Epi>
__device__ __forceinline__ void gemm_phase(LAS unsigned char* lds, const int tid, const Gemm g, const StaticOrder& S, const Epi& E) {
    const int wid = __builtin_amdgcn_readfirstlane(tid >> 6), lane = tid & 63, wr = wid >> 2, wc = wid & 3, fr = lane & 15, fq = lane >> 4;
    const int K = g.K, nt = K / BK, lda = g.lda;
    unsigned voffA[2], voffB[2];
#pragma unroll
    for (int i = 0; i < 2; ++i) { int R, C; stage_rc(tid * 16 + i * 8192, R, C); const int Rb = Epi::PERM ? ((R & ~31) + perm32(R & 31)) : R;
        voffA[i] = (unsigned)(R * lda + C) * 2u; voffB[i] = (unsigned)(Rb * K + C) * 2u; }
    const size_t kstep = (size_t)(BK * 2);
    const size_t hstepA = (size_t)HALF * lda * 2, hstepB = (size_t)HALF * K * 2;
    const size_t tstepA = 2 * hstepA, tstepB = 2 * hstepB;
    const unsigned ldsw = (unsigned)wid * 1024u;
    const int aoff = lds_byte(wr * 64 + fr, fq * 8), boff = lds_byte(wc * 32 + fr, fq * 8);
#define PG8_SA(b, h) (((b) * 2 + (h)) * HTB)
#define PG8_SB(b, h) ((4 + (b) * 2 + (h)) * HTB)
#define PG8_STAGE(bufoff, gbase, voff) do { _Pragma("unroll") for (int _i = 0; _i < 2; ++_i) \
        __builtin_amdgcn_global_load_lds((const unsigned*)((const char*)(gbase) + (voff)[_i]), (LAS unsigned*)(lds + (bufoff) + ldsw + _i * 8192), 16, 0, 0); } while (0)
#define PG8_LDA(dst, b, h) do { _Pragma("unroll") for (int m = 0; m < 4; ++m) _Pragma("unroll") for (int k = 0; k < 2; ++k) dst[m][k] = *(const LAS bf16x8*)(lds + PG8_SA(b, h) + aoff + m * 2048 + k * 1024); } while (0)
#define PG8_LDB(dst, b, h) do { _Pragma("unroll") for (int n = 0; n < 2; ++n) _Pragma("unroll") for (int k = 0; k < 2; ++k) dst[n][k] = *(const LAS bf16x8*)(lds + PG8_SB(b, h) + boff + n * 2048 + k * 1024); } while (0)
#define PG8_MMA(ai, bj, At, Bt) do { __builtin_amdgcn_s_setprio(1); _Pragma("unroll") for (int m = 0; m < 4; ++m) _Pragma("unroll") for (int n = 0; n < 2; ++n) _Pragma("unroll") for (int k = 0; k < 2; ++k) \
        acc[ai][bj][m][n] = __builtin_amdgcn_mfma_f32_16x16x32_bf16(Bt[n][k], At[m][k], acc[ai][bj][m][n], 0, 0, 0); __builtin_amdgcn_s_setprio(0); } while (0)
#define PG8_WAIT_V(n) asm volatile("s_waitcnt vmcnt(" #n ")" ::: "memory")
#define PG8_WAIT_L(n) asm volatile("s_waitcnt lgkmcnt(" #n ")" ::: "memory")
#define PG8_BAR __builtin_amdgcn_s_barrier()
#define PG8_SCHED __builtin_amdgcn_sched_barrier(0)
    Unit cur, nxt; int ui = 0;
    if (!S.next(0, cur)) return;
    f32x4 acc[2][2][4][2];
#pragma unroll
    for (int a = 0; a < 2; ++a)
#pragma unroll
        for (int b = 0; b < 2; ++b)
#pragma unroll
            for (int m = 0; m < 4; ++m)
#pragma unroll
                for (int n = 0; n < 2; ++n) acc[a][b][m][n] = (f32x4){0.f, 0.f, 0.f, 0.f};
    bf16x8 At[4][2], B0[2][2], B1[2][2];
    const char* cA = (const char*)g.A + (size_t)cur.pm * tstepA; const char* cB = (const char*)g.Bt + (size_t)cur.pn * tstepB;
    PG8_STAGE(PG8_SB(0, 0), cB, voffB); PG8_STAGE(PG8_SB(0, 1), cB + hstepB, voffB); PG8_STAGE(PG8_SA(0, 0), cA, voffA); PG8_STAGE(PG8_SA(0, 1), cA + hstepA, voffA);
    if (wr == 1) PG8_BAR;
    PG8_WAIT_V(2); PG8_BAR;
    PG8_STAGE(PG8_SB(1, 0), cB + kstep, voffB); PG8_STAGE(PG8_SA(1, 0), cA + kstep, voffA); PG8_STAGE(PG8_SB(1, 1), cB + hstepB + kstep, voffB);
    PG8_WAIT_V(6); PG8_BAR;
    for (;;) {
        const bool has_next = S.next(ui + 1, nxt);
        const char* nA = has_next ? (const char*)g.A + (size_t)nxt.pm * tstepA : cA; const char* nB = has_next ? (const char*)g.Bt + (size_t)nxt.pn * tstepB : cB;
        for (int t = 0; t < nt; t += 2) {
            const bool last = (t == nt - 2);
            const char* a1 = cA + (size_t)(t + 1) * kstep;
            const char* a2 = last ? nA : cA + (size_t)(t + 2) * kstep; const char* b2 = last ? nB : cB + (size_t)(t + 2) * kstep;
            const char* a3 = a2 + kstep; const char* b3 = b2 + kstep;
            PG8_LDB(B0, 0, 0); PG8_LDB(B1, 0, 1); PG8_SCHED; PG8_LDA(At, 0, 0); PG8_STAGE(PG8_SA(1, 1), a1 + hstepA, voffA);
            PG8_WAIT_V(8); PG8_WAIT_L(0); PG8_BAR; PG8_MMA(0, 0, At, B0); PG8_MMA(0, 1, At, B1); PG8_BAR; PG8_SCHED;
            PG8_LDA(At, 0, 1); PG8_STAGE(PG8_SB(0, 0), b2, voffB); PG8_STAGE(PG8_SB(0, 1), b2 + hstepB, voffB); PG8_STAGE(PG8_SA(0, 0), a2, voffA);
            PG8_WAIT_V(8); PG8_WAIT_L(0); PG8_BAR; PG8_MMA(1, 0, At, B0); PG8_MMA(1, 1, At, B1); PG8_BAR; PG8_SCHED;
            PG8_LDB(B0, 1, 0); PG8_LDB(B1, 1, 1); PG8_SCHED; PG8_LDA(At, 1, 0); PG8_STAGE(PG8_SA(0, 1), a2 + hstepA, voffA);
            PG8_WAIT_V(8); PG8_WAIT_L(0); PG8_BAR; PG8_MMA(0, 0, At, B0); PG8_MMA(0, 1, At, B1); PG8_BAR; PG8_SCHED;
            PG8_LDA(At, 1, 1); PG8_STAGE(PG8_SB(1, 0), b3, voffB); PG8_STAGE(PG8_SB(1, 1), b3 + hstepB, voffB); PG8_STAGE(PG8_SA(1, 0), a3, voffA);
            PG8_WAIT_V(8); PG8_WAIT_L(0); PG8_BAR; PG8_MMA(1, 0, At, B0); PG8_MMA(1, 1, At, B1); PG8_BAR; PG8_SCHED;
        }
        if (wr == 0) PG8_BAR;
        E(acc, cur, wr, wc, fr, fq);
        if (!has_next) break;
#pragma unroll
        for (int a = 0; a < 2; ++a)
#pragma unroll
            for (int b = 0; b < 2; ++b)
#pragma unroll
                for (int m = 0; m < 4; ++m)
#pragma unroll
                    for (int n = 0; n < 2; ++n) acc[a][b][m][n] = (f32x4){0.f, 0.f, 0.f, 0.f};
        cur = nxt; cA = nA; cB = nB; ++ui;
        if (wr == 1) PG8_BAR;
    }
    PG8_WAIT_V(0);
    PG8_BAR;
#undef PG8_SA
#undef PG8_SB
#undef PG8_STAGE
#undef PG8_LDA
#undef PG8_LDB
#undef PG8_MMA
#undef PG8_WAIT_V
#undef PG8_WAIT_L
#undef PG8_BAR
#undef PG8_SCHED
}
}
using pg8::Unit;

__device__ __forceinline__ void row_rstd8(const float* ssq, int row0, int fq, int lane, float (&rs)[8]) {
#pragma unroll
    for (int ai = 0; ai < 2; ++ai)
#pragma unroll
        for (int m = 0; m < 4; ++m) {
            const f32x4 v = *(const f32x4*)(ssq + (size_t)(row0 + 128 * ai + 16 * m) * 16 + 4 * fq);
            float s = (v[0] + v[1]) + (v[2] + v[3]); s += sx(s, 16, lane); s += sx(s, 32, lane);
            rs[ai * 4 + m] = 1.0f / sqrtf(s * (1.0f / DM) + NORM_EPS);
        }
}
__device__ __forceinline__ float gelu_erf(float v) {
    const float av = fabsf(v), t = fast_rcp(av * 0.2316418882f + 1.0f);
    float q = t * 0.5307027145f + (-0.7265760135f); q = q * t + 0.7107068705f; q = q * t + (-0.142248368f); q = q * t + 0.127414796f; q = q * t;
    const float e = fast_exp2((v * v) * (-0.72134752044f));
    const float m = v * (q * e);
    return v < 0.f ? m : v - m;
}

struct EpiSwiglu {
    static constexpr bool PERM = true;
    const float* ssq; bf16_t* H;
    __device__ __forceinline__ void operator()(const f32x4 (&acc)[2][2][4][2], const Unit& u, int wr, int wc, int fr_, int fq_) const {
        (void)fr_; (void)fq_; unsigned o_ = ~0u; asm volatile("" : "+s"(o_)); const int lane = (int)__builtin_amdgcn_mbcnt_hi(o_, __builtin_amdgcn_mbcnt_lo(o_, 0u)); const int fr = lane & 15, fq = lane >> 4;
        const int row0 = u.pm * 256 + wr * 64 + fr, col0 = u.pn * 128 + wc * 32 + 8 * fq;
        float rs[8]; row_rstd8(ssq, row0, fq, fq * 16 + fr, rs);
#pragma unroll
        for (int ai = 0; ai < 2; ++ai)
#pragma unroll
            for (int m = 0; m < 4; ++m) {
                const float r = rs[ai * 4 + m]; float o[8];
#pragma unroll
                for (int n = 0; n < 2; ++n)
#pragma unroll
                    for (int i = 0; i < 4; ++i) { const float gt = acc[ai][0][m][n][i] * r, up = acc[ai][1][m][n][i] * r; o[n * 4 + i] = gt * sigmoidf_(gt) * up; }
                u32x4 w; w.x = cvtpk(o[0], o[1]); w.y = cvtpk(o[2], o[3]); w.z = cvtpk(o[4], o[5]); w.w = cvtpk(o[6], o[7]);
                *(u32x4*)(H + (size_t)(row0 + 128 * ai + 16 * m) * DFF + col0) = w;
            }
    }
};
struct EpiResid {
    static constexpr bool PERM = false;
    const float* base; float* out; bf16_t* hb; float* ssq; float scale;
    __device__ __forceinline__ void operator()(const f32x4 (&acc)[2][2][4][2], const Unit& u, int wr, int wc, int fr_, int fq_) const {
        (void)fr_; (void)fq_; unsigned o_ = ~0u; asm volatile("" : "+s"(o_)); const int lane = (int)__builtin_amdgcn_mbcnt_hi(o_, __builtin_amdgcn_mbcnt_lo(o_, 0u)); const int fr = lane & 15, fq = lane >> 4;
        const int row0 = u.pm * 256 + wr * 64 + fr, col0 = u.pn * 256 + wc * 32 + 4 * fq;
#pragma unroll
        for (int ai = 0; ai < 2; ++ai) {
            f32x4 bs[4][2][2];
#pragma unroll
            for (int m = 0; m < 4; ++m)
#pragma unroll
                for (int bj = 0; bj < 2; ++bj)
#pragma unroll
                    for (int n = 0; n < 2; ++n) bs[m][bj][n] = *(const f32x4*)(base + (size_t)(row0 + 128 * ai + 16 * m) * DM + col0 + bj * 128 + n * 16);
            asm volatile("" ::: "memory");
#pragma unroll
            for (int m = 0; m < 4; ++m) {
                const int row = row0 + 128 * ai + 16 * m; const size_t off = (size_t)row * DM + col0; float ss = 0.f;
#pragma unroll
                for (int bj = 0; bj < 2; ++bj)
#pragma unroll
                    for (int n = 0; n < 2; ++n) {
                        const size_t o2 = off + bj * 128 + n * 16;
                        const f32x4 o = bs[m][bj][n] + acc[ai][bj][m][n] * scale;
                        *(f32x4*)(out + o2) = o; ss += (o[0] * o[0] + o[1] * o[1]) + (o[2] * o[2] + o[3] * o[3]);
                        u32x2 w; w.x = cvtpk(o[0], o[1]); w.y = cvtpk(o[2], o[3]); *(u32x2*)(hb + o2) = w;
                    }
                ss += sx(ss, 16, lane); ss += sx(ss, 32, lane);
                if (fq == 0) ssq[(size_t)row * 16 + u.pn * 4 + wc] = ss;
            }
            asm volatile("" ::: "memory");
        }
    }
};
struct EpiPleGate {
    static constexpr bool PERM = false;
    const float* ssq_in; const float* h; float* hout; bf16_t* hb; float* ssq_out; const float* bg; const bf16_t* pp;
    __device__ __forceinline__ void operator()(const f32x4 (&acc)[2][2][4][2], const Unit& u, int wr, int wc, int fr_, int fq_) const {
        (void)fr_; (void)fq_; unsigned o_ = ~0u; asm volatile("" : "+s"(o_)); const int lane = (int)__builtin_amdgcn_mbcnt_hi(o_, __builtin_amdgcn_mbcnt_lo(o_, 0u)); const int fr = lane & 15, fq = lane >> 4;
        const int row0 = u.pm * 256 + wr * 64 + fr, col0 = u.pn * 256 + wc * 32 + 4 * fq;
        float rs[8]; row_rstd8(ssq_in, row0, fq, lane, rs);
#pragma unroll
        for (int ai = 0; ai < 2; ++ai)
#pragma unroll
        for (int mp = 0; mp < 2; ++mp) {
            f32x4 bs[2][2][2]; u32x2 pw[2][2][2];
#pragma unroll
            for (int mm = 0; mm < 2; ++mm)
#pragma unroll
                for (int bj = 0; bj < 2; ++bj)
#pragma unroll
                    for (int n = 0; n < 2; ++n) { const size_t o2 = (size_t)(row0 + 128 * ai + 16 * (2 * mp + mm)) * DM + col0 + bj * 128 + n * 16; bs[mm][bj][n] = *(const f32x4*)(h + o2); pw[mm][bj][n] = *(const u32x2*)(pp + o2); }
            asm volatile("" ::: "memory");
#pragma unroll
            for (int mm = 0; mm < 2; ++mm) {
                const int m = 2 * mp + mm;
                const int row = row0 + 128 * ai + 16 * m; const size_t off = (size_t)row * DM + col0; float ss = 0.f; const float r = rs[ai * 4 + m];
#pragma unroll
                for (int bj = 0; bj < 2; ++bj)
#pragma unroll
                    for (int n = 0; n < 2; ++n) {
                        const size_t o2 = off + bj * 128 + n * 16; const f32x4 b = bs[mm][bj][n]; const u32x2 p2 = pw[mm][bj][n];
                        const f32x4 bbv = *(const f32x4*)(bg + col0 + bj * 128 + n * 16);
                        f32x4 o;
                        o[0] = b[0] + sigmoidf_(acc[ai][bj][m][n][0] * r + bbv[0]) * bf_lo(p2.x);
                        o[1] = b[1] + sigmoidf_(acc[ai][bj][m][n][1] * r + bbv[1]) * bf_hi(p2.x);
                        o[2] = b[2] + sigmoidf_(acc[ai][bj][m][n][2] * r + bbv[2]) * bf_lo(p2.y);
                        o[3] = b[3] + sigmoidf_(acc[ai][bj][m][n][3] * r + bbv[3]) * bf_hi(p2.y);
                        *(f32x4*)(hout + o2) = o; ss += (o[0] * o[0] + o[1] * o[1]) + (o[2] * o[2] + o[3] * o[3]);
                        u32x2 w; w.x = cvtpk(o[0], o[1]); w.y = cvtpk(o[2], o[3]); *(u32x2*)(hb + o2) = w;
                    }
                ss += sx(ss, 16, lane); ss += sx(ss, 32, lane);
                if (fq == 0) ssq_out[(size_t)row * 16 + u.pn * 4 + wc] = ss;
            }
            asm volatile("" ::: "memory");
        }
    }
};
struct EpiBf16 {
    static constexpr bool PERM = true;
    bf16_t* O; int ldo;
    __device__ __forceinline__ void operator()(const f32x4 (&acc)[2][2][4][2], const Unit& u, int wr, int wc, int fr_, int fq_) const {
        (void)fr_; (void)fq_; unsigned o_ = ~0u; asm volatile("" : "+s"(o_)); const int lane = (int)__builtin_amdgcn_mbcnt_hi(o_, __builtin_amdgcn_mbcnt_lo(o_, 0u)); const int fr = lane & 15, fq = lane >> 4;
        const int row0 = u.pm * 256 + wr * 64 + fr, col0 = u.pn * 256 + wc * 32 + 8 * fq;
#pragma unroll
        for (int ai = 0; ai < 2; ++ai)
#pragma unroll
            for (int m = 0; m < 4; ++m)
#pragma unroll
                for (int bj = 0; bj < 2; ++bj) {
                    const f32x4 v0 = acc[ai][bj][m][0], v1 = acc[ai][bj][m][1];
                    u32x4 w; w.x = cvtpk(v0[0], v0[1]); w.y = cvtpk(v0[2], v0[3]); w.z = cvtpk(v1[0], v1[1]); w.w = cvtpk(v1[2], v1[3]);
                    *(u32x4*)(O + (size_t)(row0 + 128 * ai + 16 * m) * ldo + col0 + bj * 128) = w;
                }
    }
};
struct EpiQkv {
    static constexpr bool PERM = true;
    const float* ssq; bf16_t* O; int ldo; int qs_end, rope_end, fg_tile; const f32x2* rope; const float* bf; float* flog;
    __device__ __forceinline__ void operator()(const f32x4 (&acc)[2][2][4][2], const Unit& u, int wr, int wc, int fr_, int fq_) const {
        (void)fr_; (void)fq_; unsigned o_ = ~0u; asm volatile("" : "+s"(o_)); const int lane = (int)__builtin_amdgcn_mbcnt_hi(o_, __builtin_amdgcn_mbcnt_lo(o_, 0u)); const int fr = lane & 15, fq = lane >> 4;
        const int row0 = u.pm * 256 + wr * 64 + fr, colt = u.pn * 256;
        float rs[8]; row_rstd8(ssq, row0, fq, fq * 16 + fr, rs);
        if (u.pn == fg_tile) {
            if (wc == 0 && fq < 2) {
                const f32x4 b0 = *(const f32x4*)(bf + 8 * fq), b1 = *(const f32x4*)(bf + 8 * fq + 4);
#pragma unroll
                for (int ai = 0; ai < 2; ++ai)
#pragma unroll
                    for (int m = 0; m < 4; ++m) {
                        const float r = rs[ai * 4 + m]; f32x4 o0, o1;
#pragma unroll
                        for (int i = 0; i < 4; ++i) {
                            const float x0 = acc[ai][0][m][0][i] * r + b0[i], x1 = acc[ai][0][m][1][i] * r + b1[i];
                            o0[i] = fminf(x0, 0.f) - logf(1.0f + expf(-fabsf(x0))); o1[i] = fminf(x1, 0.f) - logf(1.0f + expf(-fabsf(x1)));
                        }
                        float* p = flog + (size_t)(row0 + 128 * ai + 16 * m) * 16 + 8 * fq;
                        *(f32x4*)p = o0; *(f32x4*)(p + 4) = o1;
                    }
            }
            return;
        }
        const float sc = colt < qs_end ? QSCALE : 1.0f;
        const bool do_rope = (colt < rope_end) && ((wc & 1) == 0);
        const float sgn = fq == 0 ? -1.0f : 1.0f;
#pragma unroll
        for (int ai = 0; ai < 2; ++ai)
#pragma unroll
            for (int m = 0; m < 4; ++m) {
                const int row = row0 + 128 * ai + 16 * m; const float r = rs[ai * 4 + m] * sc;
                f32x4 cs[4];
                if (do_rope) { const f32x4* tp = (const f32x4*)(rope + (size_t)(row & (SEQ - 1)) * 8);
#pragma unroll
                    for (int j = 0; j < 4; ++j) cs[j] = tp[j]; }
#pragma unroll
                for (int bj = 0; bj < 2; ++bj) {
                    f32x4 v0 = acc[ai][bj][m][0] * r, v1 = acc[ai][bj][m][1] * r;
                    if (do_rope) {
                        f32x4 p0, p1;
#pragma unroll
                        for (int i = 0; i < 4; ++i) { p0[i] = sx(v0[i], 16, lane); p1[i] = sx(v1[i], 16, lane); }
                        if (fq < 2) {
                            v0[0] = v0[0] * cs[0][0] + sgn * p0[0] * cs[0][1]; v0[1] = v0[1] * cs[0][2] + sgn * p0[1] * cs[0][3];
                            v0[2] = v0[2] * cs[1][0] + sgn * p0[2] * cs[1][1]; v0[3] = v0[3] * cs[1][2] + sgn * p0[3] * cs[1][3];
                            v1[0] = v1[0] * cs[2][0] + sgn * p1[0] * cs[2][1]; v1[1] = v1[1] * cs[2][2] + sgn * p1[1] * cs[2][3];
                            v1[2] = v1[2] * cs[3][0] + sgn * p1[2] * cs[3][1]; v1[3] = v1[3] * cs[3][2] + sgn * p1[3] * cs[3][3];
                        }
                    }
                    u32x4 w; w.x = cvtpk(v0[0], v0[1]); w.y = cvtpk(v0[2], v0[3]); w.z = cvtpk(v1[0], v1[1]); w.w = cvtpk(v1[2], v1[3]);
                    *(u32x4*)(O + (size_t)row * ldo + colt + bj * 128 + wc * 32 + 8 * fq) = w;
                }
            }
    }
};
struct EpiSguIn {
    static constexpr bool PERM = true;
    const float* ssq; bf16_t* O; float* ssqv;
    __device__ __forceinline__ void operator()(const f32x4 (&acc)[2][2][4][2], const Unit& u, int wr, int wc, int fr_, int fq_) const {
        (void)fr_; (void)fq_; unsigned o_ = ~0u; asm volatile("" : "+s"(o_)); const int lane = (int)__builtin_amdgcn_mbcnt_hi(o_, __builtin_amdgcn_mbcnt_lo(o_, 0u)); const int fr = lane & 15, fq = lane >> 4;
        const int row0 = u.pm * 256 + wr * 64 + fr, col0 = u.pn * 256 + wc * 32 + 8 * fq;
        float rs[8]; row_rstd8(ssq, row0, fq, fq * 16 + fr, rs);
#pragma unroll
        for (int ai = 0; ai < 2; ++ai)
#pragma unroll
            for (int m = 0; m < 4; ++m) {
                const int row = row0 + 128 * ai + 16 * m; const float r = rs[ai * 4 + m]; float ss = 0.f;
#pragma unroll
                for (int bj = 0; bj < 2; ++bj) {
                    float o[8];
#pragma unroll
                    for (int n = 0; n < 2; ++n)
#pragma unroll
                        for (int i = 0; i < 4; ++i) { const float gv = gelu_erf(acc[ai][bj][m][n][i] * r); o[n * 4 + i] = gv; ss += gv * gv; }
                    u32x4 w; w.x = cvtpk(o[0], o[1]); w.y = cvtpk(o[2], o[3]); w.z = cvtpk(o[4], o[5]); w.w = cvtpk(o[6], o[7]);
                    *(u32x4*)(O + (size_t)row * 4096 + col0 + bj * 128) = w;
                }
                if (u.pn >= 8) { ss += sx(ss, 16, lane); ss += sx(ss, 32, lane); if (fq == 0) ssqv[(size_t)row * 32 + (u.pn - 8) * 4 + wc] = ss; }
            }
    }
};

struct AttnJob {
    const bf16_t* Q; const bf16_t* K; const bf16_t* V; bf16_t* O;
    long pitch, opitch;
    const float* bias; int bstride;
    float* lse; int lstride;
    int q0, window;
};
constexpr int A_K = 0, A_V = 18432, A_B = 34816, A_WS = 35328, A_OST = 40960;
__device__ __forceinline__ int crow(int r, int hi) { return (r & 3) + 8 * (r >> 2) + 4 * hi; }

__device__ __forceinline__ void attn_unit(LAS unsigned char* lds, const int tid, const AttnJob& J) {
    const int lane = tid & 63, r32 = lane & 31, hi = lane >> 5; const int wid = __builtin_amdgcn_readfirstlane(tid >> 6);
    const int q0 = J.q0, W = J.window;
    const int t_lo = (q0 - W > 0 ? q0 - W : 0) >> 6, t_hi = (q0 + 255) >> 6, nt = t_hi - t_lo + 1;
    const int qw = q0 + 32 * wid;
    const int tw_lo = (qw - W > 0 ? qw - W : 0) >> 6, tw_hi = (qw + 31) >> 6;
    const int qrow = qw + r32;
    bf16x8 qr[4];
    { const bf16_t* qp = J.Q + (long)qrow * J.pitch + hi * 8;
#pragma unroll
      for (int d0 = 0; d0 < 4; ++d0) qr[d0] = *(const bf16x8*)(qp + d0 * 16); }
    const int srow = tid >> 3, sch = tid & 7;
    const bf16_t* kg = J.K + (long)srow * J.pitch + sch * 8; const bf16_t* vg = J.V + (long)srow * J.pitch + sch * 8;
    const long tstride = 64 * J.pitch;
    const int kdst = A_K + srow * 144 + sch * 16, vdst = A_V + (srow >> 2) * 512 + (sch >> 2) * 256 + (srow & 3) * 64 + (sch & 3) * 16;
    LAS float* wsf = (LAS float*)(lds + A_WS) + wid * 64;
    u32x4 kreg, vreg; float breg = 0.f;
    kreg = *(const u32x4*)(kg + (long)t_lo * tstride); vreg = *(const u32x4*)(vg + (long)t_lo * tstride);
    if (J.bias && tid < 64) breg = J.bias[(long)(t_lo * 64 + tid) * J.bstride];
    *(LAS u32x4*)(lds + kdst) = kreg; *(LAS u32x4*)(lds + vdst) = vreg; if (J.bias && tid < 64) *(LAS float*)(lds + A_B + tid * 4) = breg;
    __syncthreads();
    float m_run = -1e30f, l_run = 0.f; f32x16 o0 = {}, o1 = {};
    const int g16 = (lane >> 4) & 1, i16 = lane & 15;
    const int vrd = A_V + hi * 512 + (i16 >> 2) * 64 + g16 * 32 + (i16 & 3) * 8;
    for (int it = 0; it < nt; ++it) {
        const int t = t_lo + it, cur = it & 1;
        if (it + 1 < nt) { kreg = *(const u32x4*)(kg + (long)(t + 1) * tstride); vreg = *(const u32x4*)(vg + (long)(t + 1) * tstride);
            if (J.bias && tid < 64) breg = J.bias[(long)((t + 1) * 64 + tid) * J.bstride]; }
        if (t >= tw_lo && t <= tw_hi) {
            const LAS unsigned char* Kb = lds + A_K + cur * 9216; const LAS unsigned char* Vb = lds + cur * 8192;
            f32x16 p0 = {}, p1 = {};
#pragma unroll
            for (int d0 = 0; d0 < 4; ++d0) {
                const bf16x8 k0 = *(const LAS bf16x8*)(Kb + r32 * 144 + d0 * 32 + hi * 16);
                const bf16x8 k1 = *(const LAS bf16x8*)(Kb + (32 + r32) * 144 + d0 * 32 + hi * 16);
                p0 = __builtin_amdgcn_mfma_f32_32x32x16_bf16(k0, qr[d0], p0, 0, 0, 0);
                p1 = __builtin_amdgcn_mfma_f32_32x32x16_bf16(k1, qr[d0], p1, 0, 0, 0);
            }
            if (J.bias) {
                const LAS float* bb = (const LAS float*)(lds + A_B + cur * 256);
#pragma unroll
                for (int g = 0; g < 4; ++g) { const f32x4 b0 = *(const LAS f32x4*)(bb + 8 * g + 4 * hi), b1 = *(const LAS f32x4*)(bb + 32 + 8 * g + 4 * hi);
#pragma unroll
                    for (int i = 0; i < 4; ++i) { p0[4 * g + i] -= b0[i]; p1[4 * g + i] -= b1[i]; } }
            }
            const int kv0 = t * 64;
            const bool need_mask = (kv0 + 63 > qw) || (qw + 31 - kv0 > W);
            if (need_mask) {
#pragma unroll
                for (int r = 0; r < 16; ++r) { const int kv = kv0 + crow(r, hi);
                    if (kv > qrow || qrow - kv > W) p0[r] = -INFINITY;
                    if (kv + 32 > qrow || qrow - kv - 32 > W) p1[r] = -INFINITY; }
            }
            float mx = fmaxf(p0[0], p1[0]);
#pragma unroll
            for (int r = 1; r < 16; ++r) mx = fmaxf(mx, fmaxf(p0[r], p1[r]));
            mx = fmaxf(mx, sx(mx, 32, lane));
            const float m_new = fmaxf(m_run, mx), alpha = fast_exp2(m_run - m_new); m_run = m_new;
            float ls = 0.f;
#pragma unroll
            for (int r = 0; r < 16; ++r) { p0[r] = fast_exp2(p0[r] - m_new); p1[r] = fast_exp2(p1[r] - m_new); ls += p0[r] + p1[r]; }
            l_run = l_run * alpha + ls;
            if (__any(alpha != 1.0f)) {
                if (hi == 0) wsf[r32] = alpha;
#pragma unroll
                for (int g = 0; g < 4; ++g) { const f32x4 a = *(const LAS f32x4*)(wsf + 8 * g + 4 * hi);
#pragma unroll
                    for (int i = 0; i < 4; ++i) { o0[4 * g + i] *= a[i]; o1[4 * g + i] *= a[i]; } }
            }
            bf16x8 pa[4];
#pragma unroll
            for (int s = 0; s < 2; ++s) {
                u32x4 w0, w1;
                w0.x = cvtpk(p0[8 * s + 0], p0[8 * s + 1]); w0.y = cvtpk(p0[8 * s + 2], p0[8 * s + 3]); w0.z = cvtpk(p0[8 * s + 4], p0[8 * s + 5]); w0.w = cvtpk(p0[8 * s + 6], p0[8 * s + 7]);
                w1.x = cvtpk(p1[8 * s + 0], p1[8 * s + 1]); w1.y = cvtpk(p1[8 * s + 2], p1[8 * s + 3]); w1.z = cvtpk(p1[8 * s + 4], p1[8 * s + 5]); w1.w = cvtpk(p1[8 * s + 6], p1[8 * s + 7]);
                pa[s] = __builtin_bit_cast(bf16x8, w0); pa[2 + s] = __builtin_bit_cast(bf16x8, w1);
            }
#pragma unroll
            for (int s = 0; s < 4; ++s) {
#pragma unroll
                for (int db = 0; db < 2; ++db) {
                    const LAS unsigned char* vp = lds + vrd + cur * 8192 + s * 2048 + db * 256;
                    const s16x4 lo = __builtin_bit_cast(s16x4, __builtin_amdgcn_ds_read_tr16_b64_v4i16((LAS s16x4*)vp));
                    const s16x4 hh = __builtin_bit_cast(s16x4, __builtin_amdgcn_ds_read_tr16_b64_v4i16((LAS s16x4*)(vp + 1024)));
                    const bf16x8 vf = (bf16x8){lo[0], lo[1], lo[2], lo[3], hh[0], hh[1], hh[2], hh[3]};
                    if (db == 0) o0 = __builtin_amdgcn_mfma_f32_32x32x16_bf16(pa[s], vf, o0, 0, 0, 0);
                    else         o1 = __builtin_amdgcn_mfma_f32_32x32x16_bf16(pa[s], vf, o1, 0, 0, 0);
                }
            }
            (void)Vb;
        }
        if (it + 1 < nt) { const int nb = cur ^ 1;
            *(LAS u32x4*)(lds + kdst + nb * 9216) = kreg; *(LAS u32x4*)(lds + vdst + nb * 8192) = vreg; if (J.bias && tid < 64) *(LAS float*)(lds + A_B + nb * 256 + tid * 4) = breg; }
        __syncthreads();
    }
    const float l_tot = l_run + sx(l_run, 32, lane);
    if (J.lse && hi == 0) J.lse[(long)qrow * J.lstride] = (m_run + log2f(l_tot)) * LN2;
    if (hi == 0) wsf[r32] = 1.0f / l_tot;
    LAS bf16_t* stg = (LAS bf16_t*)(lds + A_OST) + wid * 2048;
#pragma unroll
    for (int g = 0; g < 4; ++g) { const f32x4 a = *(const LAS f32x4*)(wsf + 8 * g + 4 * hi);
#pragma unroll
        for (int i = 0; i < 4; ++i) { const int orow = 8 * g + 4 * hi + i;
            stg[orow * 64 + r32] = (bf16_t)(cvtpk(o0[4 * g + i] * a[i], 0.f) & 0xffffu);
            stg[orow * 64 + 32 + r32] = (bf16_t)(cvtpk(o1[4 * g + i] * a[i], 0.f) & 0xffffu); } }
    bf16_t* Ow = J.O + (long)qw * J.opitch;
#pragma unroll
    for (int i = 0; i < 4; ++i) { const int row = i * 8 + (lane >> 3), ch = lane & 7; const u32x4 v = *(const LAS u32x4*)(stg + row * 64 + ch * 8); *(u32x4*)(Ow + (long)row * J.opitch + ch * 8) = v; }
    __syncthreads();
}

__device__ __forceinline__ void grid_bar(unsigned* bw, unsigned G, int tid, unsigned k) {
    asm volatile("s_waitcnt vmcnt(0)" ::: "memory");
    __syncthreads();
    if (tid == 0) {
        __builtin_amdgcn_fence(__ATOMIC_RELEASE, "agent");
        asm volatile("s_waitcnt vmcnt(0)" ::: "memory");
        const unsigned old = __hip_atomic_fetch_add(bw, 1u, __ATOMIC_RELAXED, __HIP_MEMORY_SCOPE_AGENT);
        if (old + 1u == G * (k + 1u)) __hip_atomic_store(bw + 64, k + 1u, __ATOMIC_RELAXED, __HIP_MEMORY_SCOPE_AGENT);
        else { unsigned sp = 0; while (__hip_atomic_load(bw + 64, __ATOMIC_RELAXED, __HIP_MEMORY_SCOPE_AGENT) <= k) { __builtin_amdgcn_s_sleep(1); if (++sp > (1u << 27)) break; } }
        __builtin_amdgcn_fence(__ATOMIC_ACQUIRE, "agent");
        asm volatile("s_waitcnt vmcnt(0)" ::: "memory");
    }
    __syncthreads();
}

struct Args {
    const float *x, *p, *norm_ffn1, *w_ffn1_in, *w_ffn1_out, *norm_mix, *norm_ffn2, *w_ffn2_in, *w_ffn2_out, *norm_ple, *w_ple_gate, *b_ple_gate, *w_ple_proj,
        *fox_w_in, *fox_b_f, *fox_w_out, *dil_w_in, *dil_w_out, *diff_w_in, *diff_lambda, *diff_subln, *diff_w_out, *sgu_w_in, *sgu_norm_v, *sgu_w_s, *sgu_b_s, *sgu_w_out, *norm_final;
    float* out; unsigned char* ws;
};

__device__ __forceinline__ void transpose_item(const float* W, int K, int N, bf16_t* WT, const float* gain, int mode, LAS float* scr, int item, int lane) {
    const int nblk = (N + 31) / 32, kb = item / nblk, nb = item % nblk, k0 = 64 * kb, n0 = 32 * nb;
    const int ncol = n0 + (lane & 31); const bool okc = ncol < N;
    float vv[32];
#pragma unroll
    for (int i = 0; i < 32; ++i) { const int kk = 2 * i + (lane >> 5); vv[i] = okc ? W[(size_t)(k0 + kk) * N + ncol] : 0.f; }
    if (gain) {
#pragma unroll
        for (int i = 0; i < 32; ++i) vv[i] *= gain[k0 + 2 * i + (lane >> 5)];
    }
#pragma unroll
    for (int i = 0; i < 32; ++i) scr[(2 * i + (lane >> 5)) * 33 + (lane & 31)] = vv[i];
    asm volatile("s_waitcnt lgkmcnt(0)" ::: "memory");
    int d0 = n0;
    if (mode == 1) { if (n0 < DFF) d0 = (n0 / 128) * 256 + (n0 % 128); else { const int mm = n0 - DFF; d0 = (mm / 128) * 256 + 128 + (mm % 128); } }
    const int c = lane & 7;
#pragma unroll
    for (int j = 0; j < 4; ++j) { const int n = (lane >> 3) + 8 * j; const LAS float* s = scr + (8 * c) * 33 + n;
        u32x4 o; o.x = cvtpk(s[0 * 33], s[1 * 33]); o.y = cvtpk(s[2 * 33], s[3 * 33]); o.z = cvtpk(s[4 * 33], s[5 * 33]); o.w = cvtpk(s[6 * 33], s[7 * 33]);
        *(u32x4*)(WT + (size_t)(d0 + n) * K + k0 + 8 * c) = o; }
    asm volatile("s_waitcnt lgkmcnt(0)" ::: "memory");
}

__device__ __forceinline__ void get_mat(const Args& a, bf16_t* Wt, int mi, const float*& src, int& K, int& N, bf16_t*& dst, const float*& gain, int& mode) {
    gain = nullptr; mode = 0;
    if (mi < 24) {
        const int L = mi / 6, k = mi % 6; bf16_t* wl = Wt + (size_t)L * L_SIZE;
        if (k == 0)      { src = a.w_ffn1_in + (size_t)L * DM * 2 * DFF; K = DM; N = 2 * DFF; dst = wl + L_FFN1IN; gain = a.norm_ffn1 + L * DM; mode = 1; }
        else if (k == 1) { src = a.w_ffn1_out + (size_t)L * DFF * DM; K = DFF; N = DM; dst = wl + L_FFN1OUT; }
        else if (k == 2) { src = a.w_ffn2_in + (size_t)L * DM * 2 * DFF; K = DM; N = 2 * DFF; dst = wl + L_FFN2IN; gain = a.norm_ffn2 + L * DM; mode = 1; }
        else if (k == 3) { src = a.w_ffn2_out + (size_t)L * DFF * DM; K = DFF; N = DM; dst = wl + L_FFN2OUT; }
        else if (k == 4) { src = a.w_ple_gate + (size_t)L * DM * DM; K = DM; N = DM; dst = wl + L_PLEG; gain = a.norm_ple + L * DM; }
        else             { src = a.w_ple_proj + (size_t)L * PLE * DM; K = PLE; N = DM; dst = wl + L_PLEP; }
    } else {
        const int k = mi - 24;
        if (k == 0)      { src = a.fox_w_in; K = DM; N = 3 * DM + 16; dst = Wt + W_FOXIN; gain = a.norm_mix; }
        else if (k == 1) { src = a.fox_w_out; K = DM; N = DM; dst = Wt + W_FOXOUT; }
        else if (k == 2) { src = a.dil_w_in; K = DM; N = 5 * DM; dst = Wt + W_DILIN; gain = a.norm_mix + DM; }
        else if (k == 3) { src = a.dil_w_out; K = DM; N = DM; dst = Wt + W_DILOUT; }
        else if (k == 4) { src = a.diff_w_in; K = DM; N = 3 * DM; dst = Wt + W_DIFFIN; gain = a.norm_mix + 2 * DM; }
        else if (k == 5) { src = a.diff_w_out; K = DM; N = DM; dst = Wt + W_DIFFOUT; }
        else if (k == 6) { src = a.sgu_w_in; K = DM; N = 4 * DM; dst = Wt + W_SGUIN; gain = a.norm_mix + 3 * DM; }
        else             { src = a.sgu_w_out; K = 2 * DM; N = DM; dst = Wt + W_SGUOUT; }
    }
}

__global__ void __launch_bounds__(512, 2) mega(Args a) {
    extern __shared__ __attribute__((aligned(16))) unsigned char lds_raw[];
    LAS unsigned char* lds = (LAS unsigned char*)lds_raw;
    cg::this_grid().sync();
    const int wave0 = __builtin_amdgcn_readfirstlane((int)threadIdx.x >> 6);
#define ssqX ((float*)(ws + WS_SSQX))
#define ssqY ((float*)(ws + WS_SSQY))
#define ssqV ((float*)(ws + WS_SSQV))
#define lseb ((float*)(ws + WS_LSE))
#define flog ((float*)(ws + WS_FLOG))
#define rope ((f32x2*)(ws + WS_ROPE))
#define misc ((float*)(ws + WS_MISC))
#define pbf ((bf16_t*)(ws + WS_PBF))
#define hb ((bf16_t*)(ws + WS_HB))
#define Wt ((bf16_t*)(ws + WS_W))
#define S1 ((bf16_t*)(ws + WS_S1))
#define FRESH_TID(name) int name; { int w_ = wave0; asm volatile("" : "+s"(w_)); unsigned o_ = ~0u; asm volatile("" : "+s"(o_)); name = w_ * 64 + (int)__builtin_amdgcn_mbcnt_hi(o_, __builtin_amdgcn_mbcnt_lo(o_, 0u)); asm volatile("" : "+v"(name)); }
#define PHASE_VARS \
    int wave_ = wave0; asm volatile("" : "+s"(wave_)); \
    unsigned ones_ = ~0u; asm volatile("" : "+s"(ones_)); \
    int tid = wave_ * 64 + (int)__builtin_amdgcn_mbcnt_hi(ones_, __builtin_amdgcn_mbcnt_lo(ones_, 0u)); asm volatile("" : "+v"(tid)); \
    int bid = blockIdx.x; asm volatile("" : "+s"(bid)); \
    int G = gridDim.x; asm volatile("" : "+s"(G)); \
    const int lane = tid & 63, wave = wave_; \
    const int gw = bid * 8 + wave, NGW = G * 8; \
    const long gt = (long)bid * 512 + tid, NGT = (long)G * 512; \
    gbyte_t* wsg_ = (gbyte_t*)a.ws; asm volatile("" : "+s"(wsg_)); unsigned char* ws = (unsigned char*)wsg_; \
    float* h = a.out; \
    (void)lane; (void)wave; (void)gw; (void)NGW; (void)gt; (void)NGT; (void)h; (void)ws;

    {
        PHASE_VARS
        LAS float* scr = (LAS float*)(lds + wave * 16384);
#pragma unroll 1
        for (int rep = 0; rep < (PROBE_REP == 6 ? 2 : 1); ++rep) {
        int it0 = 0;
#pragma unroll 1
        for (int mi = 0; mi < 32; ++mi) {
            const float* src; int K_, N_; bf16_t* dst; const float* gain; int mode;
            get_mat(a, Wt, mi, src, K_, N_, dst, gain, mode);
            const int nitems = (K_ / 64) * ((N_ + 31) / 32);
            const int first = it0 + (((gw - it0) % NGW) + NGW) % NGW;
#pragma unroll 1
            for (int gi = first; gi < it0 + nitems; gi += NGW) transpose_item(src, K_, N_, dst, gain, mode, scr, gi - it0, lane);
            it0 += nitems;
        }
#pragma unroll 1
        for (int m = gw; m < MTOK; m += NGW) {
            const f32x4* xr = (const f32x4*)(a.x + (size_t)m * DM) + lane; u32x2* o8 = (u32x2*)(hb + (size_t)m * DM) + lane; float ss = 0.f;
#pragma unroll
            for (int j = 0; j < 4; ++j) { const f32x4 v = xr[64 * j]; ss += (v[0] * v[0] + v[1] * v[1]) + (v[2] * v[2] + v[3] * v[3]); u32x2 w; w.x = cvtpk(v[0], v[1]); w.y = cvtpk(v[2], v[3]); o8[64 * j] = w; }
            ss = wave_sum(ss, lane);
            if (lane < 16) ssqX[(size_t)m * 16 + lane] = ss * (1.0f / 16.0f);
        }
#pragma unroll 1
        for (long i = gt; i < (long)MTOK * PLE / 4; i += NGT) { const f32x4 v = ((const f32x4*)a.p)[i]; u32x2 w; w.x = cvtpk(v[0], v[1]); w.y = cvtpk(v[2], v[3]); ((u32x2*)pbf)[i] = w; }
        if (gt < SEQ * 8) {
            const int pos = (int)(gt >> 3), j = (int)(gt & 7);
            const float invf = j == 0 ? 1.0f : j == 1 ? 0.1939227432012558f : j == 2 ? 0.03760603070259094f : j == 3 ? 0.007292664609849453f : j == 4 ? 0.0014142135623842478f
                             : j == 5 ? 0.00027424818836152554f : j == 6 ? 5.318296098266728e-05f : 1.0313386155758053e-05f;
            const float angf = (float)pos * invf; const double ang = (double)angf;
            const double kk = rint(ang * 0.15915494309189535); const double r = (ang - kk * 6.283185307179586) - kk * 2.4492935982947064e-16; const double r2 = r * r;
            double s = 1.0, c = 1.0;
#pragma unroll
            for (int n = 13; n >= 1; --n) { s = 1.0 - s * r2 * (1.0 / (double)((2 * n) * (2 * n + 1))); c = 1.0 - c * r2 * (1.0 / (double)((2 * n - 1) * (2 * n))); }
            rope[gt] = (f32x2){(float)c, (float)(r * s)};
        }
        if (gt == 0) {
            float s1 = 0.f, s2 = 0.f;
#pragma unroll 1
            for (int i = 0; i < 64; ++i) { s1 += a.diff_lambda[i] * a.diff_lambda[64 + i]; s2 += a.diff_lambda[128 + i] * a.diff_lambda[192 + i]; }
            misc[0] = expf(s1) - expf(s2) + LAM_INIT;
        }
        }
        grid_bar((unsigned*)(ws + WS_BAR), (unsigned)G, tid, 0u);
    }

#pragma unroll 1
    for (int qq = 0; qq < 4 * NSLOTS; ++qq) {
        PHASE_VARS
        pg8::StaticOrder SO;
        bf16_t* const pp = S1 + (size_t)96 * MiB;
        bf16_t* const hb2 = S1 + (size_t)128 * MiB;
        const int L = qq / NSLOTS, sl = qq % NSLOTS;
#if PROBE_REP == 1
        const int s = (sl <= 1) ? 0 : (sl <= 7) ? sl - 1 : (sl == 8) ? 6 : sl - 2;
#elif PROBE_REP == 7
        const int s = (sl <= 2) ? sl : sl - 1;
#elif PROBE_REP == 8
        const int s = (sl <= 8) ? sl : 8;
#else
        const int s = sl;
#endif
        const bf16_t* wl = Wt + (size_t)L * L_SIZE;
        if (s == 0 || s == 6) {
            pg8::Gemm g{hb, wl + (s == 0 ? L_FFN1IN : L_FFN2IN), MTOK, 2 * DFF, DM, DM}; SO.init(MTOK, 2 * DFF, G, bid); EpiSwiglu E{ssqX, S1}; pg8::gemm_phase(lds, tid, g, SO, E);

        } else if (s == 1 || s == 5 || s == 7) {
            const bf16_t* Bt; int K_, lda_; float sc; float* sq;
            if (s == 1) { Bt = wl + L_FFN1OUT; K_ = DFF; lda_ = DFF; sc = 0.5f; sq = ssqY; }
            else if (s == 7) { Bt = wl + L_FFN2OUT; K_ = DFF; lda_ = DFF; sc = 0.5f; sq = ssqY; }
            else { sc = 1.0f; sq = ssqX; K_ = DM;
                if (L == 0) { Bt = Wt + W_FOXOUT; lda_ = 3072; } else if (L == 1) { Bt = Wt + W_DILOUT; lda_ = 5120; } else if (L == 2) { Bt = Wt + W_DIFFOUT; lda_ = 3072; } else { Bt = Wt + W_SGUOUT; K_ = 2 * DM; lda_ = 4096; } }
#if PROBE_REP == 2 || PROBE_REP == 4
            if ((PROBE_REP == 2) == (s != 5)) { pg8::Gemm g{S1, Bt, MTOK, DM, K_, lda_}; SO.init(MTOK, DM, G, bid); EpiResid E{(L == 0 && s == 1) ? a.x : h, (float*)(S1 + (size_t)96 * MiB), s == 7 ? hb2 : hb, sq, sc}; pg8::gemm_phase(lds, tid, g, SO, E); }
#endif
            { pg8::Gemm g{S1, Bt, MTOK, DM, K_, lda_}; SO.init(MTOK, DM, G, bid); EpiResid E{(L == 0 && s == 1) ? a.x : h, h, s == 7 ? hb2 : hb, sq, sc}; pg8::gemm_phase(lds, tid, g, SO, E); }
            if (s == 7) { pg8::Gemm g{pbf, wl + L_PLEP, MTOK, DM, PLE, PLE}; SO.init(MTOK, DM, G, bid); EpiBf16 E{pp, DM}; pg8::gemm_phase(lds, tid, g, SO, E); }
        } else if (s == 2) {
            if (L < 3) {
                const bf16_t* Bt; int N_, ldo, qs, re, fg;
                if (L == 0) { Bt = Wt + W_FOXIN; N_ = 3328; ldo = 3072; qs = 1024; re = 0; fg = 12; }
                else if (L == 1) { Bt = Wt + W_DILIN; N_ = 5120; ldo = 5120; qs = 3072; re = 4096; fg = -1; }
                else { Bt = Wt + W_DIFFIN; N_ = 3072; ldo = 3072; qs = 1024; re = 2048; fg = -1; }
                pg8::Gemm g{hb, Bt, MTOK, N_, DM, DM}; SO.init(MTOK, N_, G, bid); EpiQkv E{ssqY, S1, ldo, qs, re, fg, rope, a.fox_b_f, flog}; pg8::gemm_phase(lds, tid, g, SO, E);
            } else {
                pg8::Gemm g{hb, Wt + W_SGUIN, MTOK, 4096, DM, DM}; SO.init(MTOK, 4096, G, bid); EpiSguIn E{ssqY, S1, ssqV}; pg8::gemm_phase(lds, tid, g, SO, E);
            }
        } else if (s == 8) {
            { pg8::Gemm g{hb2, wl + L_PLEG, MTOK, DM, DM, DM}; SO.init(MTOK, DM, G, bid); EpiPleGate E{ssqY, h, (PROBE_REP == 8 && sl == 8) ? (float*)S1 : h, hb, ssqX, a.b_ple_gate + L * DM, pp}; pg8::gemm_phase(lds, tid, g, SO, E); }
            if (L < 3) {
                const f32x4* ps = (const f32x4*)(a.p + (size_t)(L + 1) * MTOK * PLE);
                FRESH_TID(tid3)
#pragma unroll 1
                for (long i = (long)bid * 512 + tid3; i < (long)MTOK * PLE / 4; i += NGT) { const f32x4 v = ps[i]; u32x2 w; w.x = cvtpk(v[0], v[1]); w.y = cvtpk(v[2], v[3]); ((u32x2*)pbf)[i] = w; }
            }
        } else if ((s == 4 && L == 0) || (s == 3 && (L == 1 || L == 2))) {
            const int total = L == 0 ? 2048 : L == 1 ? 6144 : 4096;
#pragma unroll 1
            for (int n = bid; n < total; n += G) {
                AttnJob J;
                if (L == 0) {
                    const int v = n & 255, i = n >> 8, bh = v >> 1, s2 = (v & 1) * 4 + (i >> 1), qb = (i & 1) ? 15 - s2 : s2, b = bh >> 4, hh = bh & 15;
                    bf16_t* base = S1 + (size_t)b * SEQ * 3072 + hh * 64;
                    J = AttnJob{base, base + 1024, base + 2048, base, 3072, 3072, flog + (size_t)b * SEQ * 16 + hh, 16, nullptr, 0, qb * 256, 1 << 20};
                } else if (L == 1) {
                    const int gi = n / 2048, idx = n % 2048, bh = idx & 127, sub = idx >> 7, b = bh >> 4, hh = bh & 15;
                    const int d = gi == 0 ? 1 : gi == 1 ? 4 : 16; const int res = sub % d, ub = sub / d;
                    bf16_t* base = S1 + ((size_t)b * SEQ + res) * 5120 + hh * 64;
                    J = AttnJob{base + gi * 1024, base + 3072, base + 4096, base + gi * 1024, (long)5120 * d, (long)5120 * d, nullptr, 0,
                                lseb + (size_t)gi * MTOK * 16 + ((size_t)b * SEQ + res) * 16 + hh, 16 * d, ub * 256, 128};
                } else {
                    const int v = n & 255, i = n >> 8, b = v >> 5, ph2 = v & 31, mm = ph2 >> 1, vh = ph2 & 1, qb = (i & 1) ? 15 - (i >> 1) : (i >> 1);
                    bf16_t* base = S1 + (size_t)b * SEQ * 3072; bf16_t* OM = S1 + (size_t)MTOK * 3072;
                    J = AttnJob{base + mm * 64, base + 1024 + mm * 64, base + 2048 + (mm >> 1) * 128 + vh * 64, OM + (size_t)b * SEQ * 2048 + mm * 128 + vh * 64, 3072, 2048, nullptr, 0, nullptr, 0, qb * 256, 1 << 20};
                }
#if PROBE_REP == 3
                if (L != 1) { AttnJob J2 = J; if (L == 0) { const size_t off = (size_t)(J.Q - S1); J2.O = S1 + (size_t)96 * MiB + (off / ((size_t)SEQ * 3072)) * SEQ * 1024 + (off % 3072); J2.opitch = 1024; } attn_unit(lds, tid, J2); }
#endif
                attn_unit(lds, tid, J);
            }
        } else if (s == 3 && L == 0) {
            if (bid < 8) {
                const int hh = tid & 15, seg = tid >> 4; float* fp = flog + ((size_t)bid * SEQ + seg * 128) * 16 + hh; float sm = 0.f;
#pragma unroll 8
                for (int i = 0; i < 128; ++i) sm += fp[i * 16];
                LAS float* sc = (LAS float*)lds; sc[tid] = sm; __syncthreads();
                float pre = 0.f;
#pragma unroll 1
                for (int j = 0; j < seg; ++j) pre += sc[j * 16 + hh];
                float run = pre;
#pragma unroll 8
                for (int i = 0; i < 128; ++i) { run += fp[i * 16]; fp[i * 16] = run * LOG2E; }
                __syncthreads();
            }
        } else if (s == 4 && L == 1) {
#pragma unroll 1
            for (long it = gt; it < (long)MTOK * 128; it += NGT) {
                const long row = it >> 7; const int hh = (int)(it >> 3) & 15, ch = (int)it & 7;
                const float l0 = lseb[row * 16 + hh], l1 = lseb[(size_t)MTOK * 16 + row * 16 + hh], l2 = lseb[(size_t)2 * MTOK * 16 + row * 16 + hh];
                const float mx = fmaxf(l0, fmaxf(l1, l2)); float w0 = expf(l0 - mx), w1 = expf(l1 - mx), w2 = expf(l2 - mx); const float inv = 1.0f / (w0 + w1 + w2); w0 *= inv; w1 *= inv; w2 *= inv;
                bf16_t* p0 = S1 + row * 5120 + hh * 64 + ch * 8;
                const u32x4 a0 = *(const u32x4*)p0, a1 = *(const u32x4*)(p0 + 1024), a2 = *(const u32x4*)(p0 + 2048); u32x4 o;
#pragma unroll
                for (int k = 0; k < 4; ++k) o[k] = cvtpk(w0 * bf_lo(a0[k]) + w1 * bf_lo(a1[k]) + w2 * bf_lo(a2[k]), w0 * bf_hi(a0[k]) + w1 * bf_hi(a1[k]) + w2 * bf_hi(a2[k]));
                *(u32x4*)p0 = o;
            }
        } else if (s == 4 && L == 2) {
            const float lam = misc[0]; const bf16_t* OM = S1 + (size_t)MTOK * 3072;
#pragma unroll 1
            for (long it = gt; it < (long)MTOK * 128; it += NGT) {
                const long row = it >> 7; const int hh = (int)(it >> 4) & 7, c16 = (int)it & 15;
                const bf16_t* p1 = OM + row * 2048 + (2 * hh) * 128 + c16 * 8;
                const u32x4 a1 = *(const u32x4*)p1, a2 = *(const u32x4*)(p1 + 128); float o[8]; float ss = 0.f;
#pragma unroll
                for (int k = 0; k < 4; ++k) { o[2 * k] = bf_lo(a1[k]) - lam * bf_lo(a2[k]); o[2 * k + 1] = bf_hi(a1[k]) - lam * bf_hi(a2[k]); ss += o[2 * k] * o[2 * k] + o[2 * k + 1] * o[2 * k + 1]; }
                ss += sx(ss, 1, lane); ss += sx(ss, 2, lane); ss += sx(ss, 4, lane); ss += sx(ss, 8, lane);
                const float r = (1.0f - LAM_INIT) / sqrtf(ss * (1.0f / 128.0f) + 1e-5f);
                const f32x4 g0 = *(const f32x4*)(a.diff_subln + c16 * 8), g1 = *(const f32x4*)(a.diff_subln + c16 * 8 + 4);
                u32x4 w; w.x = cvtpk(o[0] * r * g0[0], o[1] * r * g0[1]); w.y = cvtpk(o[2] * r * g0[2], o[3] * r * g0[3]); w.z = cvtpk(o[4] * r * g1[0], o[5] * r * g1[1]); w.w = cvtpk(o[6] * r * g1[2], o[7] * r * g1[3]);
                *(u32x4*)(S1 + row * 3072 + hh * 128 + c16 * 8) = w;
            }
        } else if (s == 3 && L == 3) {
#pragma unroll 1
            for (int n = bid; n < 2048; n += G) {
                const int chunk = n >> 3, gg = n & 7; const size_t row0 = (size_t)chunk * 128;
                LAS float* rsv = (LAS float*)(lds + 65536);
                if (tid < 128) { const f32x4* sp = (const f32x4*)(ssqV + (row0 + tid) * 32); float sm = 0.f;
#pragma unroll
                    for (int j = 0; j < 8; ++j) { const f32x4 v = sp[j]; sm += (v[0] + v[1]) + (v[2] + v[3]); }
                    rsv[tid] = 1.0f / sqrtf(sm * (1.0f / 2048.0f) + NORM_EPS); }
                __syncthreads();
#pragma unroll 2
                for (int k = 0; k < 8; ++k) {
                    const int item = tid + 512 * k, sr = item >> 5, ch = item & 31;
                    const u32x4 vv = *(const u32x4*)(S1 + (row0 + sr) * 4096 + 2048 + gg * 256 + ch * 8);
                    const f32x4 n0 = *(const f32x4*)(a.sgu_norm_v + gg * 256 + ch * 8), n1 = *(const f32x4*)(a.sgu_norm_v + gg * 256 + ch * 8 + 4); const float r = rsv[sr];
                    u32x4 w; w.x = cvtpk(bf_lo(vv.x) * r * n0[0], bf_hi(vv.x) * r * n0[1]); w.y = cvtpk(bf_lo(vv.y) * r * n0[2], bf_hi(vv.y) * r * n0[3]);
                    w.z = cvtpk(bf_lo(vv.z) * r * n1[0], bf_hi(vv.z) * r * n1[1]); w.w = cvtpk(bf_lo(vv.w) * r * n1[2], bf_hi(vv.w) * r * n1[3]);
                    *(LAS u32x4*)(lds + (sr >> 2) * 2048 + (ch >> 2) * 256 + (sr & 3) * 64 + (ch & 3) * 16) = w;
                }
                __syncthreads();
                {
                    const int r32 = lane & 31, hi = lane >> 5, tb = wave & 3, chalf = wave >> 2, g16 = (lane >> 4) & 1, i16 = lane & 15;
                    const int trow = 32 * tb + r32; const float* wrow = a.sgu_w_s + ((size_t)gg * 128 + trow) * 128;
                    f32x16 acc[4] = {};
                    const int vrd = (2 * hi) * 2048 + (i16 >> 2) * 64 + g16 * 32 + (i16 & 3) * 8;
#pragma unroll 1
                    for (int ks = 0; ks <= 2 * tb + 1; ++ks) {
                        const int s0 = 16 * ks + 8 * hi; const f32x4 w0 = *(const f32x4*)(wrow + s0), w1 = *(const f32x4*)(wrow + s0 + 4); float wv[8];
#pragma unroll
                        for (int j = 0; j < 4; ++j) { wv[j] = (s0 + j <= trow) ? w0[j] : 0.f; wv[4 + j] = (s0 + 4 + j <= trow) ? w1[j] : 0.f; }
                        u32x4 pw; pw.x = cvtpk(wv[0], wv[1]); pw.y = cvtpk(wv[2], wv[3]); pw.z = cvtpk(wv[4], wv[5]); pw.w = cvtpk(wv[6], wv[7]);
                        const bf16x8 pa = __builtin_bit_cast(bf16x8, pw);
#pragma unroll
                        for (int cbl = 0; cbl < 4; ++cbl) {
                            const LAS unsigned char* vp = lds + vrd + ks * 8192 + (chalf * 4 + cbl) * 256;
                            const s16x4 lo = __builtin_bit_cast(s16x4, __builtin_amdgcn_ds_read_tr16_b64_v4i16((LAS s16x4*)vp));
                            const s16x4 hh = __builtin_bit_cast(s16x4, __builtin_amdgcn_ds_read_tr16_b64_v4i16((LAS s16x4*)(vp + 2048)));
                            const bf16x8 vf = (bf16x8){lo[0], lo[1], lo[2], lo[3], hh[0], hh[1], hh[2], hh[3]};
                            acc[cbl] = __builtin_amdgcn_mfma_f32_32x32x16_bf16(pa, vf, acc[cbl], 0, 0, 0);
                        }
                    }
#pragma unroll
                    for (int cbl = 0; cbl < 4; ++cbl)
#pragma unroll
                        for (int r = 0; r < 16; ++r) {
                            const int t = 32 * tb + crow(r, hi); bf16_t* up = S1 + (row0 + t) * 4096 + gg * 256 + (chalf * 4 + cbl) * 32 + r32;
                            const float uval = __uint_as_float((unsigned)(*up) << 16); const float mixed = acc[cbl][r] + a.sgu_b_s[gg * 128 + t];
                            *up = (bf16_t)(cvtpk(uval * mixed, 0.f) & 0xffffu);
                        }
                }
                __syncthreads();
            }
        }
        { FRESH_TID(tid2) grid_bar((unsigned*)(ws + WS_BAR), (unsigned)G, tid2, (unsigned)qq + 1u); }
    }
    PHASE_VARS
#pragma unroll 1
    for (int m = gw; m < MTOK; m += NGW) {
        float sm = lane < 16 ? ssqX[(size_t)m * 16 + lane] : 0.f; sm = wave_sum(sm, lane);
        const float r = 1.0f / sqrtf(sm * (1.0f / DM) + NORM_EPS);
        f32x4* xr = (f32x4*)(h + (size_t)m * DM) + lane; const f32x4* gr = (const f32x4*)a.norm_final + lane;
#pragma unroll
        for (int j = 0; j < 4; ++j) { const f32x4 v = xr[64 * j]; const f32x4 gg = gr[64 * j]; xr[64 * j] = v * r * gg; }
    }
}

extern "C" void kernel_launch(void* const* d_in, const int* in_sizes, int n_in, void* d_out, int out_size, void* d_ws, size_t ws_size, hipStream_t stream) {
    static int grid = 0;
    if (grid == 0) {
        int dev = 0, cus = 0, per_cu = 0;
        hipGetDevice(&dev);
        hipDeviceGetAttribute(&cus, hipDeviceAttributeMultiprocessorCount, dev);
        hipFuncSetAttribute((const void*)mega, hipFuncAttributeMaxDynamicSharedMemorySize, LDS_BYTES);
        hipOccupancyMaxActiveBlocksPerMultiprocessor(&per_cu, (const void*)mega, 512, LDS_BYTES);
        if (per_cu < 1) per_cu = 1;
        grid = cus * per_cu;
        if (ws_size < WS_END) fprintf(stderr, "kernel_launch: workspace too small: %zu < %zu\n", ws_size, (size_t)WS_END);
    }
    hipMemsetAsync((unsigned char*)d_ws + WS_BAR, 0, 1024, stream);
    Args a{};
    const float** pa = (const float**)&a;
    for (int i = 0; i < 28; ++i) pa[i] = (const float*)d_in[i];
    a.out = (float*)d_out; a.ws = (unsigned char*)d_ws;
    void* args[] = {&a};
    hipError_t e = hipLaunchCooperativeKernel((const void*)mega, dim3(grid), dim3(512), args, LDS_BYTES, stream);
    if (e != hipSuccess) fprintf(stderr, "cooperative launch failed: %s (grid %d)\n", hipGetErrorString(e), grid);
}
```

```cpp
#include <hip/hip_runtime.h>
#include <hip/hip_cooperative_groups.h>
#include <cstdint>
#include <cstdio>
namespace cg = cooperative_groups;

#define LAS __attribute__((address_space(3)))
typedef unsigned short bf16_t;
typedef short bf16x8 __attribute__((ext_vector_type(8)));
typedef short s16x4 __attribute__((ext_vector_type(4)));
typedef float f32x4 __attribute__((ext_vector_type(4)));
typedef float f32x2 __attribute__((ext_vector_type(2)));
typedef float f32x16 __attribute__((ext_vector_type(16)));
typedef unsigned u32x4 __attribute__((ext_vector_type(4)));
typedef unsigned u32x2 __attribute__((ext_vector_type(2)));
typedef __bf16 bf16x2_t __attribute__((ext_vector_type(2)));
typedef __attribute__((address_space(1))) unsigned char gbyte_t;

constexpr int MTOK = 32768, SEQ = 4096, DM = 1024, DFF = 2816, PLE = 256;
constexpr float NORM_EPS = 1e-6f;
constexpr float LOG2E = 1.4426950408889634f, LN2 = 0.6931471805599453f;
constexpr float QSCALE = 0.125f * LOG2E;
constexpr float LAM_INIT = 0.47071301834358414f;

constexpr size_t MiB = 1u << 20;
constexpr size_t WS_SSQX = 0, WS_SSQY = 2 * MiB, WS_SSQV = 4 * MiB, WS_LSE = 8 * MiB, WS_FLOG = 14 * MiB, WS_ROPE = 16 * MiB, WS_MISC = 16 * MiB + 512 * 1024, WS_BAR = 16 * MiB + 768 * 1024;
constexpr size_t WS_PBF = 17 * MiB, WS_HB = 33 * MiB, WS_W = 97 * MiB, WS_S1 = 280 * MiB, WS_END = 600 * MiB;
constexpr size_t L_FFN1IN = 0, L_FFN1OUT = 5767168, L_FFN2IN = 8650752, L_FFN2OUT = 14417920, L_PLEG = 17301504, L_PLEP = 18350080, L_SIZE = 18612224;
constexpr size_t W_FOXIN = 4 * L_SIZE, W_FOXOUT = W_FOXIN + 3407872, W_DILIN = W_FOXOUT + 1048576, W_DILOUT = W_DILIN + 5242880, W_DIFFIN = W_DILOUT + 1048576,
                 W_DIFFOUT = W_DIFFIN + 3145728, W_SGUIN = W_DIFFOUT + 1048576, W_SGUOUT = W_SGUIN + 4194304, W_TOTAL = W_SGUOUT + 2097152;
static_assert(WS_W + W_TOTAL * 2 <= WS_S1, "weights fit");

#ifndef PROBE_REP
#define PROBE_REP 0
#endif
constexpr unsigned BARMUL = (PROBE_REP == 9) ? 2u : 1u;
constexpr int NSLOTS = (PROBE_REP == 1) ? 11 : (PROBE_REP == 7 || PROBE_REP == 8) ? 10 : 9;
constexpr int LDS_BYTES = 139264;

__device__ __forceinline__ unsigned cvtpk(float lo, float hi) { f32x2 v = {lo, hi}; bf16x2_t b = __builtin_convertvector(v, bf16x2_t); return __builtin_bit_cast(unsigned, b); }
__device__ __forceinline__ float bf_lo(unsigned w) { return __uint_as_float(w << 16); }
__device__ __forceinline__ float bf_hi(unsigned w) { return __uint_as_float(w & 0xffff0000u); }
__device__ __forceinline__ float sx(float v, int o, int lane) { return __int_as_float(__builtin_amdgcn_ds_bpermute((lane ^ o) << 2, __float_as_int(v))); }
__device__ __forceinline__ float wave_sum(float v, int lane) {
#pragma unroll
    for (int o = 1; o < 64; o <<= 1) v += sx(v, o, lane);
    return v;
}
__device__ __forceinline__ float fast_exp2(float x) { return __builtin_amdgcn_exp2f(x); }
__device__ __forceinline__ float fast_rcp(float x) { return __builtin_amdgcn_rcpf(x); }
__device__ __forceinline__ float sigmoidf_(float x) { return fast_rcp(1.0f + fast_exp2(-x * LOG2E)); }

namespace pg8 {
constexpr int BM = 256, BK = 64, HALF = 128, HTB = HALF * BK * 2, STAGE_BYTES = 8 * HTB, NXCD = 8, WGM = 8;
__host__ __device__ __forceinline__ int lds_byte(int r, int c) { const int st = (r >> 4) * 2 + (c >> 5), rr = r & 15, cc = c & 31, ob = rr * 64 + cc * 2; return st * 1024 + (ob ^ (((ob >> 9) & 1) << 5)); }
__host__ __device__ __forceinline__ void stage_rc(int b, int& R, int& C) { const int st = b / 1024, sb = b % 1024, swz = sb ^ (((sb >> 9) & 1) << 5); R = (st >> 1) * 16 + swz / 64; C = (st & 1) * 32 + (swz % 64) / 2; }
__host__ __device__ __forceinline__ int perm32(int rho) { const int n = rho >> 4, i = rho & 15; return 8 * (i >> 2) + 4 * n + (i & 3); }
struct Unit { int pm, pn; };
struct Gemm { const bf16_t* A; const bf16_t* Bt; int M, N, K, lda; };
struct StaticOrder {
    int nM, nN, nwg, G, c;
    __device__ void init(int M, int N, int G_, int c_) { nM = M / BM; nN = N / BM; nwg = nM * nN; G = G_; c = c_; }
    __device__ bool next(int i, Unit& u) const {
        const long L = (long)i * G + c; if (L >= nwg) return false;
        int wgid = (int)L; { const int q = nwg / NXCD, r = nwg % NXCD, xcd = wgid % NXCD, off = wgid / NXCD; wgid = (xcd < r ? xcd * (q + 1) : r * (q + 1) + (xcd - r) * q) + off; }
        const int nig = WGM * nN, gid = wgid / nig, fm = gid * WGM, gsz = (nM - fm) < WGM ? (nM - fm) : WGM;
        u.pm = fm + ((wgid % nig) % gsz); u.pn = (wgid % nig) / gsz; return true;
    }
};
template <class Epi>
__device__ __forceinline__ void gemm_phase(LAS unsigned char* lds, const int tid, const Gemm g, const StaticOrder& S, const Epi& E) {
    const int wid = __builtin_amdgcn_readfirstlane(tid >> 6), lane = tid & 63, wr = wid >> 2, wc = wid & 3, fr = lane & 15, fq = lane >> 4;
    const int K = g.K, nt = K / BK, lda = g.lda;
    unsigned voffA[2], voffB[2];
#pragma unroll
    for (int i = 0; i < 2; ++i) { int R, C; stage_rc(tid * 16 + i * 8192, R, C); const int Rb = Epi::PERM ? ((R & ~31) + perm32(R & 31)) : R;
        voffA[i] = (unsigned)(R * lda + C) * 2u; voffB[i] = (unsigned)(Rb * K + C) * 2u; }
    const size_t kstep = (size_t)(BK * 2);
    const size_t hstepA = (size_t)HALF * lda * 2, hstepB = (size_t)HALF * K * 2;
    const size_t tstepA = 2 * hstepA, tstepB = 2 * hstepB;
    const unsigned ldsw = (unsigned)wid * 1024u;
    const int aoff = lds_byte(wr * 64 + fr, fq * 8), boff = lds_byte(wc * 32 + fr, fq * 8);
#define PG8_SA(b, h) (((b) * 2 + (h)) * HTB)
#define PG8_SB(b, h) ((4 + (b) * 2 + (h)) * HTB)
#define PG8_STAGE(bufoff, gbase, voff) do { _Pragma("unroll") for (int _i = 0; _i < 2; ++_i) \
        __builtin_amdgcn_global_load_lds((const unsigned*)((const char*)(gbase) + (voff)[_i]), (LAS unsigned*)(lds + (bufoff) + ldsw + _i * 8192), 16, 0, 0); } while (0)
#define PG8_LDA(dst, b, h) do { _Pragma("unroll") for (int m = 0; m < 4; ++m) _Pragma("unroll") for (int k = 0; k < 2; ++k) dst[m][k] = *(const LAS bf16x8*)(lds + PG8_SA(b, h) + aoff + m * 2048 + k * 1024); } while (0)
#define PG8_LDB(dst, b, h) do { _Pragma("unroll") for (int n = 0; n < 2; ++n) _Pragma("unroll") for (int k = 0; k < 2; ++k) dst[n][k] = *(const LAS bf16x8*)(lds + PG8_SB(b, h) + boff + n * 2048 + k * 1024); } while (0)
#define PG8_MMA(ai, bj, At, Bt) do { __builtin_amdgcn_s_setprio(1); _Pragma("unroll") for (int m = 0; m < 4; ++m) _Pragma("unroll") for (int n = 0; n < 2; ++n) _Pragma("unroll") for (int k = 0; k < 2; ++k) \
        acc[ai][bj][m][n] = __builtin_amdgcn_mfma_f32_16x16x32_bf16(Bt[n][k], At[m][k], acc[ai][bj][m][n], 0, 0, 0); __builtin_amdgcn_s_setprio(0); } while (0)
#define PG8_WAIT_V(n) asm volatile("s_waitcnt vmcnt(" #n ")" ::: "memory")
#define PG8_WAIT_L(n) asm volatile("s_waitcnt lgkmcnt(" #n ")" ::: "memory")
#define PG8_BAR __builtin_amdgcn_s_barrier()
#define PG8_SCHED __builtin_amdgcn_sched_barrier(0)
    Unit cur, nxt; int ui = 0;
    if (!S.next(0, cur)) return;
    f32x4 acc[2][2][4][2];
#pragma unroll
    for (int a = 0; a < 2; ++a)
#pragma unroll
        for (int b = 0; b < 2; ++b)
#pragma unroll
            for (int m = 0; m < 4; ++m)
#pragma unroll
                for (int n = 0; n < 2; ++n) acc[a][b][m][n] = (f32x4){0.f, 0.f, 0.f, 0.f};
    bf16x8 At[4][2], B0[2][2], B1[2][2];
    const char* cA = (const char*)g.A + (size_t)cur.pm * tstepA; const char* cB = (const char*)g.Bt + (size_t)cur.pn * tstepB;
    PG8_STAGE(PG8_SB(0, 0), cB, voffB); PG8_STAGE(PG8_SB(0, 1), cB + hstepB, voffB); PG8_STAGE(PG8_SA(0, 0), cA, voffA); PG8_STAGE(PG8_SA(0, 1), cA + hstepA, voffA);
    if (wr == 1) PG8_BAR;
    PG8_WAIT_V(2); PG8_BAR;
    PG8_STAGE(PG8_SB(1, 0), cB + kstep, voffB); PG8_STAGE(PG8_SA(1, 0), cA + kstep, voffA); PG8_STAGE(PG8_SB(1, 1), cB + hstepB + kstep, voffB);
    PG8_WAIT_V(6); PG8_BAR;
    for (;;) {
        const bool has_next = S.next(ui + 1, nxt);
        const char* nA = has_next ? (const char*)g.A + (size_t)nxt.pm * tstepA : cA; const char* nB = has_next ? (const char*)g.Bt + (size_t)nxt.pn * tstepB : cB;
        for (int t = 0; t < nt; t += 2) {
            const bool last = (t == nt - 2);
            const char* a1 = cA + (size_t)(t + 1) * kstep;
            const char* a2 = last ? nA : cA + (size_t)(t + 2) * kstep; const char* b2 = last ? nB : cB + (size_t)(t + 2) * kstep;
            const char* a3 = a2 + kstep; const char* b3 = b2 + kstep;
            PG8_LDB(B0, 0, 0); PG8_LDB(B1, 0, 1); PG8_SCHED; PG8_LDA(At, 0, 0); PG8_STAGE(PG8_SA(1, 1), a1 + hstepA, voffA);
            PG8_WAIT_V(8); PG8_WAIT_L(0); PG8_BAR; PG8_MMA(0, 0, At, B0); PG8_MMA(0, 1, At, B1); PG8_BAR; PG8_SCHED;
            PG8_LDA(At, 0, 1); PG8_STAGE(PG8_SB(0, 0), b2, voffB); PG8_STAGE(PG8_SB(0, 1), b2 + hstepB, voffB); PG8_STAGE(PG8_SA(0, 0), a2, voffA);
            PG8_WAIT_V(8); PG8_WAIT_L(0); PG8_BAR; PG8_MMA(1, 0, At, B0); PG8_MMA(1, 1, At, B1); PG8_BAR; PG8_SCHED;
            PG8_LDB(B0, 1, 0); PG8_LDB(B1, 1, 1); PG8_SCHED; PG8_LDA(At, 1, 0); PG8_STAGE(PG8_SA(0, 1), a2 + hstepA, voffA);
            PG8_WAIT_V(8); PG8_WAIT_L(0); PG8_BAR; PG8_MMA(0, 0, At, B0); PG8_MMA(0, 1, At, B1); PG8_BAR; PG8_SCHED;
            PG8_LDA(At, 1, 1); PG8_STAGE(PG8_SB(1, 0), b3, voffB); PG8_STAGE(PG8_SB(1, 1), b3 + hstepB, voffB); PG8_STAGE(PG8_SA(1, 0), a3, voffA);
            PG8_WAIT_V(8); PG8_WAIT_L(0); PG8_BAR; PG8_MMA(1, 0, At, B0); PG8_MMA(1, 1, At, B1); PG8_BAR; PG8_SCHED;
        }
        if (wr == 0) PG8_BAR;
        E(acc, cur, wr, wc, fr, fq);
        if (!has_next) break;
#pragma unroll
        for (int a = 0; a < 2; ++a)
#pragma unroll
            for (int b = 0; b < 2; ++b)
#pragma unroll
                for (int m = 0; m < 4; ++m)
#pragma unroll
                    for (int n = 0; n < 2; ++n) acc[a][b][m][n] = (f32x4){0.f, 0.f, 0.f, 0.f};
        cur = nxt; cA = nA; cB = nB; ++ui;
        if (wr == 1) PG8_BAR;
    }
    PG8_WAIT_V(0);
    PG8_BAR;
#undef PG8_SA
#undef PG8_SB
#undef PG8_STAGE
#undef PG8_LDA
#undef PG8_LDB
#undef PG8_MMA
#undef PG8_WAIT_V
#undef PG8_WAIT_L
#undef PG8_BAR
#undef PG8_SCHED
}
}
using pg8::Unit;

__device__ __forceinline__ void row_rstd8(const float* ssq, int row0, int fq, int lane, float (&rs)[8]) {
#pragma unroll
    for (int ai = 0; ai < 2; ++ai)
#pragma unroll
        for (int m = 0; m < 4; ++m) {
            const f32x4 v = *(const f32x4*)(ssq + (size_t)(row0 + 128 * ai + 16 * m) * 16 + 4 * fq);
            float s = (v[0] + v[1]) + (v[2] + v[3]); s += sx(s, 16, lane); s += sx(s, 32, lane);
            rs[ai * 4 + m] = 1.0f / sqrtf(s * (1.0f / DM) + NORM_EPS);
        }
}
__device__ __forceinline__ float gelu_erf(float v) {
    const float av = fabsf(v), t = fast_rcp(av * 0.2316418882f + 1.0f);
    float q = t * 0.5307027145f + (-0.7265760135f); q = q * t + 0.7107068705f; q = q * t + (-0.142248368f); q = q * t + 0.127414796f; q = q * t;
    const float e = fast_exp2((v * v) * (-0.72134752044f));
    const float m = v * (q * e);
    return v < 0.f ? m : v - m;
}

struct EpiSwiglu {
    static constexpr bool PERM = true;
    const float* ssq; bf16_t* H;
    __device__ __forceinline__ void operator()(const f32x4 (&acc)[2][2][4][2], const Unit& u, int wr, int wc, int fr_, int fq_) const {
        (void)fr_; (void)fq_; unsigned o_ = ~0u; asm volatile("" : "+s"(o_)); const int lane = (int)__builtin_amdgcn_mbcnt_hi(o_, __builtin_amdgcn_mbcnt_lo(o_, 0u)); const int fr = lane & 15, fq = lane >> 4;
        const int row0 = u.pm * 256 + wr * 64 + fr, col0 = u.pn * 128 + wc * 32 + 8 * fq;
        float rs[8]; row_rstd8(ssq, row0, fq, fq * 16 + fr, rs);
#pragma unroll
        for (int ai = 0; ai < 2; ++ai)
#pragma unroll
            for (int m = 0; m < 4; ++m) {
                const float r = rs[ai * 4 + m]; float o[8];
#pragma unroll
                for (int n = 0; n < 2; ++n)
#pragma unroll
                    for (int i = 0; i < 4; ++i) { const float gt = acc[ai][0][m][n][i] * r, up = acc[ai][1][m][n][i] * r; o[n * 4 + i] = gt * sigmoidf_(gt) * up; }
                u32x4 w; w.x = cvtpk(o[0], o[1]); w.y = cvtpk(o[2], o[3]); w.z = cvtpk(o[4], o[5]); w.w = cvtpk(o[6], o[7]);
                *(u32x4*)(H + (size_t)(row0 + 128 * ai + 16 * m) * DFF + col0) = w;
            }
    }
};
struct EpiResid {
    static constexpr bool PERM = false;
    const float* base; float* out; bf16_t* hb; float* ssq; float scale;
    __device__ __forceinline__ void operator()(const f32x4 (&acc)[2][2][4][2], const Unit& u, int wr, int wc, int fr_, int fq_) const {
        (void)fr_; (void)fq_; unsigned o_ = ~0u; asm volatile("" : "+s"(o_)); const int lane = (int)__builtin_amdgcn_mbcnt_hi(o_, __builtin_amdgcn_mbcnt_lo(o_, 0u)); const int fr = lane & 15, fq = lane >> 4;
        const int row0 = u.pm * 256 + wr * 64 + fr, col0 = u.pn * 256 + wc * 32 + 4 * fq;
#pragma unroll
        for (int ai = 0; ai < 2; ++ai) {
            f32x4 bs[4][2][2];
#pragma unroll
            for (int m = 0; m < 4; ++m)
#pragma unroll
                for (int bj = 0; bj < 2; ++bj)
#pragma unroll
                    for (int n = 0; n < 2; ++n) bs[m][bj][n] = *(const f32x4*)(base + (size_t)(row0 + 128 * ai + 16 * m) * DM + col0 + bj * 128 + n * 16);
            asm volatile("" ::: "memory");
#pragma unroll
            for (int m = 0; m < 4; ++m) {
                const int row = row0 + 128 * ai + 16 * m; const size_t off = (size_t)row * DM + col0; float ss = 0.f;
#pragma unroll
                for (int bj = 0; bj < 2; ++bj)
#pragma unroll
                    for (int n = 0; n < 2; ++n) {
                        const size_t o2 = off + bj * 128 + n * 16;
                        const f32x4 o = bs[m][bj][n] + acc[ai][bj][m][n] * scale;
                        *(f32x4*)(out + o2) = o; ss += (o[0] * o[0] + o[1] * o[1]) + (o[2] * o[2] + o[3] * o[3]);
                        u32x2 w; w.x = cvtpk(o[0], o[1]); w.y = cvtpk(o[2], o[3]); *(u32x2*)(hb + o2) = w;
                    }
                ss += sx(ss, 16, lane); ss += sx(ss, 32, lane);
                if (fq == 0) ssq[(size_t)row * 16 + u.pn * 4 + wc] = ss;
            }
            asm volatile("" ::: "memory");
        }
    }
};
struct EpiPleGate {
    static constexpr bool PERM = false;
    const float* ssq_in; const float* h; float* hout; bf16_t* hb; float* ssq_out; const float* bg; const bf16_t* pp;
    __device__ __forceinline__ void operator()(const f32x4 (&acc)[2][2][4][2], const Unit& u, int wr, int wc, int fr_, int fq_) const {
        (void)fr_; (void)fq_; unsigned o_ = ~0u; asm volatile("" : "+s"(o_)); const int lane = (int)__builtin_amdgcn_mbcnt_hi(o_, __builtin_amdgcn_mbcnt_lo(o_, 0u)); const int fr = lane & 15, fq = lane >> 4;
        const int row0 = u.pm * 256 + wr * 64 + fr, col0 = u.pn * 256 + wc * 32 + 4 * fq;
        float rs[8]; row_rstd8(ssq_in, row0, fq, lane, rs);
#pragma unroll
        for (int ai = 0; ai < 2; ++ai)
#pragma unroll
        for (int mp = 0; mp < 2; ++mp) {
            f32x4 bs[2][2][2]; u32x2 pw[2][2][2];
#pragma unroll
            for (int mm = 0; mm < 2; ++mm)
#pragma unroll
                for (int bj = 0; bj < 2; ++bj)
#pragma unroll
                    for (int n = 0; n < 2; ++n) { const size_t o2 = (size_t)(row0 + 128 * ai + 16 * (2 * mp + mm)) * DM + col0 + bj * 128 + n * 16; bs[mm][bj][n] = *(const f32x4*)(h + o2); pw[mm][bj][n] = *(const u32x2*)(pp + o2); }
            asm volatile("" ::: "memory");
#pragma unroll
            for (int mm = 0; mm < 2; ++mm) {
                const int m = 2 * mp + mm;
                const int row = row0 + 128 * ai + 16 * m; const size_t off = (size_t)row * DM + col0; float ss = 0.f; const float r = rs[ai * 4 + m];
#pragma unroll
                for (int bj = 0; bj < 2; ++bj)
#pragma unroll
                    for (int n = 0; n < 2; ++n) {
                        const size_t o2 = off + bj * 128 + n * 16; const f32x4 b = bs[mm][bj][n]; const u32x2 p2 = pw[mm][bj][n];
                        const f32x4 bbv = *(const f32x4*)(bg + col0 + bj * 128 + n * 16);
                        f32x4 o;
                        o[0] = b[0] + sigmoidf_(acc[ai][bj][m][n][0] * r + bbv[0]) * bf_lo(p2.x);
                        o[1] = b[1] + sigmoidf_(acc[ai][bj][m][n][1] * r + bbv[1]) * bf_hi(p2.x);
                        o[2] = b[2] + sigmoidf_(acc[ai][bj][m][n][2] * r + bbv[2]) * bf_lo(p2.y);
                        o[3] = b[3] + sigmoidf_(acc[ai][bj][m][n][3] * r + bbv[3]) * bf_hi(p2.y);
                        *(f32x4*)(hout + o2) = o; ss += (o[0] * o[0] + o[1] * o[1]) + (o[2] * o[2] + o[3] * o[3]);
                        u32x2 w; w.x = cvtpk(o[0], o[1]); w.y = cvtpk(o[2], o[3]); *(u32x2*)(hb + o2) = w;
                    }
                ss += sx(ss, 16, lane); ss += sx(ss, 32, lane);
                if (fq == 0) ssq_out[(size_t)row * 16 + u.pn * 4 + wc] = ss;
            }
            asm volatile("" ::: "memory");
        }
    }
};
struct EpiBf16 {
    static constexpr bool PERM = true;
    bf16_t* O; int ldo;
    __device__ __forceinline__ void operator()(const f32x4 (&acc)[2][2][4][2], const Unit& u, int wr, int wc, int fr_, int fq_) const {
        (void)fr_; (void)fq_; unsigned o_ = ~0u; asm volatile("" : "+s"(o_)); const int lane = (int)__builtin_amdgcn_mbcnt_hi(o_, __builtin_amdgcn_mbcnt_lo(o_, 0u)); const int fr = lane & 15, fq = lane >> 4;
        const int row0 = u.pm * 256 + wr * 64 + fr, col0 = u.pn * 256 + wc * 32 + 8 * fq;
#pragma unroll
        for (int ai = 0; ai < 2; ++ai)
#pragma unroll
            for (int m = 0; m < 4; ++m)
#pragma unroll
                for (int bj = 0; bj < 2; ++bj) {
                    const f32x4 v0 = acc[ai][bj][m][0], v1 = acc[ai][bj][m][1];
                    u32x4 w; w.x = cvtpk(v0[0], v0[1]); w.y = cvtpk(v0[2], v0[3]); w.z = cvtpk(v1[0], v1[1]); w.w = cvtpk(v1[2], v1[3]);
                    *(u32x4*)(O + (size_t)(row0 + 128 * ai + 16 * m) * ldo + col0 + bj * 128) = w;
                }
    }
};
struct EpiQkv {
    static constexpr bool PERM = true;
    const float* ssq; bf16_t* O; int ldo; int qs_end, rope_end, fg_tile; const f32x2* rope; const float* bf; float* flog;
    __device__ __forceinline__ void operator()(const f32x4 (&acc)[2][2][4][2], const Unit& u, int wr, int wc, int fr_, int fq_) const {
        (void)fr_; (void)fq_; unsigned o_ = ~0u; asm volatile("" : "+s"(o_)); const int lane = (int)__builtin_amdgcn_mbcnt_hi(o_, __builtin_amdgcn_mbcnt_lo(o_, 0u)); const int fr = lane & 15, fq = lane >> 4;
        const int row0 = u.pm * 256 + wr * 64 + fr, colt = u.pn * 256;
        float rs[8]; row_rstd8(ssq, row0, fq, fq * 16 + fr, rs);
        if (u.pn == fg_tile) {
            if (wc == 0 && fq < 2) {
                const f32x4 b0 = *(const f32x4*)(bf + 8 * fq), b1 = *(const f32x4*)(bf + 8 * fq + 4);
#pragma unroll
                for (int ai = 0; ai < 2; ++ai)
#pragma unroll
                    for (int m = 0; m < 4; ++m) {
                        const float r = rs[ai * 4 + m]; f32x4 o0, o1;
#pragma unroll
                        for (int i = 0; i < 4; ++i) {
                            const float x0 = acc[ai][0][m][0][i] * r + b0[i], x1 = acc[ai][0][m][1][i] * r + b1[i];
                            o0[i] = fminf(x0, 0.f) - logf(1.0f + expf(-fabsf(x0))); o1[i] = fminf(x1, 0.f) - logf(1.0f + expf(-fabsf(x1)));
                        }
                        float* p = flog + (size_t)(row0 + 128 * ai + 16 * m) * 16 + 8 * fq;
                        *(f32x4*)p = o0; *(f32x4*)(p + 4) = o1;
                    }
            }
            return;
        }
        const float sc = colt < qs_end ? QSCALE : 1.0f;
        const bool do_rope = (colt < rope_end) && ((wc & 1) == 0);
        const float sgn = fq == 0 ? -1.0f : 1.0f;
#pragma unroll
        for (int ai = 0; ai < 2; ++ai)
#pragma unroll
            for (int m = 0; m < 4; ++m) {
                const int row = row0 + 128 * ai + 16 * m; const float r = rs[ai * 4 + m] * sc;
                f32x4 cs[4];
                if (do_rope) { const f32x4* tp = (const f32x4*)(rope + (size_t)(row & (SEQ - 1)) * 8);
#pragma unroll
                    for (int j = 0; j < 4; ++j) cs[j] = tp[j]; }
#pragma unroll
                for (int bj = 0; bj < 2; ++bj) {
                    f32x4 v0 = acc[ai][bj][m][0] * r, v1 = acc[ai][bj][m][1] * r;
                    if (do_rope) {
                        f32x4 p0, p1;
#pragma unroll
                        for (int i = 0; i < 4; ++i) { p0[i] = sx(v0[i], 16, lane); p1[i] = sx(v1[i], 16, lane); }
                        if (fq < 2) {
                            v0[0] = v0[0] * cs[0][0] + sgn * p0[0] * cs[0][1]; v0[1] = v0[1] * cs[0][2] + sgn * p0[1] * cs[0][3];
                            v0[2] = v0[2] * cs[1][0] + sgn * p0[2] * cs[1][1]; v0[3] = v0[3] * cs[1][2] + sgn * p0[3] * cs[1][3];
                            v1[0] = v1[0] * cs[2][0] + sgn * p1[0] * cs[2][1]; v1[1] = v1[1] * cs[2][2] + sgn * p1[1] * cs[2][3];
                            v1[2] = v1[2] * cs[3][0] + sgn * p1[2] * cs[3][1]; v1[3] = v1[3] * cs[3][2] + sgn * p1[3] * cs[3][3];
                        }
                    }
                    u32x4 w; w.x = cvtpk(v0[0], v0[1]); w.y = cvtpk(v0[2], v0[3]); w.z = cvtpk(v1[0], v1[1]); w.w = cvtpk(v1[2], v1[3]);
                    *(u32x4*)(O + (size_t)row * ldo + colt + bj * 128 + wc * 32 + 8 * fq) = w;
                }
            }
    }
};
struct EpiSguIn {
    static constexpr bool PERM = true;
    const float* ssq; bf16_t* O; float* ssqv;
    __device__ __forceinline__ void operator()(const f32x4 (&acc)[2][2][4][2], const Unit& u, int wr, int wc, int fr_, int fq_) const {
        (void)fr_; (void)fq_; unsigned o_ = ~0u; asm volatile("" : "+s"(o_)); const int lane = (int)__builtin_amdgcn_mbcnt_hi(o_, __builtin_amdgcn_mbcnt_lo(o_, 0u)); const int fr = lane & 15, fq = lane >> 4;
        const int row0 = u.pm * 256 + wr * 64 + fr, col0 = u.pn * 256 + wc * 32 + 8 * fq;
        float rs[8]; row_rstd8(ssq, row0, fq, fq * 16 + fr, rs);
#pragma unroll
        for (int ai = 0; ai < 2; ++ai)
#pragma unroll
            for (int m = 0; m < 4; ++m) {
                const int row = row0 + 128 * ai + 16 * m; const float r = rs[ai * 4 + m]; float ss = 0.f;
#pragma unroll
                for (int bj = 0; bj < 2; ++bj) {
                    float o[8];
#pragma unroll
                    for (int n = 0; n < 2; ++n)
#pragma unroll
                        for (int i = 0; i < 4; ++i) { const float gv = gelu_erf(acc[ai][bj][m][n][i] * r); o[n * 4 + i] = gv; ss += gv * gv; }
                    u32x4 w; w.x = cvtpk(o[0], o[1]); w.y = cvtpk(o[2], o[3]); w.z = cvtpk(o[4], o[5]); w.w = cvtpk(o[6], o[7]);
                    *(u32x4*)(O + (size_t)row * 4096 + col0 + bj * 128) = w;
                }
                if (u.pn >= 8) { ss += sx(ss, 16, lane); ss += sx(ss, 32, lane); if (fq == 0) ssqv[(size_t)row * 32 + (u.pn - 8) * 4 + wc] = ss; }
            }
    }
};

struct AttnJob {
    const bf16_t* Q; const bf16_t* K; const bf16_t* V; bf16_t* O;
    long pitch, opitch;
    const float* bias; int bstride;
    float* lse; int lstride;
    int q0, window;
};
constexpr int A_K = 0, A_V = 18432, A_B = 51200, A_WS = 51712, A_OST = 53760;
__device__ __forceinline__ int crow(int r, int hi) { return (r & 3) + 8 * (r >> 2) + 4 * hi; }

template <int NDB>
__device__ __forceinline__ void attn_unit(LAS unsigned char* lds, const int tid, const AttnJob& J) {
    constexpr int VGRP = NDB * 256, VBUF = 16 * VGRP;
    const int lane = tid & 63, r32 = lane & 31, hi = lane >> 5; const int wid = __builtin_amdgcn_readfirstlane(tid >> 6);
    const int q0 = J.q0, W = J.window;
    const int t_lo = (q0 - W > 0 ? q0 - W : 0) >> 6, t_hi = (q0 + 255) >> 6, nt = t_hi - t_lo + 1;
    const int qw = q0 + 32 * wid;
    const int tw_lo = (qw - W > 0 ? qw - W : 0) >> 6, tw_hi = (qw + 31) >> 6;
    const int qrow = qw + r32;
    bf16x8 qr[4];
    { const bf16_t* qp = J.Q + (long)qrow * J.pitch + hi * 8;
#pragma unroll
      for (int d0 = 0; d0 < 4; ++d0) qr[d0] = *(const bf16x8*)(qp + d0 * 16); }
    const int srow = tid >> 3, sch = tid & 7;
    const bf16_t* kg = J.K + (long)srow * J.pitch + sch * 8; const bf16_t* vg = J.V + (long)srow * J.pitch + sch * 8;
    const long tstride = 64 * J.pitch;
    const int kdst = A_K + srow * 144 + sch * 16, vdst = A_V + (srow >> 2) * VGRP + (sch >> 2) * 256 + (srow & 3) * 64 + (sch & 3) * 16;
    LAS float* wsf = (LAS float*)(lds + A_WS) + wid * 64;
    u32x4 kreg, vreg, vreg2 = {}; float breg = 0.f;
    kreg = *(const u32x4*)(kg + (long)t_lo * tstride); vreg = *(const u32x4*)(vg + (long)t_lo * tstride);
    if (NDB == 4) vreg2 = *(const u32x4*)(vg + (long)t_lo * tstride + 64);
    if (J.bias && tid < 64) breg = J.bias[(long)(t_lo * 64 + tid) * J.bstride];
    *(LAS u32x4*)(lds + kdst) = kreg; *(LAS u32x4*)(lds + vdst) = vreg; if (NDB == 4) *(LAS u32x4*)(lds + vdst + 512) = vreg2;
    if (J.bias && tid < 64) *(LAS float*)(lds + A_B + tid * 4) = breg;
    __syncthreads();
    float m_run = -1e30f, l_run = 0.f; f32x16 o[NDB];
#pragma unroll
    for (int db = 0; db < NDB; ++db) o[db] = (f32x16){};
    const int g16 = (lane >> 4) & 1, i16 = lane & 15;
    const int vrd = A_V + hi * VGRP + (i16 >> 2) * 64 + g16 * 32 + (i16 & 3) * 8;
#pragma unroll 1
    for (int it = 0; it < nt; ++it) {
        const int t = t_lo + it, cur = it & 1;
        if (it + 1 < nt) { kreg = *(const u32x4*)(kg + (long)(t + 1) * tstride); vreg = *(const u32x4*)(vg + (long)(t + 1) * tstride);
            if (NDB == 4) vreg2 = *(const u32x4*)(vg + (long)(t + 1) * tstride + 64);
            if (J.bias && tid < 64) breg = J.bias[(long)((t + 1) * 64 + tid) * J.bstride]; }
        if (t >= tw_lo && t <= tw_hi) {
            const LAS unsigned char* Kb = lds + A_K + cur * 9216 + r32 * 144 + hi * 16;
            bf16x8 kf[8];
#pragma unroll
            for (int d0 = 0; d0 < 4; ++d0) { kf[2 * d0] = *(const LAS bf16x8*)(Kb + d0 * 32); kf[2 * d0 + 1] = *(const LAS bf16x8*)(Kb + 32 * 144 + d0 * 32); }
            f32x16 p0 = {}, p1 = {};
#pragma unroll
            for (int d0 = 0; d0 < 4; ++d0) {
                p0 = __builtin_amdgcn_mfma_f32_32x32x16_bf16(kf[2 * d0], qr[d0], p0, 0, 0, 0);
                p1 = __builtin_amdgcn_mfma_f32_32x32x16_bf16(kf[2 * d0 + 1], qr[d0], p1, 0, 0, 0);
            }
            if (J.bias) {
                const LAS float* bb = (const LAS float*)(lds + A_B + cur * 256);
#pragma unroll
                for (int g = 0; g < 4; ++g) { const f32x4 b0 = *(const LAS f32x4*)(bb + 8 * g + 4 * hi), b1 = *(const LAS f32x4*)(bb + 32 + 8 * g + 4 * hi);
#pragma unroll
                    for (int i = 0; i < 4; ++i) { p0[4 * g + i] = p0[4 * g + i] * QSCALE - b0[i]; p1[4 * g + i] = p1[4 * g + i] * QSCALE - b1[i]; } }
            } else {
#pragma unroll
                for (int r = 0; r < 16; ++r) { p0[r] *= QSCALE; p1[r] *= QSCALE; }
            }
            const int kv0 = t * 64;
            const bool need_mask = (kv0 + 63 > qw) || (qw + 31 - kv0 > W);
            if (need_mask) {
#pragma unroll
                for (int r = 0; r < 16; ++r) { const int kv = kv0 + crow(r, hi);
                    if (kv > qrow || qrow - kv > W) p0[r] = -INFINITY;
                    if (kv + 32 > qrow || qrow - kv - 32 > W) p1[r] = -INFINITY; }
            }
            float mx = fmaxf(p0[0], p1[0]);
#pragma unroll
            for (int r = 1; r < 16; ++r) mx = fmaxf(mx, fmaxf(p0[r], p1[r]));
            mx = fmaxf(mx, sx(mx, 32, lane));
            const float m_new = fmaxf(m_run, mx), alpha = fast_exp2(m_run - m_new); m_run = m_new;
            float ls = 0.f;
#pragma unroll
            for (int r = 0; r < 16; ++r) { p0[r] = fast_exp2(p0[r] - m_new); p1[r] = fast_exp2(p1[r] - m_new); ls += p0[r] + p1[r]; }
            l_run = l_run * alpha + ls;
            if (__any(alpha != 1.0f)) {
                if (hi == 0) wsf[r32] = alpha;
#pragma unroll
                for (int g = 0; g < 4; ++g) { const f32x4 a = *(const LAS f32x4*)(wsf + 8 * g + 4 * hi);
#pragma unroll
                    for (int db = 0; db < NDB; ++db)
#pragma unroll
                        for (int i = 0; i < 4; ++i) o[db][4 * g + i] *= a[i]; }
            }
            bf16x8 pa[4];
#pragma unroll
            for (int s = 0; s < 2; ++s) {
                u32x4 w0, w1;
                w0.x = cvtpk(p0[8 * s + 0], p0[8 * s + 1]); w0.y = cvtpk(p0[8 * s + 2], p0[8 * s + 3]); w0.z = cvtpk(p0[8 * s + 4], p0[8 * s + 5]); w0.w = cvtpk(p0[8 * s + 6], p0[8 * s + 7]);
                w1.x = cvtpk(p1[8 * s + 0], p1[8 * s + 1]); w1.y = cvtpk(p1[8 * s + 2], p1[8 * s + 3]); w1.z = cvtpk(p1[8 * s + 4], p1[8 * s + 5]); w1.w = cvtpk(p1[8 * s + 6], p1[8 * s + 7]);
                pa[s] = __builtin_bit_cast(bf16x8, w0); pa[2 + s] = __builtin_bit_cast(bf16x8, w1);
            }
#pragma unroll
            for (int s = 0; s < 4; ++s) {
                bf16x8 vf[NDB];
#pragma unroll
                for (int db = 0; db < NDB; ++db) {
                    const LAS unsigned char* vp = lds + vrd + cur * VBUF + s * 4 * VGRP + db * 256;
                    const s16x4 lo = __builtin_bit_cast(s16x4, __builtin_amdgcn_ds_read_tr16_b64_v4i16((LAS s16x4*)vp));
                    const s16x4 hh = __builtin_bit_cast(s16x4, __builtin_amdgcn_ds_read_tr16_b64_v4i16((LAS s16x4*)(vp + 2 * VGRP)));
                    vf[db] = (bf16x8){lo[0], lo[1], lo[2], lo[3], hh[0], hh[1], hh[2], hh[3]};
                }
#pragma unroll
                for (int db = 0; db < NDB; ++db) o[db] = __builtin_amdgcn_mfma_f32_32x32x16_bf16(pa[s], vf[db], o[db], 0, 0, 0);
            }
        }
        if (it + 1 < nt) { const int nb = cur ^ 1;
            *(LAS u32x4*)(lds + kdst + nb * 9216) = kreg; *(LAS u32x4*)(lds + vdst + nb * VBUF) = vreg; if (NDB == 4) *(LAS u32x4*)(lds + vdst + nb * VBUF + 512) = vreg2;
            if (J.bias && tid < 64) *(LAS float*)(lds + A_B + nb * 256 + tid * 4) = breg; }
        __syncthreads();
    }
    const float l_tot = l_run + sx(l_run, 32, lane);
    if (J.lse && hi == 0) J.lse[(long)qrow * J.lstride] = (m_run + log2f(l_tot)) * LN2;
    if (hi == 0) wsf[r32] = 1.0f / l_tot;
    LAS bf16_t* stg = (LAS bf16_t*)(lds + A_OST) + wid * (NDB * 1024);
#pragma unroll
    for (int g = 0; g < 4; ++g) { const f32x4 a = *(const LAS f32x4*)(wsf + 8 * g + 4 * hi);
#pragma unroll
        for (int i = 0; i < 4; ++i) { const int orow = 8 * g + 4 * hi + i;
#pragma unroll
            for (int db = 0; db < NDB; ++db) stg[orow * (NDB * 32) + db * 32 + r32] = (bf16_t)(cvtpk(o[db][4 * g + i] * a[i], 0.f) & 0xffffu); } }
    bf16_t* Ow = J.O + (long)qw * J.opitch;
#pragma unroll
    for (int i = 0; i < NDB * 2; ++i) { const int idx = i * 64 + lane, row = idx / (NDB * 4), ch = idx % (NDB * 4);
        const u32x4 v = *(const LAS u32x4*)(stg + row * (NDB * 32) + ch * 8); *(u32x4*)(Ow + (long)row * J.opitch + ch * 8) = v; }
    __syncthreads();
}

__device__ __forceinline__ void grid_bar(unsigned* bw, unsigned G, int tid, unsigned k) {
    asm volatile("s_waitcnt vmcnt(0)" ::: "memory");
    __syncthreads();
    if (tid == 0) {
        __builtin_amdgcn_fence(__ATOMIC_RELEASE, "agent");
        asm volatile("s_waitcnt vmcnt(0)" ::: "memory");
        const unsigned old = __hip_atomic_fetch_add(bw, 1u, __ATOMIC_RELAXED, __HIP_MEMORY_SCOPE_AGENT);
        if (old + 1u == G * (k + 1u)) __hip_atomic_store(bw + 64, k + 1u, __ATOMIC_RELAXED, __HIP_MEMORY_SCOPE_AGENT);
        else { unsigned sp = 0; while (__hip_atomic_load(bw + 64, __ATOMIC_RELAXED, __HIP_MEMORY_SCOPE_AGENT) <= k) { __builtin_amdgcn_s_sleep(1); if (++sp > (1u << 27)) break; } }
        __builtin_amdgcn_fence(__ATOMIC_ACQUIRE, "agent");
        asm volatile("s_waitcnt vmcnt(0)" ::: "memory");
    }
    __syncthreads();
}

struct Args {
    const float *x, *p, *norm_ffn1, *w_ffn1_in, *w_ffn1_out, *norm_mix, *norm_ffn2, *w_ffn2_in, *w_ffn2_out, *norm_ple, *w_ple_gate, *b_ple_gate, *w_ple_proj,
        *fox_w_in, *fox_b_f, *fox_w_out, *dil_w_in, *dil_w_out, *diff_w_in, *diff_lambda, *diff_subln, *diff_w_out, *sgu_w_in, *sgu_norm_v, *sgu_w_s, *sgu_b_s, *sgu_w_out, *norm_final;
    float* out; unsigned char* ws;
};

__device__ __forceinline__ void transpose_item(const float* W, int K, int N, bf16_t* WT, const float* gain, int mode, LAS float* scr, int item, int lane) {
    const int nblk = (N + 31) / 32, kb = item / nblk, nb = item % nblk, k0 = 64 * kb, n0 = 32 * nb;
    const int ncol = n0 + (lane & 31); const bool okc = ncol < N;
    float vv[32];
#pragma unroll
    for (int i = 0; i < 32; ++i) { const int kk = 2 * i + (lane >> 5); vv[i] = okc ? W[(size_t)(k0 + kk) * N + ncol] : 0.f; }
    if (gain) {
#pragma unroll
        for (int i = 0; i < 32; ++i) vv[i] *= gain[k0 + 2 * i + (lane >> 5)];
    }
#pragma unroll
    for (int i = 0; i < 32; ++i) scr[(2 * i + (lane >> 5)) * 33 + (lane & 31)] = vv[i];
    asm volatile("s_waitcnt lgkmcnt(0)" ::: "memory");
    int d0 = n0;
    if (mode == 1) { if (n0 < DFF) d0 = (n0 / 128) * 256 + (n0 % 128); else { const int mm = n0 - DFF; d0 = (mm / 128) * 256 + 128 + (mm % 128); } }
    const int c = lane & 7;
#pragma unroll
    for (int j = 0; j < 4; ++j) { const int n = (lane >> 3) + 8 * j; const LAS float* s = scr + (8 * c) * 33 + n;
        u32x4 o; o.x = cvtpk(s[0 * 33], s[1 * 33]); o.y = cvtpk(s[2 * 33], s[3 * 33]); o.z = cvtpk(s[4 * 33], s[5 * 33]); o.w = cvtpk(s[6 * 33], s[7 * 33]);
        *(u32x4*)(WT + (size_t)(d0 + n) * K + k0 + 8 * c) = o; }
    asm volatile("s_waitcnt lgkmcnt(0)" ::: "memory");
}

__device__ __forceinline__ void get_mat(const Args& a, bf16_t* Wt, int mi, const float*& src, int& K, int& N, bf16_t*& dst, const float*& gain, int& mode) {
    gain = nullptr; mode = 0;
    if (mi < 24) {
        const int L = mi / 6, k = mi % 6; bf16_t* wl = Wt + (size_t)L * L_SIZE;
        if (k == 0)      { src = a.w_ffn1_in + (size_t)L * DM * 2 * DFF; K = DM; N = 2 * DFF; dst = wl + L_FFN1IN; gain = a.norm_ffn1 + L * DM; mode = 1; }
        else if (k == 1) { src = a.w_ffn1_out + (size_t)L * DFF * DM; K = DFF; N = DM; dst = wl + L_FFN1OUT; }
        else if (k == 2) { src = a.w_ffn2_in + (size_t)L * DM * 2 * DFF; K = DM; N = 2 * DFF; dst = wl + L_FFN2IN; gain = a.norm_ffn2 + L * DM; mode = 1; }
        else if (k == 3) { src = a.w_ffn2_out + (size_t)L * DFF * DM; K = DFF; N = DM; dst = wl + L_FFN2OUT; }
        else if (k == 4) { src = a.w_ple_gate + (size_t)L * DM * DM; K = DM; N = DM; dst = wl + L_PLEG; gain = a.norm_ple + L * DM; }
        else             { src = a.w_ple_proj + (size_t)L * PLE * DM; K = PLE; N = DM; dst = wl + L_PLEP; }
    } else {
        const int k = mi - 24;
        if (k == 0)      { src = a.fox_w_in; K = DM; N = 3 * DM + 16; dst = Wt + W_FOXIN; gain = a.norm_mix; }
        else if (k == 1) { src = a.fox_w_out; K = DM; N = DM; dst = Wt + W_FOXOUT; }
        else if (k == 2) { src = a.dil_w_in; K = DM; N = 5 * DM; dst = Wt + W_DILIN; gain = a.norm_mix + DM; }
        else if (k == 3) { src = a.dil_w_out; K = DM; N = DM; dst = Wt + W_DILOUT; }
        else if (k == 4) { src = a.diff_w_in; K = DM; N = 3 * DM; dst = Wt + W_DIFFIN; gain = a.norm_mix + 2 * DM; }
        else if (k == 5) { src = a.diff_w_out; K = DM; N = DM; dst = Wt + W_DIFFOUT; }
        else if (k == 6) { src = a.sgu_w_in; K = DM; N = 4 * DM; dst = Wt + W_SGUIN; gain = a.norm_mix + 3 * DM; }
        else             { src = a.sgu_w_out; K = 2 * DM; N = DM; dst = Wt + W_SGUOUT; }
    }
}

__global__ void __launch_bounds__(512, 2) mega(Args a) {
    extern __shared__ __attribute__((aligned(16))) unsigned char lds_raw[];
    LAS unsigned char* lds = (LAS unsigned char*)lds_raw;
    cg::this_grid().sync();
    const int wave0 = __builtin_amdgcn_readfirstlane((int)threadIdx.x >> 6);
#define ssqX ((float*)(ws + WS_SSQX))
#define ssqY ((float*)(ws + WS_SSQY))
#define ssqV ((float*)(ws + WS_SSQV))
#define lseb ((float*)(ws + WS_LSE))
#define flog ((float*)(ws + WS_FLOG))
#define rope ((f32x2*)(ws + WS_ROPE))
#define misc ((float*)(ws + WS_MISC))
#define pbf ((bf16_t*)(ws + WS_PBF))
#define hb ((bf16_t*)(ws + WS_HB))
#define Wt ((bf16_t*)(ws + WS_W))
#define S1 ((bf16_t*)(ws + WS_S1))
#define FRESH_TID(name) int name; { int w_ = wave0; asm volatile("" : "+s"(w_)); unsigned o_ = ~0u; asm volatile("" : "+s"(o_)); name = w_ * 64 + (int)__builtin_amdgcn_mbcnt_hi(o_, __builtin_amdgcn_mbcnt_lo(o_, 0u)); asm volatile("" : "+v"(name)); }
#define PHASE_VARS \
    int wave_ = wave0; asm volatile("" : "+s"(wave_)); \
    unsigned ones_ = ~0u; asm volatile("" : "+s"(ones_)); \
    int tid = wave_ * 64 + (int)__builtin_amdgcn_mbcnt_hi(ones_, __builtin_amdgcn_mbcnt_lo(ones_, 0u)); asm volatile("" : "+v"(tid)); \
    int bid = blockIdx.x; asm volatile("" : "+s"(bid)); \
    int G = gridDim.x; asm volatile("" : "+s"(G)); \
    const int lane = tid & 63, wave = wave_; \
    const int gw = bid * 8 + wave, NGW = G * 8; \
    const long gt = (long)bid * 512 + tid, NGT = (long)G * 512; \
    gbyte_t* wsg_ = (gbyte_t*)a.ws; asm volatile("" : "+s"(wsg_)); unsigned char* ws = (unsigned char*)wsg_; \
    float* h = a.out; \
    (void)lane; (void)wave; (void)gw; (void)NGW; (void)gt; (void)NGT; (void)h; (void)ws;

    {
        PHASE_VARS
        LAS float* scr = (LAS float*)(lds + wave * 16384);
#pragma unroll 1
        for (int rep = 0; rep < (PROBE_REP == 6 ? 2 : 1); ++rep) {
        int it0 = 0;
#pragma unroll 1
        for (int mi = 0; mi < 32; ++mi) {
            const float* src; int K_, N_; bf16_t* dst; const float* gain; int mode;
            get_mat(a, Wt, mi, src, K_, N_, dst, gain, mode);
            const int nitems = (K_ / 64) * ((N_ + 31) / 32);
            const int first = it0 + (((gw - it0) % NGW) + NGW) % NGW;
#pragma unroll 1
            for (int gi = first; gi < it0 + nitems; gi += NGW) transpose_item(src, K_, N_, dst, gain, mode, scr, gi - it0, lane);
            it0 += nitems;
        }
#pragma unroll 1
        for (int m = gw; m < MTOK; m += NGW) {
            const f32x4* xr = (const f32x4*)(a.x + (size_t)m * DM) + lane; u32x2* o8 = (u32x2*)(hb + (size_t)m * DM) + lane; float ss = 0.f;
#pragma unroll
            for (int j = 0; j < 4; ++j) { const f32x4 v = xr[64 * j]; ss += (v[0] * v[0] + v[1] * v[1]) + (v[2] * v[2] + v[3] * v[3]); u32x2 w; w.x = cvtpk(v[0], v[1]); w.y = cvtpk(v[2], v[3]); o8[64 * j] = w; }
            ss = wave_sum(ss, lane);
            if (lane < 16) ssqX[(size_t)m * 16 + lane] = ss * (1.0f / 16.0f);
        }
#pragma unroll 1
        for (long i = gt; i < (long)MTOK * PLE / 4; i += NGT) { const f32x4 v = ((const f32x4*)a.p)[i]; u32x2 w; w.x = cvtpk(v[0], v[1]); w.y = cvtpk(v[2], v[3]); ((u32x2*)pbf)[i] = w; }
        if (gt < SEQ * 8) {
            const int pos = (int)(gt >> 3), j = (int)(gt & 7);
            const float invf = j == 0 ? 1.0f : j == 1 ? 0.1939227432012558f : j == 2 ? 0.03760603070259094f : j == 3 ? 0.007292664609849453f : j == 4 ? 0.0014142135623842478f
                             : j == 5 ? 0.00027424818836152554f : j == 6 ? 5.318296098266728e-05f : 1.0313386155758053e-05f;
            const float angf = (float)pos * invf; const double ang = (double)angf;
            const double kk = rint(ang * 0.15915494309189535); const double r = (ang - kk * 6.283185307179586) - kk * 2.4492935982947064e-16; const double r2 = r * r;
            double s = 1.0, c = 1.0;
#pragma unroll
            for (int n = 13; n >= 1; --n) { s = 1.0 - s * r2 * (1.0 / (double)((2 * n) * (2 * n + 1))); c = 1.0 - c * r2 * (1.0 / (double)((2 * n - 1) * (2 * n))); }
            rope[gt] = (f32x2){(float)c, (float)(r * s)};
        }
        if (gt == 0) {
            float s1 = 0.f, s2 = 0.f;
#pragma unroll 1
            for (int i = 0; i < 64; ++i) { s1 += a.diff_lambda[i] * a.diff_lambda[64 + i]; s2 += a.diff_lambda[128 + i] * a.diff_lambda[192 + i]; }
            misc[0] = expf(s1) - expf(s2) + LAM_INIT;
        }
        }
        grid_bar((unsigned*)(ws + WS_BAR), (unsigned)G, tid, 0u);
    }

#pragma unroll 1
    for (int qq = 0; qq < 4 * NSLOTS; ++qq) {
        PHASE_VARS
        pg8::StaticOrder SO;
        bf16_t* const pp = S1 + (size_t)96 * MiB;
        bf16_t* const hb2 = S1 + (size_t)128 * MiB;
        const int L = qq / NSLOTS, sl = qq % NSLOTS;
#if PROBE_REP == 1
        const int s = (sl <= 1) ? 0 : (sl <= 7) ? sl - 1 : (sl == 8) ? 6 : sl - 2;
#elif PROBE_REP == 7
        const int s = (sl <= 2) ? sl : sl - 1;
#elif PROBE_REP == 8
        const int s = (sl <= 8) ? sl : 8;
#else
        const int s = sl;
#endif
        const bf16_t* wl = Wt + (size_t)L * L_SIZE;
        if (s == 0 || s == 6) {
            pg8::Gemm g{hb, wl + (s == 0 ? L_FFN1IN : L_FFN2IN), MTOK, 2 * DFF, DM, DM}; SO.init(MTOK, 2 * DFF, G, bid); EpiSwiglu E{ssqX, S1}; pg8::gemm_phase(lds, tid, g, SO, E);

        } else if (s == 1 || s == 5 || s == 7) {
            const bf16_t* Bt; int K_, lda_; float sc; float* sq;
            if (s == 1) { Bt = wl + L_FFN1OUT; K_ = DFF; lda_ = DFF; sc = 0.5f; sq = ssqY; }
            else if (s == 7) { Bt = wl + L_FFN2OUT; K_ = DFF; lda_ = DFF; sc = 0.5f; sq = ssqY; }
            else { sc = 1.0f; sq = ssqX; K_ = DM;
                if (L == 0) { Bt = Wt + W_FOXOUT; lda_ = 3072; } else if (L == 1) { Bt = Wt + W_DILOUT; lda_ = 5120; } else if (L == 2) { Bt = Wt + W_DIFFOUT; lda_ = 3072; } else { Bt = Wt + W_SGUOUT; K_ = 2 * DM; lda_ = 4096; } }
#if PROBE_REP == 2 || PROBE_REP == 4
            if ((PROBE_REP == 2) == (s != 5)) { pg8::Gemm g{S1, Bt, MTOK, DM, K_, lda_}; SO.init(MTOK, DM, G, bid); EpiResid E{(L == 0 && s == 1) ? a.x : h, (float*)(S1 + (size_t)96 * MiB), s == 7 ? hb2 : hb, sq, sc}; pg8::gemm_phase(lds, tid, g, SO, E); }
#endif
            { pg8::Gemm g{S1, Bt, MTOK, DM, K_, lda_}; SO.init(MTOK, DM, G, bid); EpiResid E{(L == 0 && s == 1) ? a.x : h, h, s == 7 ? hb2 : hb, sq, sc}; pg8::gemm_phase(lds, tid, g, SO, E); }
            if (s == 7) { pg8::Gemm g{pbf, wl + L_PLEP, MTOK, DM, PLE, PLE}; SO.init(MTOK, DM, G, bid); EpiBf16 E{pp, DM}; pg8::gemm_phase(lds, tid, g, SO, E); }
        } else if (s == 2) {
            if (L < 3) {
                const bf16_t* Bt; int N_, ldo, qs, re, fg;
                if (L == 0) { Bt = Wt + W_FOXIN; N_ = 3328; ldo = 3072; qs = 0; re = 0; fg = 12; }
                else if (L == 1) { Bt = Wt + W_DILIN; N_ = 5120; ldo = 5120; qs = 0; re = 4096; fg = -1; }
                else { Bt = Wt + W_DIFFIN; N_ = 3072; ldo = 3072; qs = 0; re = 2048; fg = -1; }
                pg8::Gemm g{hb, Bt, MTOK, N_, DM, DM}; SO.init(MTOK, N_, G, bid); EpiQkv E{ssqY, S1, ldo, qs, re, fg, rope, a.fox_b_f, flog}; pg8::gemm_phase(lds, tid, g, SO, E);
            } else {
                pg8::Gemm g{hb, Wt + W_SGUIN, MTOK, 4096, DM, DM}; SO.init(MTOK, 4096, G, bid); EpiSguIn E{ssqY, S1, ssqV}; pg8::gemm_phase(lds, tid, g, SO, E);
            }
        } else if (s == 8) {
            { pg8::Gemm g{hb2, wl + L_PLEG, MTOK, DM, DM, DM}; SO.init(MTOK, DM, G, bid); EpiPleGate E{ssqY, h, (PROBE_REP == 8 && sl == 8) ? (float*)S1 : h, hb, ssqX, a.b_ple_gate + L * DM, pp}; pg8::gemm_phase(lds, tid, g, SO, E); }
            if (L < 3) {
                const f32x4* ps = (const f32x4*)(a.p + (size_t)(L + 1) * MTOK * PLE);
                FRESH_TID(tid3)
#pragma unroll 1
                for (long i = (long)bid * 512 + tid3; i < (long)MTOK * PLE / 4; i += NGT) { const f32x4 v = ps[i]; u32x2 w; w.x = cvtpk(v[0], v[1]); w.y = cvtpk(v[2], v[3]); ((u32x2*)pbf)[i] = w; }
            }
        } else if ((s == 4 && L == 0) || (s == 3 && (L == 1 || L == 2))) {
            const int total = L == 1 ? 6144 : 2048;
#pragma unroll 1
            for (int n = bid; n < total; n += G) {
                AttnJob J;
                if (L == 0) {
                    const int v = n & 255, i = n >> 8, bh = v >> 1, s2 = (v & 1) * 4 + (i >> 1), qb = (i & 1) ? 15 - s2 : s2, b = bh >> 4, hh = bh & 15;
                    bf16_t* base = S1 + (size_t)b * SEQ * 3072 + hh * 64;
                    J = AttnJob{base, base + 1024, base + 2048, base, 3072, 3072, flog + (size_t)b * SEQ * 16 + hh, 16, nullptr, 0, qb * 256, 1 << 20};
                } else if (L == 1) {
                    const int gi = n / 2048, idx = n % 2048, bh = idx & 127, sub = idx >> 7, b = bh >> 4, hh = bh & 15;
                    const int d = gi == 0 ? 1 : gi == 1 ? 4 : 16; const int res = sub % d, ub = sub / d;
                    bf16_t* base = S1 + ((size_t)b * SEQ + res) * 5120 + hh * 64;
                    J = AttnJob{base + gi * 1024, base + 3072, base + 4096, base + gi * 1024, (long)5120 * d, (long)5120 * d, nullptr, 0,
                                lseb + (size_t)gi * MTOK * 16 + ((size_t)b * SEQ + res) * 16 + hh, 16 * d, ub * 256, 128};
                } else {
                    const int v = n & 255, i = n >> 8, bm = v >> 1, s2 = (v & 1) * 4 + (i >> 1), qb = (i & 1) ? 15 - s2 : s2, b = bm >> 4, mm = bm & 15;
                    bf16_t* base = S1 + (size_t)b * SEQ * 3072; bf16_t* OM = S1 + (size_t)MTOK * 3072;
                    J = AttnJob{base + mm * 64, base + 1024 + mm * 64, base + 2048 + (mm >> 1) * 128, OM + (size_t)b * SEQ * 2048 + mm * 128, 3072, 2048, nullptr, 0, nullptr, 0, qb * 256, 1 << 20};
                }
                if (L == 2) attn_unit<4>(lds, tid, J); else attn_unit<2>(lds, tid, J);
            }
        } else if (s == 3 && L == 0) {
            if (bid < 8) {
                const int hh = tid & 15, seg = tid >> 4; float* fp = flog + ((size_t)bid * SEQ + seg * 128) * 16 + hh; float sm = 0.f;
#pragma unroll 8
                for (int i = 0; i < 128; ++i) sm += fp[i * 16];
                LAS float* sc = (LAS float*)lds; sc[tid] = sm; __syncthreads();
                float pre = 0.f;
#pragma unroll 1
                for (int j = 0; j < seg; ++j) pre += sc[j * 16 + hh];
                float run = pre;
#pragma unroll 8
                for (int i = 0; i < 128; ++i) { run += fp[i * 16]; fp[i * 16] = run * LOG2E; }
                __syncthreads();
            }
        } else if (s == 4 && L == 1) {
#pragma unroll 1
            for (long it = gt; it < (long)MTOK * 128; it += NGT) {
                const long row = it >> 7; const int hh = (int)(it >> 3) & 15, ch = (int)it & 7;
                const float l0 = lseb[row * 16 + hh], l1 = lseb[(size_t)MTOK * 16 + row * 16 + hh], l2 = lseb[(size_t)2 * MTOK * 16 + row * 16 + hh];
                const float mx = fmaxf(l0, fmaxf(l1, l2)); float w0 = expf(l0 - mx), w1 = expf(l1 - mx), w2 = expf(l2 - mx); const float inv = 1.0f / (w0 + w1 + w2); w0 *= inv; w1 *= inv; w2 *= inv;
                bf16_t* p0 = S1 + row * 5120 + hh * 64 + ch * 8;
                const u32x4 a0 = *(const u32x4*)p0, a1 = *(const u32x4*)(p0 + 1024), a2 = *(const u32x4*)(p0 + 2048); u32x4 o;
#pragma unroll
                for (int k = 0; k < 4; ++k) o[k] = cvtpk(w0 * bf_lo(a0[k]) + w1 * bf_lo(a1[k]) + w2 * bf_lo(a2[k]), w0 * bf_hi(a0[k]) + w1 * bf_hi(a1[k]) + w2 * bf_hi(a2[k]));
                *(u32x4*)p0 = o;
            }
        } else if (s == 4 && L == 2) {
            const float lam = misc[0]; const bf16_t* OM = S1 + (size_t)MTOK * 3072;
#pragma unroll 1
            for (long it = gt; it < (long)MTOK * 128; it += NGT) {
                const long row = it >> 7; const int hh = (int)(it >> 4) & 7, c16 = (int)it & 15;
                const bf16_t* p1 = OM + row * 2048 + (2 * hh) * 128 + c16 * 8;
                const u32x4 a1 = *(const u32x4*)p1, a2 = *(const u32x4*)(p1 + 128); float o[8]; float ss = 0.f;
#pragma unroll
                for (int k = 0; k < 4; ++k) { o[2 * k] = bf_lo(a1[k]) - lam * bf_lo(a2[k]); o[2 * k + 1] = bf_hi(a1[k]) - lam * bf_hi(a2[k]); ss += o[2 * k] * o[2 * k] + o[2 * k + 1] * o[2 * k + 1]; }
                ss += sx(ss, 1, lane); ss += sx(ss, 2, lane); ss += sx(ss, 4, lane); ss += sx(ss, 8, lane);
                const float r = (1.0f - LAM_INIT) / sqrtf(ss * (1.0f / 128.0f) + 1e-5f);
                const f32x4 g0 = *(const f32x4*)(a.diff_subln + c16 * 8), g1 = *(const f32x4*)(a.diff_subln + c16 * 8 + 4);
                u32x4 w; w.x = cvtpk(o[0] * r * g0[0], o[1] * r * g0[1]); w.y = cvtpk(o[2] * r * g0[2], o[3] * r * g0[3]); w.z = cvtpk(o[4] * r * g1[0], o[5] * r * g1[1]); w.w = cvtpk(o[6] * r * g1[2], o[7] * r * g1[3]);
                *(u32x4*)(S1 + row * 3072 + hh * 128 + c16 * 8) = w;
            }
        } else if (s == 3 && L == 3) {
#pragma unroll 1
            for (int n = bid; n < 2048; n += G) {
                const int chunk = n >> 3, gg = n & 7; const size_t row0 = (size_t)chunk * 128;
                LAS float* rsv = (LAS float*)(lds + 65536);
                if (tid < 128) { const f32x4* sp = (const f32x4*)(ssqV + (row0 + tid) * 32); float sm = 0.f;
#pragma unroll
                    for (int j = 0; j < 8; ++j) { const f32x4 v = sp[j]; sm += (v[0] + v[1]) + (v[2] + v[3]); }
                    rsv[tid] = 1.0f / sqrtf(sm * (1.0f / 2048.0f) + NORM_EPS); }
                __syncthreads();
#pragma unroll 2
                for (int k = 0; k < 8; ++k) {
                    const int item = tid + 512 * k, sr = item >> 5, ch = item & 31;
                    const u32x4 vv = *(const u32x4*)(S1 + (row0 + sr) * 4096 + 2048 + gg * 256 + ch * 8);
                    const f32x4 n0 = *(const f32x4*)(a.sgu_norm_v + gg * 256 + ch * 8), n1 = *(const f32x4*)(a.sgu_norm_v + gg * 256 + ch * 8 + 4); const float r = rsv[sr];
                    u32x4 w; w.x = cvtpk(bf_lo(vv.x) * r * n0[0], bf_hi(vv.x) * r * n0[1]); w.y = cvtpk(bf_lo(vv.y) * r * n0[2], bf_hi(vv.y) * r * n0[3]);
                    w.z = cvtpk(bf_lo(vv.z) * r * n1[0], bf_hi(vv.z) * r * n1[1]); w.w = cvtpk(bf_lo(vv.w) * r * n1[2], bf_hi(vv.w) * r * n1[3]);
                    *(LAS u32x4*)(lds + (sr >> 2) * 2048 + (ch >> 2) * 256 + (sr & 3) * 64 + (ch & 3) * 16) = w;
                }
                __syncthreads();
                {
                    const int r32 = lane & 31, hi = lane >> 5, tb = wave & 3, chalf = wave >> 2, g16 = (lane >> 4) & 1, i16 = lane & 15;
                    const int trow = 32 * tb + r32; const float* wrow = a.sgu_w_s + ((size_t)gg * 128 + trow) * 128;
                    f32x16 acc[4] = {};
                    const int vrd = (2 * hi) * 2048 + (i16 >> 2) * 64 + g16 * 32 + (i16 & 3) * 8;
#pragma unroll 1
                    for (int ks = 0; ks <= 2 * tb + 1; ++ks) {
                        const int s0 = 16 * ks + 8 * hi; const f32x4 w0 = *(const f32x4*)(wrow + s0), w1 = *(const f32x4*)(wrow + s0 + 4); float wv[8];
#pragma unroll
                        for (int j = 0; j < 4; ++j) { wv[j] = (s0 + j <= trow) ? w0[j] : 0.f; wv[4 + j] = (s0 + 4 + j <= trow) ? w1[j] : 0.f; }
                        u32x4 pw; pw.x = cvtpk(wv[0], wv[1]); pw.y = cvtpk(wv[2], wv[3]); pw.z = cvtpk(wv[4], wv[5]); pw.w = cvtpk(wv[6], wv[7]);
                        const bf16x8 pa = __builtin_bit_cast(bf16x8, pw);
#pragma unroll
                        for (int cbl = 0; cbl < 4; ++cbl) {
                            const LAS unsigned char* vp = lds + vrd + ks * 8192 + (chalf * 4 + cbl) * 256;
                            const s16x4 lo = __builtin_bit_cast(s16x4, __builtin_amdgcn_ds_read_tr16_b64_v4i16((LAS s16x4*)vp));
                            const s16x4 hh = __builtin_bit_cast(s16x4, __builtin_amdgcn_ds_read_tr16_b64_v4i16((LAS s16x4*)(vp + 2048)));
                            const bf16x8 vf = (bf16x8){lo[0], lo[1], lo[2], lo[3], hh[0], hh[1], hh[2], hh[3]};
                            acc[cbl] = __builtin_amdgcn_mfma_f32_32x32x16_bf16(pa, vf, acc[cbl], 0, 0, 0);
                        }
                    }
#pragma unroll
                    for (int cbl = 0; cbl < 4; ++cbl)
#pragma unroll
                        for (int r = 0; r < 16; ++r) {
                            const int t = 32 * tb + crow(r, hi); bf16_t* up = S1 + (row0 + t) * 4096 + gg * 256 + (chalf * 4 + cbl) * 32 + r32;
                            const float uval = __uint_as_float((unsigned)(*up) << 16); const float mixed = acc[cbl][r] + a.sgu_b_s[gg * 128 + t];
                            *up = (bf16_t)(cvtpk(uval * mixed, 0.f) & 0xffffu);
                        }
                }
                __syncthreads();
            }
        }
        { FRESH_TID(tid2) grid_bar((unsigned*)(ws + WS_BAR), (unsigned)G, tid2, (unsigned)qq + 1u); }
    }
    PHASE_VARS
#pragma unroll 1
    for (int m = gw; m < MTOK; m += NGW) {
        float sm = lane < 16 ? ssqX[(size_t)m * 16 + lane] : 0.f; sm = wave_sum(sm, lane);
        const float r = 1.0f / sqrtf(sm * (1.0f / DM) + NORM_EPS);
        f32x4* xr = (f32x4*)(h + (size_t)m * DM) + lane; const f32x4* gr = (const f32x4*)a.norm_final + lane;
#pragma unroll
        for (int j = 0; j < 4; ++j) { const f32x4 v = xr[64 * j]; const f32x4 gg = gr[64 * j]; xr[64 * j] = v * r * gg; }
    }
}

extern "C" void kernel_launch(void* const* d_in, const int* in_sizes, int n_in, void* d_out, int out_size, void* d_ws, size_t ws_size, hipStream_t stream) {
    static int grid = 0;
    if (grid == 0) {
        int dev = 0, cus = 0, per_cu = 0;
        hipGetDevice(&dev);
        hipDeviceGetAttribute(&cus, hipDeviceAttributeMultiprocessorCount, dev);
        hipFuncSetAttribute((const void*)mega, hipFuncAttributeMaxDynamicSharedMemorySize, LDS_BYTES);
        hipOccupancyMaxActiveBlocksPerMultiprocessor(&per_cu, (const void*)mega, 512, LDS_BYTES);
        if (per_cu < 1) per_cu = 1;
        grid = cus * per_cu;
        if (ws_size < WS_END) fprintf(stderr, "kernel_launch: workspace too small: %zu < %zu\n", ws_size, (size_t)WS_END);
    }
    hipMemsetAsync((unsigned char*)d_ws + WS_BAR, 0, 1024, stream);
    Args a{};
    const float** pa = (const float**)&a;
    for (int i = 0; i < 28; ++i) pa[i] = (const float*)d_in[i];
    a.out = (float*)d_out; a.ws = (unsigned char*)d_ws;
    void* args[] = {&a};
    hipError_t e = hipLaunchCooperativeKernel((const void*)mega, dim3(grid), dim3(512), args, LDS_BYTES, stream);
    if (e != hipSuccess) fprintf(stderr, "cooperative launch failed: %s (grid %d)\n", hipGetErrorString(e), grid);
}
```

```cpp
#include <hip/hip_runtime.h>
#include <hip/hip_cooperative_groups.h>
#include <cstdint>
#include <cstdio>
namespace cg = cooperative_groups;

#define LAS __attribute__((address_space(3)))
typedef unsigned short bf16_t;
typedef short bf16x8 __attribute__((ext_vector_type(8)));
typedef short s16x4 __attribute__((ext_vector_type(4)));
typedef float f32x4 __attribute__((ext_vector_type(4)));
typedef float f32x2 __attribute__((ext_vector_type(2)));
typedef float f32x16 __attribute__((ext_vector_type(16)));
typedef unsigned u32x4 __attribute__((ext_vector_type(4)));
typedef unsigned u32x2 __attribute__((ext_vector_type(2)));
typedef __bf16 bf16x2_t __attribute__((ext_vector_type(2)));
typedef __attribute__((address_space(1))) unsigned char gbyte_t;

constexpr int MTOK = 32768, SEQ = 4096, DM = 1024, DFF = 2816, PLE = 256;
constexpr float NORM_EPS = 1e-6f;
constexpr float LOG2E = 1.4426950408889634f, LN2 = 0.6931471805599453f;
constexpr float QSCALE = 0.125f * LOG2E;
constexpr float LAM_INIT = 0.47071301834358414f;

constexpr size_t MiB = 1u << 20;
constexpr size_t WS_SSQX = 0, WS_SSQY = 2 * MiB, WS_SSQV = 4 * MiB, WS_LSE = 8 * MiB, WS_FLOG = 14 * MiB, WS_ROPE = 16 * MiB, WS_MISC = 16 * MiB + 512 * 1024, WS_BAR = 16 * MiB + 768 * 1024;
constexpr size_t WS_PBF = 17 * MiB, WS_HB = 33 * MiB, WS_W = 97 * MiB, WS_S1 = 280 * MiB, WS_END = 600 * MiB;
constexpr size_t L_FFN1IN = 0, L_FFN1OUT = 5767168, L_FFN2IN = 8650752, L_FFN2OUT = 14417920, L_PLEG = 17301504, L_PLEP = 18350080, L_SIZE = 18612224;
constexpr size_t W_FOXIN = 4 * L_SIZE, W_FOXOUT = W_FOXIN + 3407872, W_DILIN = W_FOXOUT + 1048576, W_DILOUT = W_DILIN + 5242880, W_DIFFIN = W_DILOUT + 1048576,
                 W_DIFFOUT = W_DIFFIN + 3145728, W_SGUIN = W_DIFFOUT + 1048576, W_SGUOUT = W_SGUIN + 4194304, W_TOTAL = W_SGUOUT + 2097152;
static_assert(WS_W + W_TOTAL * 2 <= WS_S1, "weights fit");

#ifndef PROBE_REP
#define PROBE_REP 0
#endif
constexpr unsigned BARMUL = (PROBE_REP == 9) ? 2u : 1u;
constexpr int NSLOTS = (PROBE_REP == 1) ? 11 : (PROBE_REP == 7 || PROBE_REP == 8) ? 10 : 9;
constexpr int LDS_BYTES = 139264;

__device__ __forceinline__ unsigned cvtpk(float lo, float hi) { f32x2 v = {lo, hi}; bf16x2_t b = __builtin_convertvector(v, bf16x2_t); return __builtin_bit_cast(unsigned, b); }
__device__ __forceinline__ float bf_lo(unsigned w) { return __uint_as_float(w << 16); }
__device__ __forceinline__ float bf_hi(unsigned w) { return __uint_as_float(w & 0xffff0000u); }
__device__ __forceinline__ float sx(float v, int o, int lane) { return __int_as_float(__builtin_amdgcn_ds_bpermute((lane ^ o) << 2, __float_as_int(v))); }
__device__ __forceinline__ float wave_sum(float v, int lane) {
#pragma unroll
    for (int o = 1; o < 64; o <<= 1) v += sx(v, o, lane);
    return v;
}
__device__ __forceinline__ float fast_exp2(float x) { return __builtin_amdgcn_exp2f(x); }
__device__ __forceinline__ float fast_rcp(float x) { return __builtin_amdgcn_rcpf(x); }
__device__ __forceinline__ float sigmoidf_(float x) { return fast_rcp(1.0f + fast_exp2(-x * LOG2E)); }

namespace pg8 {
constexpr int BM = 256, BK = 64, HALF = 128, HTB = HALF * BK * 2, STAGE_BYTES = 8 * HTB, NXCD = 8, WGM = 8;
__host__ __device__ __forceinline__ int lds_byte(int r, int c) { const int st = (r >> 4) * 2 + (c >> 5), rr = r & 15, cc = c & 31, ob = rr * 64 + cc * 2; return st * 1024 + (ob ^ (((ob >> 9) & 1) << 5)); }
__host__ __device__ __forceinline__ void stage_rc(int b, int& R, int& C) { const int st = b / 1024, sb = b % 1024, swz = sb ^ (((sb >> 9) & 1) << 5); R = (st >> 1) * 16 + swz / 64; C = (st & 1) * 32 + (swz % 64) / 2; }
__host__ __device__ __forceinline__ int perm32(int rho) { const int n = rho >> 4, i = rho & 15; return 8 * (i >> 2) + 4 * n + (i & 3); }
struct Unit { int pm, pn; };
struct Gemm { const bf16_t* A; const bf16_t* Bt; int M, N, K, lda; };
struct StaticOrder {
    int nM, nN, nwg, G, c;
    __device__ void init(int M, int N, int G_, int c_) { nM = M / BM; nN = N / BM; nwg = nM * nN; G = G_; c = c_; }
    __device__ bool next(int i, Unit& u) const {
        const long L = (long)i * G + c; if (L >= nwg) return false;
        int wgid = (int)L; { const int q = nwg / NXCD, r = nwg % NXCD, xcd = wgid % NXCD, off = wgid / NXCD; wgid = (xcd < r ? xcd * (q + 1) : r * (q + 1) + (xcd - r) * q) + off; }
        const int nig = WGM * nN, gid = wgid / nig, fm = gid * WGM, gsz = (nM - fm) < WGM ? (nM - fm) : WGM;
        u.pm = fm + ((wgid % nig) % gsz); u.pn = (wgid % nig) / gsz; return true;
    }
};
template <class Epi>
__device__ __forceinline__ void gemm_phase(LAS unsigned char* lds, const int tid, const Gemm g, const StaticOrder& S, const Epi& E) {
    const int wid = __builtin_amdgcn_readfirstlane(tid >> 6), lane = tid & 63, wr = wid >> 2, wc = wid & 3, fr = lane & 15, fq = lane >> 4;
    const int K = g.K, nt = K / BK, lda = g.lda;
    unsigned voffA[2], voffB[2];
#pragma unroll
    for (int i = 0; i < 2; ++i) { int R, C; stage_rc(tid * 16 + i * 8192, R, C); const int Rb = Epi::PERM ? ((R & ~31) + perm32(R & 31)) : R;
        voffA[i] = (unsigned)(R * lda + C) * 2u; voffB[i] = (unsigned)(Rb * K + C) * 2u; }
    const size_t kstep = (size_t)(BK * 2);
    const size_t hstepA = (size_t)HALF * lda * 2, hstepB = (size_t)HALF * K * 2;
    const size_t tstepA = 2 * hstepA, tstepB = 2 * hstepB;
    const unsigned ldsw = (unsigned)wid * 1024u;
    const int aoff = lds_byte(wr * 64 + fr, fq * 8), boff = lds_byte(wc * 32 + fr, fq * 8);
#define PG8_SA(b, h) (((b) * 2 + (h)) * HTB)
#define PG8_SB(b, h) ((4 + (b) * 2 + (h)) * HTB)
#define PG8_STAGE(bufoff, gbase, voff) do { _Pragma("unroll") for (int _i = 0; _i < 2; ++_i) \
        __builtin_amdgcn_global_load_lds((const unsigned*)((const char*)(gbase) + (voff)[_i]), (LAS unsigned*)(lds + (bufoff) + ldsw + _i * 8192), 16, 0, 0); } while (0)
#define PG8_LDA(dst, b, h) do { _Pragma("unroll") for (int m = 0; m < 4; ++m) _Pragma("unroll") for (int k = 0; k < 2; ++k) dst[m][k] = *(const LAS bf16x8*)(lds + PG8_SA(b, h) + aoff + m * 2048 + k * 1024); } while (0)
#define PG8_LDB(dst, b, h) do { _Pragma("unroll") for (int n = 0; n < 2; ++n) _Pragma("unroll") for (int k = 0; k < 2; ++k) dst[n][k] = *(const LAS bf16x8*)(lds + PG8_SB(b, h) + boff + n * 2048 + k * 1024); } while (0)
#define PG8_MMA(ai, bj, At, Bt) do { __builtin_amdgcn_s_setprio(1); _Pragma("unroll") for (int m = 0; m < 4; ++m) _Pragma("unroll") for (int n = 0; n < 2; ++n) _Pragma("unroll") for (int k = 0; k < 2; ++k) \
        acc[ai][bj][m][n] = __builtin_amdgcn_mfma_f32_16x16x32_bf16(Bt[n][k], At[m][k], acc[ai][bj][m][n], 0, 0, 0); __builtin_amdgcn_s_setprio(0); } while (0)
#define PG8_WAIT_V(n) asm volatile("s_waitcnt vmcnt(" #n ")" ::: "memory")
#define PG8_WAIT_L(n) asm volatile("s_waitcnt lgkmcnt(" #n ")" ::: "memory")
#define PG8_BAR __builtin_amdgcn_s_barrier()
#define PG8_SCHED __builtin_amdgcn_sched_barrier(0)
    Unit cur, nxt; int ui = 0;
    if (!S.next(0, cur)) return;
    f32x4 acc[2][2][4][2];
#pragma unroll
    for (int a = 0; a < 2; ++a)
#pragma unroll
        for (int b = 0; b < 2; ++b)
#pragma unroll
            for (int m = 0; m < 4; ++m)
#pragma unroll
                for (int n = 0; n < 2; ++n) acc[a][b][m][n] = (f32x4){0.f, 0.f, 0.f, 0.f};
    bf16x8 At[4][2], B0[2][2], B1[2][2];
    const char* cA = (const char*)g.A + (size_t)cur.pm * tstepA; const char* cB = (const char*)g.Bt + (size_t)cur.pn * tstepB;
    PG8_STAGE(PG8_SB(0, 0), cB, voffB); PG8_STAGE(PG8_SB(0, 1), cB + hstepB, voffB); PG8_STAGE(PG8_SA(0, 0), cA, voffA); PG8_STAGE(PG8_SA(0, 1), cA + hstepA, voffA);
    if (wr == 1) PG8_BAR;
    PG8_WAIT_V(2); PG8_BAR;
    PG8_STAGE(PG8_SB(1, 0), cB + kstep, voffB); PG8_STAGE(PG8_SA(1, 0), cA + kstep, voffA); PG8_STAGE(PG8_SB(1, 1), cB + hstepB + kstep, voffB);
    PG8_WAIT_V(6); PG8_BAR;
    for (;;) {
        const bool has_next = S.next(ui + 1, nxt);
        const char* nA = has_next ? (const char*)g.A + (size_t)nxt.pm * tstepA : cA; const char* nB = has_next ? (const char*)g.Bt + (size_t)nxt.pn * tstepB : cB;
        for (int t = 0; t < nt; t += 2) {
            const bool last = (t == nt - 2);
            const char* a1 = cA + (size_t)(t + 1) * kstep;
            const char* a2 = last ? nA : cA + (size_t)(t + 2) * kstep; const char* b2 = last ? nB : cB + (size_t)(t + 2) * kstep;
            const char* a3 = a2 + kstep; const char* b3 = b2 + kstep;
            PG8_LDB(B0, 0, 0); PG8_LDB(B1, 0, 1); PG8_SCHED; PG8_LDA(At, 0, 0); PG8_STAGE(PG8_SA(1, 1), a1 + hstepA, voffA);
            PG8_WAIT_V(8); PG8_WAIT_L(0); PG8_BAR; PG8_MMA(0, 0, At, B0); PG8_MMA(0, 1, At, B1); PG8_BAR; PG8_SCHED;
            PG8_LDA(At, 0, 1); PG8_STAGE(PG8_SB(0, 0), b2, voffB); PG8_STAGE(PG8_SB(0, 1), b2 + hstepB, voffB); PG8_STAGE(PG8_SA(0, 0), a2, voffA);
            PG8_WAIT_V(8); PG8_WAIT_L(0); PG8_BAR; PG8_MMA(1, 0, At, B0); PG8_MMA(1, 1, At, B1); PG8_BAR; PG8_SCHED;
            PG8_LDB(B0, 1, 0); PG8_LDB(B1, 1, 1); PG8_SCHED; PG8_LDA(At, 1, 0); PG8_STAGE(PG8_SA(0, 1), a2 + hstepA, voffA);
            PG8_WAIT_V(8); PG8_WAIT_L(0); PG8_BAR; PG8_MMA(0, 0, At, B0); PG8_MMA(0, 1, At, B1); PG8_BAR; PG8_SCHED;
            PG8_LDA(At, 1, 1); PG8_STAGE(PG8_SB(1, 0), b3, voffB); PG8_STAGE(PG8_SB(1, 1), b3 + hstepB, voffB); PG8_STAGE(PG8_SA(1, 0), a3, voffA);
            PG8_WAIT_V(8); PG8_WAIT_L(0); PG8_BAR; PG8_MMA(1, 0, At, B0); PG8_MMA(1, 1, At, B1); PG8_BAR; PG8_SCHED;
        }
        if (wr == 0) PG8_BAR;
        E(acc, cur, wr, wc, fr, fq);
        if (!has_next) break;
#pragma unroll
        for (int a = 0; a < 2; ++a)
#pragma unroll
            for (int b = 0; b < 2; ++b)
#pragma unroll
                for (int m = 0; m < 4; ++m)
#pragma unroll
                    for (int n = 0; n < 2; ++n) acc[a][b][m][n] = (f32x4){0.f, 0.f, 0.f, 0.f};
        cur = nxt; cA = nA; cB = nB; ++ui;
        if (wr == 1) PG8_BAR;
    }
    PG8_WAIT_V(0);
    PG8_BAR;
#undef PG8_SA
#undef PG8_SB
#undef PG8_STAGE
#undef PG8_LDA
#undef PG8_LDB
#undef PG8_MMA
#undef PG8_WAIT_V
#undef PG8_WAIT_L
#undef PG8_BAR
#undef PG8_SCHED
}
}
using pg8::Unit;

__device__ __forceinline__ void row_rstd8(const float* ssq, int row0, int fq, int lane, float (&rs)[8]) {
#pragma unroll
    for (int ai = 0; ai < 2; ++ai)
#pragma unroll
        for (int m = 0; m < 4; ++m) {
            const f32x4 v = *(const f32x4*)(ssq + (size_t)(row0 + 128 * ai + 16 * m) * 16 + 4 * fq);
            float s = (v[0] + v[1]) + (v[2] + v[3]); s += sx(s, 16, lane); s += sx(s, 32, lane);
            rs[ai * 4 + m] = 1.0f / sqrtf(s * (1.0f / DM) + NORM_EPS);
        }
}
__device__ __forceinline__ float gelu_erf(float v) {
    const float av = fabsf(v), t = fast_rcp(av * 0.2316418882f + 1.0f);
    float q = t * 0.5307027145f + (-0.7265760135f); q = q * t + 0.7107068705f; q = q * t + (-0.142248368f); q = q * t + 0.127414796f; q = q * t;
    const float e = fast_exp2((v * v) * (-0.72134752044f));
    const float m = v * (q * e);
    return v < 0.f ? m : v - m;
}

struct EpiSwiglu {
    static constexpr bool PERM = true;
    const float* ssq; bf16_t* H;
    __device__ __forceinline__ void operator()(const f32x4 (&acc)[2][2][4][2], const Unit& u, int wr, int wc, int fr_, int fq_) const {
        (void)fr_; (void)fq_; unsigned o_ = ~0u; asm volatile("" : "+s"(o_)); const int lane = (int)__builtin_amdgcn_mbcnt_hi(o_, __builtin_amdgcn_mbcnt_lo(o_, 0u)); const int fr = lane & 15, fq = lane >> 4;
        const int row0 = u.pm * 256 + wr * 64 + fr, col0 = u.pn * 128 + wc * 32 + 8 * fq;
        float rs[8]; row_rstd8(ssq, row0, fq, fq * 16 + fr, rs);
#pragma unroll
        for (int ai = 0; ai < 2; ++ai)
#pragma unroll
            for (int m = 0; m < 4; ++m) {
                const float r = rs[ai * 4 + m]; float o[8];
#pragma unroll
                for (int n = 0; n < 2; ++n)
#pragma unroll
                    for (int i = 0; i < 4; ++i) { const float gt = acc[ai][0][m][n][i] * r, up = acc[ai][1][m][n][i] * r; o[n * 4 + i] = gt * sigmoidf_(gt) * up; }
                u32x4 w; w.x = cvtpk(o[0], o[1]); w.y = cvtpk(o[2], o[3]); w.z = cvtpk(o[4], o[5]); w.w = cvtpk(o[6], o[7]);
                *(u32x4*)(H + (size_t)(row0 + 128 * ai + 16 * m) * DFF + col0) = w;
            }
    }
};
struct EpiResid {
    static constexpr bool PERM = false;
    const float* base; float* out; bf16_t* hb; float* ssq; float scale;
    __device__ __forceinline__ void operator()(const f32x4 (&acc)[2][2][4][2], const Unit& u, int wr, int wc, int fr_, int fq_) const {
        (void)fr_; (void)fq_; unsigned o_ = ~0u; asm volatile("" : "+s"(o_)); const int lane = (int)__builtin_amdgcn_mbcnt_hi(o_, __builtin_amdgcn_mbcnt_lo(o_, 0u)); const int fr = lane & 15, fq = lane >> 4;
        const int row0 = u.pm * 256 + wr * 64 + fr, col0 = u.pn * 256 + wc * 32 + 4 * fq;
#pragma unroll
        for (int ai = 0; ai < 2; ++ai) {
            f32x4 bs[4][2][2];
#pragma unroll
            for (int m = 0; m < 4; ++m)
#pragma unroll
                for (int bj = 0; bj < 2; ++bj)
#pragma unroll
                    for (int n = 0; n < 2; ++n) bs[m][bj][n] = *(const f32x4*)(base + (size_t)(row0 + 128 * ai + 16 * m) * DM + col0 + bj * 128 + n * 16);
            asm volatile("" ::: "memory");
#pragma unroll
            for (int m = 0; m < 4; ++m) {
                const int row = row0 + 128 * ai + 16 * m; const size_t off = (size_t)row * DM + col0; float ss = 0.f;
#pragma unroll
                for (int bj = 0; bj < 2; ++bj)
#pragma unroll
                    for (int n = 0; n < 2; ++n) {
                        const size_t o2 = off + bj * 128 + n * 16;
                        const f32x4 o = bs[m][bj][n] + acc[ai][bj][m][n] * scale;
                        *(f32x4*)(out + o2) = o; ss += (o[0] * o[0] + o[1] * o[1]) + (o[2] * o[2] + o[3] * o[3]);
                        u32x2 w; w.x = cvtpk(o[0], o[1]); w.y = cvtpk(o[2], o[3]); *(u32x2*)(hb + o2) = w;
                    }
                ss += sx(ss, 16, lane); ss += sx(ss, 32, lane);
                if (fq == 0) ssq[(size_t)row * 16 + u.pn * 4 + wc] = ss;
            }
            asm volatile("" ::: "memory");
        }
    }
};
struct EpiPleGate {
    static constexpr bool PERM = false;
    const float* ssq_in; const float* h; float* hout; bf16_t* hb; float* ssq_out; const float* bg; const bf16_t* pp;
    __device__ __forceinline__ void operator()(const f32x4 (&acc)[2][2][4][2], const Unit& u, int wr, int wc, int fr_, int fq_) const {
        (void)fr_; (void)fq_; unsigned o_ = ~0u; asm volatile("" : "+s"(o_)); const int lane = (int)__builtin_amdgcn_mbcnt_hi(o_, __builtin_amdgcn_mbcnt_lo(o_, 0u)); const int fr = lane & 15, fq = lane >> 4;
        const int row0 = u.pm * 256 + wr * 64 + fr, col0 = u.pn * 256 + wc * 32 + 4 * fq;
        float rs[8]; row_rstd8(ssq_in, row0, fq, lane, rs);
#pragma unroll
        for (int ai = 0; ai < 2; ++ai)
#pragma unroll
        for (int mp = 0; mp < 2; ++mp) {
            f32x4 bs[2][2][2]; u32x2 pw[2][2][2];
#pragma unroll
            for (int mm = 0; mm < 2; ++mm)
#pragma unroll
                for (int bj = 0; bj < 2; ++bj)
#pragma unroll
                    for (int n = 0; n < 2; ++n) { const size_t o2 = (size_t)(row0 + 128 * ai + 16 * (2 * mp + mm)) * DM + col0 + bj * 128 + n * 16; bs[mm][bj][n] = *(const f32x4*)(h + o2); pw[mm][bj][n] = *(const u32x2*)(pp + o2); }
            asm volatile("" ::: "memory");
#pragma unroll
            for (int mm = 0; mm < 2; ++mm) {
                const int m = 2 * mp + mm;
                const int row = row0 + 128 * ai + 16 * m; const size_t off = (size_t)row * DM + col0; float ss = 0.f; const float r = rs[ai * 4 + m];
#pragma unroll
                for (int bj = 0; bj < 2; ++bj)
#pragma unroll
                    for (int n = 0; n < 2; ++n) {
                        const size_t o2 = off + bj * 128 + n * 16; const f32x4 b = bs[mm][bj][n]; const u32x2 p2 = pw[mm][bj][n];
                        const f32x4 bbv = *(const f32x4*)(bg + col0 + bj * 128 + n * 16);
                        f32x4 o;
                        o[0] = b[0] + sigmoidf_(acc[ai][bj][m][n][0] * r + bbv[0]) * bf_lo(p2.x);
                        o[1] = b[1] + sigmoidf_(acc[ai][bj][m][n][1] * r + bbv[1]) * bf_hi(p2.x);
                        o[2] = b[2] + sigmoidf_(acc[ai][bj][m][n][2] * r + bbv[2]) * bf_lo(p2.y);
                        o[3] = b[3] + sigmoidf_(acc[ai][bj][m][n][3] * r + bbv[3]) * bf_hi(p2.y);
                        *(f32x4*)(hout + o2) = o; ss += (o[0] * o[0] + o[1] * o[1]) + (o[2] * o[2] + o[3] * o[3]);
                        u32x2 w; w.x = cvtpk(o[0], o[1]); w.y = cvtpk(o[2], o[3]); *(u32x2*)(hb + o2) = w;
                    }
                ss += sx(ss, 16, lane); ss += sx(ss, 32, lane);
                if (fq == 0) ssq_out[(size_t)row * 16 + u.pn * 4 + wc] = ss;
            }
            asm volatile("" ::: "memory");
        }
    }
};
struct EpiBf16 {
    static constexpr bool PERM = true;
    bf16_t* O; int ldo;
    __device__ __forceinline__ void operator()(const f32x4 (&acc)[2][2][4][2], const Unit& u, int wr, int wc, int fr_, int fq_) const {
        (void)fr_; (void)fq_; unsigned o_ = ~0u; asm volatile("" : "+s"(o_)); const int lane = (int)__builtin_amdgcn_mbcnt_hi(o_, __builtin_amdgcn_mbcnt_lo(o_, 0u)); const int fr = lane & 15, fq = lane >> 4;
        const int row0 = u.pm * 256 + wr * 64 + fr, col0 = u.pn * 256 + wc * 32 + 8 * fq;
#pragma unroll
        for (int ai = 0; ai < 2; ++ai)
#pragma unroll
            for (int m = 0; m < 4; ++m)
#pragma unroll
                for (int bj = 0; bj < 2; ++bj) {
                    const f32x4 v0 = acc[ai][bj][m][0], v1 = acc[ai][bj][m][1];
                    u32x4 w; w.x = cvtpk(v0[0], v0[1]); w.y = cvtpk(v0[2], v0[3]); w.z = cvtpk(v1[0], v1[1]); w.w = cvtpk(v1[2], v1[3]);
                    *(u32x4*)(O + (size_t)(row0 + 128 * ai + 16 * m) * ldo + col0 + bj * 128) = w;
                }
    }
};
struct EpiQkv {
    static constexpr bool PERM = true;
    const float* ssq; bf16_t* O; int ldo; int qs_end, rope_end, fg_tile; const f32x2* rope; const float* bf; float* flog;
    __device__ __forceinline__ void operator()(const f32x4 (&acc)[2][2][4][2], const Unit& u, int wr, int wc, int fr_, int fq_) const {
        (void)fr_; (void)fq_; unsigned o_ = ~0u; asm volatile("" : "+s"(o_)); const int lane = (int)__builtin_amdgcn_mbcnt_hi(o_, __builtin_amdgcn_mbcnt_lo(o_, 0u)); const int fr = lane & 15, fq = lane >> 4;
        const int row0 = u.pm * 256 + wr * 64 + fr, colt = u.pn * 256;
        float rs[8]; row_rstd8(ssq, row0, fq, fq * 16 + fr, rs);
        if (u.pn == fg_tile) {
            if (wc == 0 && fq < 2) {
                const f32x4 b0 = *(const f32x4*)(bf + 8 * fq), b1 = *(const f32x4*)(bf + 8 * fq + 4);
#pragma unroll
                for (int ai = 0; ai < 2; ++ai)
#pragma unroll
                    for (int m = 0; m < 4; ++m) {
                        const float r = rs[ai * 4 + m]; f32x4 o0, o1;
#pragma unroll
                        for (int i = 0; i < 4; ++i) {
                            const float x0 = acc[ai][0][m][0][i] * r + b0[i], x1 = acc[ai][0][m][1][i] * r + b1[i];
                            o0[i] = fminf(x0, 0.f) - logf(1.0f + expf(-fabsf(x0))); o1[i] = fminf(x1, 0.f) - logf(1.0f + expf(-fabsf(x1)));
                        }
                        float* p = flog + (size_t)(row0 + 128 * ai + 16 * m) * 16 + 8 * fq;
                        *(f32x4*)p = o0; *(f32x4*)(p + 4) = o1;
                    }
            }
            return;
        }
        const float sc = colt < qs_end ? QSCALE : 1.0f;
        const bool do_rope = (colt < rope_end) && ((wc & 1) == 0);
        const float sgn = fq == 0 ? -1.0f : 1.0f;
#pragma unroll
        for (int ai = 0; ai < 2; ++ai)
#pragma unroll
            for (int m = 0; m < 4; ++m) {
                const int row = row0 + 128 * ai + 16 * m; const float r = rs[ai * 4 + m] * sc;
                f32x4 cs[4];
                if (do_rope) { const f32x4* tp = (const f32x4*)(rope + (size_t)(row & (SEQ - 1)) * 8);
#pragma unroll
                    for (int j = 0; j < 4; ++j) cs[j] = tp[j]; }
#pragma unroll
                for (int bj = 0; bj < 2; ++bj) {
                    f32x4 v0 = acc[ai][bj][m][0] * r, v1 = acc[ai][bj][m][1] * r;
                    if (do_rope) {
                        f32x4 p0, p1;
#pragma unroll
                        for (int i = 0; i < 4; ++i) { p0[i] = sx(v0[i], 16, lane); p1[i] = sx(v1[i], 16, lane); }
                        if (fq < 2) {
                            v0[0] = v0[0] * cs[0][0] + sgn * p0[0] * cs[0][1]; v0[1] = v0[1] * cs[0][2] + sgn * p0[1] * cs[0][3];
                            v0[2] = v0[2] * cs[1][0] + sgn * p0[2] * cs[1][1]; v0[3] = v0[3] * cs[1][2] + sgn * p0[3] * cs[1][3];
                            v1[0] = v1[0] * cs[2][0] + sgn * p1[0] * cs[2][1]; v1[1] = v1[1] * cs[2][2] + sgn * p1[1] * cs[2][3];
                            v1[2] = v1[2] * cs[3][0] + sgn * p1[2] * cs[3][1]; v1[3] = v1[3] * cs[3][2] + sgn * p1[3] * cs[3][3];
                        }
                    }
                    u32x4 w; w.x = cvtpk(v0[0], v0[1]); w.y = cvtpk(v0[2], v0[3]); w.z = cvtpk(v1[0], v1[1]); w.w = cvtpk(v1[2], v1[3]);
                    *(u32x4*)(O + (size_t)row * ldo + colt + bj * 128 + wc * 32 + 8 * fq) = w;
                }
            }
    }
};
struct EpiSguIn {
    static constexpr bool PERM = true;
    const float* ssq; bf16_t* O; float* ssqv;
    __device__ __forceinline__ void operator()(const f32x4 (&acc)[2][2][4][2], const Unit& u, int wr, int wc, int fr_, int fq_) const {
        (void)fr_; (void)fq_; unsigned o_ = ~0u; asm volatile("" : "+s"(o_)); const int lane = (int)__builtin_amdgcn_mbcnt_hi(o_, __builtin_amdgcn_mbcnt_lo(o_, 0u)); const int fr = lane & 15, fq = lane >> 4;
        const int row0 = u.pm * 256 + wr * 64 + fr, col0 = u.pn * 256 + wc * 32 + 8 * fq;
        float rs[8]; row_rstd8(ssq, row0, fq, fq * 16 + fr, rs);
#pragma unroll
        for (int ai = 0; ai < 2; ++ai)
#pragma unroll
            for (int m = 0; m < 4; ++m) {
                const int row = row0 + 128 * ai + 16 * m; const float r = rs[ai * 4 + m]; float ss = 0.f;
#pragma unroll
                for (int bj = 0; bj < 2; ++bj) {
                    float o[8];
#pragma unroll
                    for (int n = 0; n < 2; ++n)
#pragma unroll
                        for (int i = 0; i < 4; ++i) { const float gv = gelu_erf(acc[ai][bj][m][n][i] * r); o[n * 4 + i] = gv; ss += gv * gv; }
                    u32x4 w; w.x = cvtpk(o[0], o[1]); w.y = cvtpk(o[2], o[3]); w.z = cvtpk(o[4], o[5]); w.w = cvtpk(o[6], o[7]);
                    *(u32x4*)(O + (size_t)row * 4096 + col0 + bj * 128) = w;
                }
                if (u.pn >= 8) { ss += sx(ss, 16, lane); ss += sx(ss, 32, lane); if (fq == 0) ssqv[(size_t)row * 32 + (u.pn - 8) * 4 + wc] = ss; }
            }
    }
};

struct AttnJob {
    const bf16_t* Q; const bf16_t* K; const bf16_t* V; bf16_t* O;
    long pitch, opitch;
    const float* bias; int bstride;
    float* lse; int lstride;
    int q0, window;
};
constexpr int A_K = 0, A_V = 32768, A_B = 98304, A_WS = 114688, A_NB = 4;
__device__ __forceinline__ int crow(int r, int hi) { return (r & 3) + 8 * (r >> 2) + 4 * hi; }
__device__ __forceinline__ float max3f(float a, float b, float c) { float r; asm("v_max3_f32 %0, %1, %2, %3" : "=v"(r) : "v"(a), "v"(b), "v"(c)); return r; }
#define A_WAITV(n) asm volatile("s_waitcnt vmcnt(" #n ")" ::: "memory")
__device__ __forceinline__ void glds16(const void* gsrc, unsigned lds_dst) { unsigned keep;
    asm volatile("s_mov_b32 %0, m0\n\ts_mov_b32 m0, %2\n\ts_nop 0\n\tglobal_load_lds_dwordx4 %1, off\n\ts_mov_b32 m0, %0" : "=&s"(keep) : "v"(gsrc), "s"(lds_dst) : "memory"); }

#ifndef ATT_SGB
#define ATT_SGB 1
#endif
template <int NDB, bool BIAS>
__device__ __forceinline__ void attn_unit(LAS unsigned char* lds, const int tid, const AttnJob& J) {
    constexpr int VGRP = NDB * 256, VBUF = 16 * VGRP, NVD = NDB / 2;
    const int lane = tid & 63, r32 = lane & 31, hi = lane >> 5; const int wid = __builtin_amdgcn_readfirstlane(tid >> 6);
    const int q0 = J.q0, W = J.window;
    const int t_lo = (q0 - W > 0 ? q0 - W : 0) >> 6, t_hi = (q0 + 255) >> 6, nt = t_hi - t_lo + 1;
    const int qw = q0 + 32 * wid;
    const int tw_lo = (qw - W > 0 ? qw - W : 0) >> 6, tw_hi = (qw + 31) >> 6;
    const int qrow = qw + r32;
    bf16x8 qr[4];
    { const bf16_t* qp = J.Q + (long)qrow * J.pitch + hi * 8;
#pragma unroll
      for (int d0 = 0; d0 < 4; ++d0) qr[d0] = *(const bf16x8*)(qp + d0 * 16); }
    if (BIAS) { for (int k = t_lo * 64 + tid; k < (t_hi + 1) * 64; k += 512) *(LAS float*)(lds + A_B + (k - t_lo * 64) * 4) = J.bias[(long)k * J.bstride] * (-1.0f / QSCALE); }
    const bf16_t* kg = J.K + (long)(8 * wid + (lane >> 3)) * J.pitch + (((lane & 7) ^ (lane >> 3)) * 8);
    const bf16_t* vg[NVD];
#pragma unroll
    for (int j = 0; j < NVD; ++j) { const int B = (wid + 8 * j) * 1024 + lane * 16; const int kv = 4 * (B / VGRP) + ((B >> 6) & 3), d = 32 * ((B % VGRP) >> 8) + 8 * ((B >> 4) & 3);
        vg[j] = J.V + (long)kv * J.pitch + d; }
    const long tstride = 64 * J.pitch;
    const unsigned lds0 = (unsigned)(uintptr_t)lds;
#define A_DMA(t_) do { const int t__ = (t_); const int bf__ = t__ & 3; \
        glds16(kg + (long)t__ * tstride, (unsigned)__builtin_amdgcn_readfirstlane(lds0 + A_K + bf__ * 8192 + wid * 1024)); \
        _Pragma("unroll") for (int j_ = 0; j_ < NVD; ++j_) \
            glds16(vg[j_] + (long)t__ * tstride, (unsigned)__builtin_amdgcn_readfirstlane(lds0 + A_V + bf__ * VBUF + (wid + 8 * j_) * 1024)); } while (0)
    LAS float* wsf = (LAS float*)(lds + A_WS) + wid * 64;
    A_WAITV(0);
    asm volatile("" :: "v"(qr[0]), "v"(qr[1]), "v"(qr[2]), "v"(qr[3]));
    A_DMA(t_lo); if (nt > 1) A_DMA(t_lo + 1);
    float m_run = -1e30f, l_run = 0.f, alpha_prev = 1.0f; f32x16 o[NDB], pe0 = {}, pe1 = {};
#pragma unroll
    for (int db = 0; db < NDB; ++db) o[db] = (f32x16){};
    const int g16 = (lane >> 4) & 1, i16 = lane & 15;
    const int vrd = A_V + hi * VGRP + (i16 >> 2) * 64 + g16 * 32 + (i16 & 3) * 8;
    const int krd = A_K + r32 * 128;
    const int ksw = r32 & 7;
#define A_RESCALE() do { if (__any(alpha_prev != 1.0f)) { if (hi == 0) wsf[r32] = alpha_prev; \
        _Pragma("unroll") for (int g = 0; g < 4; ++g) { const f32x4 a_ = *(const LAS f32x4*)(wsf + 8 * g + 4 * hi); \
            _Pragma("unroll") for (int db = 0; db < NDB; ++db) _Pragma("unroll") for (int i = 0; i < 4; ++i) o[db][4 * g + i] *= a_[i]; } } } while (0)
#define A_SUMPACK(ls_, pa_) do { f32x2 a2_ = {0.f, 0.f}, b2_ = {0.f, 0.f}; _Pragma("unroll") for (int r = 0; r < 8; ++r) { a2_ += (f32x2){pe0[2 * r], pe0[2 * r + 1]}; b2_ += (f32x2){pe1[2 * r], pe1[2 * r + 1]}; } a2_ += b2_; ls_ = a2_[0] + a2_[1]; \
        _Pragma("unroll") for (int s_ = 0; s_ < 2; ++s_) { u32x4 w0, w1; \
            w0.x = cvtpk(pe0[8 * s_ + 0], pe0[8 * s_ + 1]); w0.y = cvtpk(pe0[8 * s_ + 2], pe0[8 * s_ + 3]); w0.z = cvtpk(pe0[8 * s_ + 4], pe0[8 * s_ + 5]); w0.w = cvtpk(pe0[8 * s_ + 6], pe0[8 * s_ + 7]); \
            w1.x = cvtpk(pe1[8 * s_ + 0], pe1[8 * s_ + 1]); w1.y = cvtpk(pe1[8 * s_ + 2], pe1[8 * s_ + 3]); w1.z = cvtpk(pe1[8 * s_ + 4], pe1[8 * s_ + 5]); w1.w = cvtpk(pe1[8 * s_ + 6], pe1[8 * s_ + 7]); \
            pa_[s_] = __builtin_bit_cast(bf16x8, w0); pa_[2 + s_] = __builtin_bit_cast(bf16x8, w1); } } while (0)
#define A_PV(pa_, vb_) do { _Pragma("unroll") for (int s_ = 0; s_ < 4; ++s_) { bf16x8 vf_[NDB]; \
        _Pragma("unroll") for (int db = 0; db < NDB; ++db) { const LAS unsigned char* vp = lds + vrd + (vb_) * VBUF + s_ * 4 * VGRP + db * 256; \
            const s16x4 lo_ = __builtin_bit_cast(s16x4, __builtin_amdgcn_ds_read_tr16_b64_v4i16((LAS s16x4*)vp)); \
            const s16x4 hh_ = __builtin_bit_cast(s16x4, __builtin_amdgcn_ds_read_tr16_b64_v4i16((LAS s16x4*)(vp + 2 * VGRP))); \
            vf_[db] = (bf16x8){lo_[0], lo_[1], lo_[2], lo_[3], hh_[0], hh_[1], hh_[2], hh_[3]}; } \
        _Pragma("unroll") for (int db = 0; db < NDB; ++db) o[db] = __builtin_amdgcn_mfma_f32_32x32x16_bf16(pa_[s_], vf_[db], o[db], 0, 0, 0); } } while (0)
#pragma unroll 1
    for (int it = 0; it < nt; ++it) {
        const int t = t_lo + it, cur = t & 3;
        if (it + 1 < nt) { if (NDB == 2) A_WAITV(2); else A_WAITV(3); } else A_WAITV(0);
        asm volatile("s_waitcnt lgkmcnt(0)" ::: "memory");
        __builtin_amdgcn_s_barrier();
        asm volatile("" ::: "memory");
        if (it + 2 < nt) A_DMA(t + 2);
        if (t >= tw_lo && t <= tw_hi) {
            const LAS unsigned char* Kb = lds + krd + cur * 8192;
            bf16x8 kf[8];
#pragma unroll
            for (int d0 = 0; d0 < 4; ++d0) { const int off = ((2 * d0 + hi) ^ ksw) << 4; kf[2 * d0] = *(const LAS bf16x8*)(Kb + off); kf[2 * d0 + 1] = *(const LAS bf16x8*)(Kb + 4096 + off); }
            f32x16 p0, p1;
            if (BIAS) {
                const LAS float* bb = (const LAS float*)(lds + A_B + it * 256);
#pragma unroll
                for (int g = 0; g < 4; ++g) { const f32x4 b0 = *(const LAS f32x4*)(bb + 8 * g + 4 * hi), b1 = *(const LAS f32x4*)(bb + 32 + 8 * g + 4 * hi);
#pragma unroll
                    for (int i = 0; i < 4; ++i) { p0[4 * g + i] = b0[i]; p1[4 * g + i] = b1[i]; } }
            }
            float ls; bf16x8 pa[4];
#pragma unroll
            for (int d0 = 0; d0 < 4; ++d0) {
                if (!BIAS && d0 == 0) {
                    const f32x16 z = {};
                    p0 = __builtin_amdgcn_mfma_f32_32x32x16_bf16(kf[0], qr[0], z, 0, 0, 0);
                    p1 = __builtin_amdgcn_mfma_f32_32x32x16_bf16(kf[1], qr[0], z, 0, 0, 0);
                } else {
                    p0 = __builtin_amdgcn_mfma_f32_32x32x16_bf16(kf[2 * d0], qr[d0], p0, 0, 0, 0);
                    p1 = __builtin_amdgcn_mfma_f32_32x32x16_bf16(kf[2 * d0 + 1], qr[d0], p1, 0, 0, 0);
                }
            }
            A_SUMPACK(ls, pa);
#if ATT_SGB
#pragma unroll
            for (int i = 0; i < 8; ++i) { __builtin_amdgcn_sched_group_barrier(0x008, 1, 0); __builtin_amdgcn_sched_group_barrier(0x002, 4, 0); }
#endif
            l_run += ls;
            f32x2 q0[8], q1[8];
#pragma unroll
            for (int r = 0; r < 8; ++r) { q0[r] = (f32x2){p0[2 * r], p0[2 * r + 1]} * QSCALE; q1[r] = (f32x2){p1[2 * r], p1[2 * r + 1]} * QSCALE; }
            const int kv0 = t * 64;
            const bool need_mask = (kv0 + 63 > qw) || (qw + 31 - kv0 > W);
            if (need_mask) {
#pragma unroll
                for (int r = 0; r < 16; ++r) { const int kv = kv0 + crow(r, hi);
                    if (kv > qrow || qrow - kv > W) q0[r >> 1][r & 1] = -INFINITY;
                    if (kv + 32 > qrow || qrow - kv - 32 > W) q1[r >> 1][r & 1] = -INFINITY; }
            }
            float mxa = max3f(q0[0][0], q0[0][1], q1[0][0]), mxb = max3f(q1[0][1], q0[1][0], q0[1][1]);
            mxa = max3f(mxa, q1[1][0], q1[1][1]);
#pragma unroll
            for (int r = 2; r < 8; ++r) { mxa = max3f(mxa, q0[r][0], q0[r][1]); mxb = max3f(mxb, q1[r][0], q1[r][1]); }
            const float mxl = max3f(mxa, mxb, m_run);
            const float m_new = fmaxf(mxl, sx(mxl, 32, lane)), alpha = fast_exp2(m_run - m_new); m_run = m_new;
            l_run *= alpha;
            const f32x2 mn2 = {m_new, m_new};
            if (t > tw_lo) {
                A_RESCALE();
                A_PV(pa, (t - 1) & 3);
#pragma unroll
                for (int r = 0; r < 8; ++r) { const f32x2 d0_ = q0[r] - mn2, d1_ = q1[r] - mn2; pe0[2 * r] = fast_exp2(d0_[0]); pe0[2 * r + 1] = fast_exp2(d0_[1]); pe1[2 * r] = fast_exp2(d1_[0]); pe1[2 * r + 1] = fast_exp2(d1_[1]); }
#if ATT_SGB
#pragma unroll
                for (int i = 0; i < NDB * 4; ++i) { __builtin_amdgcn_sched_group_barrier(0x100, 2, 0); __builtin_amdgcn_sched_group_barrier(0x008, 1, 0); __builtin_amdgcn_sched_group_barrier(0x002, 48 / (NDB * 4), 0); }
#endif
            } else {
#pragma unroll
                for (int r = 0; r < 8; ++r) { const f32x2 d0_ = q0[r] - mn2, d1_ = q1[r] - mn2; pe0[2 * r] = fast_exp2(d0_[0]); pe0[2 * r + 1] = fast_exp2(d0_[1]); pe1[2 * r] = fast_exp2(d1_[0]); pe1[2 * r + 1] = fast_exp2(d1_[1]); }
            }
            alpha_prev = alpha;
            if (t == tw_hi) {
                float ls2; bf16x8 pa2[4];
                A_SUMPACK(ls2, pa2); l_run += ls2;
                A_RESCALE();
                A_PV(pa2, cur);
            }
        }
    }
    asm volatile("s_waitcnt lgkmcnt(0)" ::: "memory");
    __builtin_amdgcn_s_barrier();
    asm volatile("" ::: "memory");
    const float l_tot = l_run + sx(l_run, 32, lane);
    if (J.lse && hi == 0) J.lse[(long)qrow * J.lstride] = (m_run + log2f(l_tot)) * LN2;
    if (hi == 0) wsf[r32] = 1.0f / l_tot;
    LAS bf16_t* stg = (LAS bf16_t*)(lds) + wid * (NDB * 1024);
#pragma unroll
    for (int g = 0; g < 4; ++g) { const f32x4 a = *(const LAS f32x4*)(wsf + 8 * g + 4 * hi);
#pragma unroll
        for (int i = 0; i < 4; ++i) { const int orow = 8 * g + 4 * hi + i;
#pragma unroll
            for (int db = 0; db < NDB; ++db) stg[orow * (NDB * 32) + db * 32 + r32] = (bf16_t)(cvtpk(o[db][4 * g + i] * a[i], 0.f) & 0xffffu); } }
    bf16_t* Ow = J.O + (long)qw * J.opitch;
#pragma unroll
    for (int i = 0; i < NDB * 2; ++i) { const int idx = i * 64 + lane, row = idx / (NDB * 4), ch = idx % (NDB * 4);
        const u32x4 v = *(const LAS u32x4*)(stg + row * (NDB * 32) + ch * 8); *(u32x4*)(Ow + (long)row * J.opitch + ch * 8) = v; }
    __syncthreads();
#undef A_DMA
#undef A_RESCALE
#undef A_SUMPACK
#undef A_PV
}

__device__ __forceinline__ void grid_bar(unsigned* bw, unsigned G, int tid, unsigned k) {
    asm volatile("s_waitcnt vmcnt(0)" ::: "memory");
    __syncthreads();
    if (tid == 0) {
        __builtin_amdgcn_fence(__ATOMIC_RELEASE, "agent");
        asm volatile("s_waitcnt vmcnt(0)" ::: "memory");
        const unsigned old = __hip_atomic_fetch_add(bw, 1u, __ATOMIC_RELAXED, __HIP_MEMORY_SCOPE_AGENT);
        if (old + 1u == G * (k + 1u)) __hip_atomic_store(bw + 64, k + 1u, __ATOMIC_RELAXED, __HIP_MEMORY_SCOPE_AGENT);
        else { unsigned sp = 0; while (__hip_atomic_load(bw + 64, __ATOMIC_RELAXED, __HIP_MEMORY_SCOPE_AGENT) <= k) { __builtin_amdgcn_s_sleep(1); if (++sp > (1u << 27)) break; } }
        __builtin_amdgcn_fence(__ATOMIC_ACQUIRE, "agent");
        asm volatile("s_waitcnt vmcnt(0)" ::: "memory");
    }
    __syncthreads();
}

struct Args {
    const float *x, *p, *norm_ffn1, *w_ffn1_in, *w_ffn1_out, *norm_mix, *norm_ffn2, *w_ffn2_in, *w_ffn2_out, *norm_ple, *w_ple_gate, *b_ple_gate, *w_ple_proj,
        *fox_w_in, *fox_b_f, *fox_w_out, *dil_w_in, *dil_w_out, *diff_w_in, *diff_lambda, *diff_subln, *diff_w_out, *sgu_w_in, *sgu_norm_v, *sgu_w_s, *sgu_b_s, *sgu_w_out, *norm_final;
    float* out; unsigned char* ws;
};

__device__ __forceinline__ void transpose_item(const float* W, int K, int N, bf16_t* WT, const float* gain, int mode, LAS float* scr, int item, int lane) {
    const int nblk = (N + 31) / 32, kb = item / nblk, nb = item % nblk, k0 = 64 * kb, n0 = 32 * nb;
    const int ncol = n0 + (lane & 31); const bool okc = ncol < N;
    float vv[32];
#pragma unroll
    for (int i = 0; i < 32; ++i) { const int kk = 2 * i + (lane >> 5); vv[i] = okc ? W[(size_t)(k0 + kk) * N + ncol] : 0.f; }
    if (gain) {
#pragma unroll
        for (int i = 0; i < 32; ++i) vv[i] *= gain[k0 + 2 * i + (lane >> 5)];
    }
#pragma unroll
    for (int i = 0; i < 32; ++i) scr[(2 * i + (lane >> 5)) * 33 + (lane & 31)] = vv[i];
    asm volatile("s_waitcnt lgkmcnt(0)" ::: "memory");
    int d0 = n0;
    if (mode == 1) { if (n0 < DFF) d0 = (n0 / 128) * 256 + (n0 % 128); else { const int mm = n0 - DFF; d0 = (mm / 128) * 256 + 128 + (mm % 128); } }
    const int c = lane & 7;
#pragma unroll
    for (int j = 0; j < 4; ++j) { const int n = (lane >> 3) + 8 * j; const LAS float* s = scr + (8 * c) * 33 + n;
        u32x4 o; o.x = cvtpk(s[0 * 33], s[1 * 33]); o.y = cvtpk(s[2 * 33], s[3 * 33]); o.z = cvtpk(s[4 * 33], s[5 * 33]); o.w = cvtpk(s[6 * 33], s[7 * 33]);
        *(u32x4*)(WT + (size_t)(d0 + n) * K + k0 + 8 * c) = o; }
    asm volatile("s_waitcnt lgkmcnt(0)" ::: "memory");
}

__device__ __forceinline__ void get_mat(const Args& a, bf16_t* Wt, int mi, const float*& src, int& K, int& N, bf16_t*& dst, const float*& gain, int& mode) {
    gain = nullptr; mode = 0;
    if (mi < 24) {
        const int L = mi / 6, k = mi % 6; bf16_t* wl = Wt + (size_t)L * L_SIZE;
        if (k == 0)      { src = a.w_ffn1_in + (size_t)L * DM * 2 * DFF; K = DM; N = 2 * DFF; dst = wl + L_FFN1IN; gain = a.norm_ffn1 + L * DM; mode = 1; }
        else if (k == 1) { src = a.w_ffn1_out + (size_t)L * DFF * DM; K = DFF; N = DM; dst = wl + L_FFN1OUT; }
        else if (k == 2) { src = a.w_ffn2_in + (size_t)L * DM * 2 * DFF; K = DM; N = 2 * DFF; dst = wl + L_FFN2IN; gain = a.norm_ffn2 + L * DM; mode = 1; }
        else if (k == 3) { src = a.w_ffn2_out + (size_t)L * DFF * DM; K = DFF; N = DM; dst = wl + L_FFN2OUT; }
        else if (k == 4) { src = a.w_ple_gate + (size_t)L * DM * DM; K = DM; N = DM; dst = wl + L_PLEG; gain = a.norm_ple + L * DM; }
        else             { src = a.w_ple_proj + (size_t)L * PLE * DM; K = PLE; N = DM; dst = wl + L_PLEP; }
    } else {
        const int k = mi - 24;
        if (k == 0)      { src = a.fox_w_in; K = DM; N = 3 * DM + 16; dst = Wt + W_FOXIN; gain = a.norm_mix; }
        else if (k == 1) { src = a.fox_w_out; K = DM; N = DM; dst = Wt + W_FOXOUT; }
        else if (k == 2) { src = a.dil_w_in; K = DM; N = 5 * DM; dst = Wt + W_DILIN; gain = a.norm_mix + DM; }
        else if (k == 3) { src = a.dil_w_out; K = DM; N = DM; dst = Wt + W_DILOUT; }
        else if (k == 4) { src = a.diff_w_in; K = DM; N = 3 * DM; dst = Wt + W_DIFFIN; gain = a.norm_mix + 2 * DM; }
        else if (k == 5) { src = a.diff_w_out; K = DM; N = DM; dst = Wt + W_DIFFOUT; }
        else if (k == 6) { src = a.sgu_w_in; K = DM; N = 4 * DM; dst = Wt + W_SGUIN; gain = a.norm_mix + 3 * DM; }
        else             { src = a.sgu_w_out; K = 2 * DM; N = DM; dst = Wt + W_SGUOUT; }
    }
}

__global__ void __launch_bounds__(512, 2) mega(Args a) {
    extern __shared__ __attribute__((aligned(16))) unsigned char lds_raw[];
    LAS unsigned char* lds = (LAS unsigned char*)lds_raw;
    cg::this_grid().sync();
    const int wave0 = __builtin_amdgcn_readfirstlane((int)threadIdx.x >> 6);
#define ssqX ((float*)(ws + WS_SSQX))
#define ssqY ((float*)(ws + WS_SSQY))
#define ssqV ((float*)(ws + WS_SSQV))
#define lseb ((float*)(ws + WS_LSE))
#define flog ((float*)(ws + WS_FLOG))
#define rope ((f32x2*)(ws + WS_ROPE))
#define misc ((float*)(ws + WS_MISC))
#define pbf ((bf16_t*)(ws + WS_PBF))
#define hb ((bf16_t*)(ws + WS_HB))
#define Wt ((bf16_t*)(ws + WS_W))
#define S1 ((bf16_t*)(ws + WS_S1))
#define FRESH_TID(name) int name; { int w_ = wave0; asm volatile("" : "+s"(w_)); unsigned o_ = ~0u; asm volatile("" : "+s"(o_)); name = w_ * 64 + (int)__builtin_amdgcn_mbcnt_hi(o_, __builtin_amdgcn_mbcnt_lo(o_, 0u)); asm volatile("" : "+v"(name)); }
#define PHASE_VARS \
    int wave_ = wave0; asm volatile("" : "+s"(wave_)); \
    unsigned ones_ = ~0u; asm volatile("" : "+s"(ones_)); \
    int tid = wave_ * 64 + (int)__builtin_amdgcn_mbcnt_hi(ones_, __builtin_amdgcn_mbcnt_lo(ones_, 0u)); asm volatile("" : "+v"(tid)); \
    int bid = blockIdx.x; asm volatile("" : "+s"(bid)); \
    int G = gridDim.x; asm volatile("" : "+s"(G)); \
    const int lane = tid & 63, wave = wave_; \
    const int gw = bid * 8 + wave, NGW = G * 8; \
    const long gt = (long)bid * 512 + tid, NGT = (long)G * 512; \
    gbyte_t* wsg_ = (gbyte_t*)a.ws; asm volatile("" : "+s"(wsg_)); unsigned char* ws = (unsigned char*)wsg_; \
    float* h = a.out; \
    (void)lane; (void)wave; (void)gw; (void)NGW; (void)gt; (void)NGT; (void)h; (void)ws;

    {
        PHASE_VARS
        LAS float* scr = (LAS float*)(lds + wave * 16384);
#pragma unroll 1
        for (int rep = 0; rep < (PROBE_REP == 6 ? 2 : 1); ++rep) {
        int it0 = 0;
#pragma unroll 1
        for (int mi = 0; mi < 32; ++mi) {
            const float* src; int K_, N_; bf16_t* dst; const float* gain; int mode;
            get_mat(a, Wt, mi, src, K_, N_, dst, gain, mode);
            const int nitems = (K_ / 64) * ((N_ + 31) / 32);
            const int first = it0 + (((gw - it0) % NGW) + NGW) % NGW;
#pragma unroll 1
            for (int gi = first; gi < it0 + nitems; gi += NGW) transpose_item(src, K_, N_, dst, gain, mode, scr, gi - it0, lane);
            it0 += nitems;
        }
#pragma unroll 1
        for (int m = gw; m < MTOK; m += NGW) {
            const f32x4* xr = (const f32x4*)(a.x + (size_t)m * DM) + lane; u32x2* o8 = (u32x2*)(hb + (size_t)m * DM) + lane; float ss = 0.f;
#pragma unroll
            for (int j = 0; j < 4; ++j) { const f32x4 v = xr[64 * j]; ss += (v[0] * v[0] + v[1] * v[1]) + (v[2] * v[2] + v[3] * v[3]); u32x2 w; w.x = cvtpk(v[0], v[1]); w.y = cvtpk(v[2], v[3]); o8[64 * j] = w; }
            ss = wave_sum(ss, lane);
            if (lane < 16) ssqX[(size_t)m * 16 + lane] = ss * (1.0f / 16.0f);
        }
#pragma unroll 1
        for (long i = gt; i < (long)MTOK * PLE / 4; i += NGT) { const f32x4 v = ((const f32x4*)a.p)[i]; u32x2 w; w.x = cvtpk(v[0], v[1]); w.y = cvtpk(v[2], v[3]); ((u32x2*)pbf)[i] = w; }
        if (gt < SEQ * 8) {
            const int pos = (int)(gt >> 3), j = (int)(gt & 7);
            const float invf = j == 0 ? 1.0f : j == 1 ? 0.1939227432012558f : j == 2 ? 0.03760603070259094f : j == 3 ? 0.007292664609849453f : j == 4 ? 0.0014142135623842478f
                             : j == 5 ? 0.00027424818836152554f : j == 6 ? 5.318296098266728e-05f : 1.0313386155758053e-05f;
            const float angf = (float)pos * invf; const double ang = (double)angf;
            const double kk = rint(ang * 0.15915494309189535); const double r = (ang - kk * 6.283185307179586) - kk * 2.4492935982947064e-16; const double r2 = r * r;
            double s = 1.0, c = 1.0;
#pragma unroll
            for (int n = 13; n >= 1; --n) { s = 1.0 - s * r2 * (1.0 / (double)((2 * n) * (2 * n + 1))); c = 1.0 - c * r2 * (1.0 / (double)((2 * n - 1) * (2 * n))); }
            rope[gt] = (f32x2){(float)c, (float)(r * s)};
        }
        if (gt == 0) {
            float s1 = 0.f, s2 = 0.f;
#pragma unroll 1
            for (int i = 0; i < 64; ++i) { s1 += a.diff_lambda[i] * a.diff_lambda[64 + i]; s2 += a.diff_lambda[128 + i] * a.diff_lambda[192 + i]; }
            misc[0] = expf(s1) - expf(s2) + LAM_INIT;
        }
        }
        grid_bar((unsigned*)(ws + WS_BAR), (unsigned)G, tid, 0u);
    }

#pragma unroll 1
    for (int qq = 0; qq < 4 * NSLOTS; ++qq) {
        PHASE_VARS
        pg8::StaticOrder SO;
        bf16_t* const pp = S1 + (size_t)96 * MiB;
        bf16_t* const hb2 = S1 + (size_t)128 * MiB;
        const int L = qq / NSLOTS, sl = qq % NSLOTS;
#if PROBE_REP == 1
        const int s = (sl <= 1) ? 0 : (sl <= 7) ? sl - 1 : (sl == 8) ? 6 : sl - 2;
#elif PROBE_REP == 7
        const int s = (sl <= 2) ? sl : sl - 1;
#elif PROBE_REP == 8
        const int s = (sl <= 8) ? sl : 8;
#else
        const int s = sl;
#endif
        const bf16_t* wl = Wt + (size_t)L * L_SIZE;
        if (s == 0 || s == 6) {
            pg8::Gemm g{hb, wl + (s == 0 ? L_FFN1IN : L_FFN2IN), MTOK, 2 * DFF, DM, DM}; SO.init(MTOK, 2 * DFF, G, bid); EpiSwiglu E{ssqX, S1}; pg8::gemm_phase(lds, tid, g, SO, E);

        } else if (s == 1 || s == 5 || s == 7) {
            const bf16_t* Bt; int K_, lda_; float sc; float* sq;
            if (s == 1) { Bt = wl + L_FFN1OUT; K_ = DFF; lda_ = DFF; sc = 0.5f; sq = ssqY; }
            else if (s == 7) { Bt = wl + L_FFN2OUT; K_ = DFF; lda_ = DFF; sc = 0.5f; sq = ssqY; }
            else { sc = 1.0f; sq = ssqX; K_ = DM;
                if (L == 0) { Bt = Wt + W_FOXOUT; lda_ = 3072; } else if (L == 1) { Bt = Wt + W_DILOUT; lda_ = 5120; } else if (L == 2) { Bt = Wt + W_DIFFOUT; lda_ = 3072; } else { Bt = Wt + W_SGUOUT; K_ = 2 * DM; lda_ = 4096; } }
#if PROBE_REP == 2 || PROBE_REP == 4
            if ((PROBE_REP == 2) == (s != 5)) { pg8::Gemm g{S1, Bt, MTOK, DM, K_, lda_}; SO.init(MTOK, DM, G, bid); EpiResid E{(L == 0 && s == 1) ? a.x : h, (float*)(S1 + (size_t)96 * MiB), s == 7 ? hb2 : hb, sq, sc}; pg8::gemm_phase(lds, tid, g, SO, E); }
#endif
            { pg8::Gemm g{S1, Bt, MTOK, DM, K_, lda_}; SO.init(MTOK, DM, G, bid); EpiResid E{(L == 0 && s == 1) ? a.x : h, h, s == 7 ? hb2 : hb, sq, sc}; pg8::gemm_phase(lds, tid, g, SO, E); }
            if (s == 7) { pg8::Gemm g{pbf, wl + L_PLEP, MTOK, DM, PLE, PLE}; SO.init(MTOK, DM, G, bid); EpiBf16 E{pp, DM}; pg8::gemm_phase(lds, tid, g, SO, E); }
        } else if (s == 2) {
            if (L < 3) {
                const bf16_t* Bt; int N_, ldo, qs, re, fg;
                if (L == 0) { Bt = Wt + W_FOXIN; N_ = 3328; ldo = 3072; qs = 0; re = 0; fg = 12; }
                else if (L == 1) { Bt = Wt + W_DILIN; N_ = 5120; ldo = 5120; qs = 0; re = 4096; fg = -1; }
                else { Bt = Wt + W_DIFFIN; N_ = 3072; ldo = 3072; qs = 0; re = 2048; fg = -1; }
                pg8::Gemm g{hb, Bt, MTOK, N_, DM, DM}; SO.init(MTOK, N_, G, bid); EpiQkv E{ssqY, S1, ldo, qs, re, fg, rope, a.fox_b_f, flog}; pg8::gemm_phase(lds, tid, g, SO, E);
            } else {
                pg8::Gemm g{hb, Wt + W_SGUIN, MTOK, 4096, DM, DM}; SO.init(MTOK, 4096, G, bid); EpiSguIn E{ssqY, S1, ssqV}; pg8::gemm_phase(lds, tid, g, SO, E);
            }
        } else if (s == 8) {
            { pg8::Gemm g{hb2, wl + L_PLEG, MTOK, DM, DM, DM}; SO.init(MTOK, DM, G, bid); EpiPleGate E{ssqY, h, (PROBE_REP == 8 && sl == 8) ? (float*)S1 : h, hb, ssqX, a.b_ple_gate + L * DM, pp}; pg8::gemm_phase(lds, tid, g, SO, E); }
            if (L < 3) {
                const f32x4* ps = (const f32x4*)(a.p + (size_t)(L + 1) * MTOK * PLE);
                FRESH_TID(tid3)
#pragma unroll 1
                for (long i = (long)bid * 512 + tid3; i < (long)MTOK * PLE / 4; i += NGT) { const f32x4 v = ps[i]; u32x2 w; w.x = cvtpk(v[0], v[1]); w.y = cvtpk(v[2], v[3]); ((u32x2*)pbf)[i] = w; }
            }
        } else if ((s == 4 && L == 0) || (s == 3 && (L == 1 || L == 2))) {
            const int total = L == 1 ? 6144 : 2048;
#pragma unroll 1
            for (int n = bid; n < total; n += G) {
                AttnJob J;
                if (L == 0) {
                    const int v = n & 255, i = n >> 8, bh = v >> 1, s2 = (v & 1) * 4 + (i >> 1), qb = (i & 1) ? 15 - s2 : s2, b = bh >> 4, hh = bh & 15;
                    bf16_t* base = S1 + (size_t)b * SEQ * 3072 + hh * 64;
                    J = AttnJob{base, base + 1024, base + 2048, base, 3072, 3072, flog + (size_t)b * SEQ * 16 + hh, 16, nullptr, 0, qb * 256, 1 << 20};
                } else if (L == 1) {
                    const int gi = n / 2048, idx = n % 2048, bh = idx & 127, sub = idx >> 7, b = bh >> 4, hh = bh & 15;
                    const int d = gi == 0 ? 1 : gi == 1 ? 4 : 16; const int res = sub % d, ub = sub / d;
                    bf16_t* base = S1 + ((size_t)b * SEQ + res) * 5120 + hh * 64;
                    J = AttnJob{base + gi * 1024, base + 3072, base + 4096, base + gi * 1024, (long)5120 * d, (long)5120 * d, nullptr, 0,
                                lseb + (size_t)gi * MTOK * 16 + ((size_t)b * SEQ + res) * 16 + hh, 16 * d, ub * 256, 128};
                } else {
                    const int v = n & 255, i = n >> 8, bm = v >> 1, s2 = (v & 1) * 4 + (i >> 1), qb = (i & 1) ? 15 - s2 : s2, b = bm >> 4, mm = bm & 15;
                    bf16_t* base = S1 + (size_t)b * SEQ * 3072; bf16_t* OM = S1 + (size_t)MTOK * 3072;
                    J = AttnJob{base + mm * 64, base + 1024 + mm * 64, base + 2048 + (mm >> 1) * 128, OM + (size_t)b * SEQ * 2048 + mm * 128, 3072, 2048, nullptr, 0, nullptr, 0, qb * 256, 1 << 20};
                }
#pragma unroll 1
                for (int rep = (PROBE_REP == 3 && L != 1) ? 0 : 1; rep < 2; ++rep) {
                    AttnJob J2 = J;
                    if (rep == 0 && L == 0) { const size_t off = (size_t)(J.Q - S1); J2.O = S1 + (size_t)96 * MiB + (off / ((size_t)SEQ * 3072)) * SEQ * 1024 + (off % 3072); J2.opitch = 1024; }
                    if (L == 2) attn_unit<4, false>(lds, tid, J2); else if (L == 0) attn_unit<2, true>(lds, tid, J2); else attn_unit<2, false>(lds, tid, J2);
                }
            }
        } else if (s == 3 && L == 0) {
            if (bid < 8) {
                const int hh = tid & 15, seg = tid >> 4; float* fp = flog + ((size_t)bid * SEQ + seg * 128) * 16 + hh; float sm = 0.f;
#pragma unroll 8
                for (int i = 0; i < 128; ++i) sm += fp[i * 16];
                LAS float* sc = (LAS float*)lds; sc[tid] = sm; __syncthreads();
                float pre = 0.f;
#pragma unroll 1
                for (int j = 0; j < seg; ++j) pre += sc[j * 16 + hh];
                float run = pre;
#pragma unroll 8
                for (int i = 0; i < 128; ++i) { run += fp[i * 16]; fp[i * 16] = run * LOG2E; }
                __syncthreads();
            }
        } else if (s == 4 && L == 1) {
#pragma unroll 1
            for (long it = gt; it < (long)MTOK * 128; it += NGT) {
                const long row = it >> 7; const int hh = (int)(it >> 3) & 15, ch = (int)it & 7;
                const float l0 = lseb[row * 16 + hh], l1 = lseb[(size_t)MTOK * 16 + row * 16 + hh], l2 = lseb[(size_t)2 * MTOK * 16 + row * 16 + hh];
                const float mx = fmaxf(l0, fmaxf(l1, l2)); float w0 = expf(l0 - mx), w1 = expf(l1 - mx), w2 = expf(l2 - mx); const float inv = 1.0f / (w0 + w1 + w2); w0 *= inv; w1 *= inv; w2 *= inv;
                bf16_t* p0 = S1 + row * 5120 + hh * 64 + ch * 8;
                const u32x4 a0 = *(const u32x4*)p0, a1 = *(const u32x4*)(p0 + 1024), a2 = *(const u32x4*)(p0 + 2048); u32x4 o;
#pragma unroll
                for (int k = 0; k < 4; ++k) o[k] = cvtpk(w0 * bf_lo(a0[k]) + w1 * bf_lo(a1[k]) + w2 * bf_lo(a2[k]), w0 * bf_hi(a0[k]) + w1 * bf_hi(a1[k]) + w2 * bf_hi(a2[k]));
                *(u32x4*)p0 = o;
            }
        } else if (s == 4 && L == 2) {
            const float lam = misc[0]; const bf16_t* OM = S1 + (size_t)MTOK * 3072;
#pragma unroll 1
            for (long it = gt; it < (long)MTOK * 128; it += NGT) {
                const long row = it >> 7; const int hh = (int)(it >> 4) & 7, c16 = (int)it & 15;
                const bf16_t* p1 = OM + row * 2048 + (2 * hh) * 128 + c16 * 8;
                const u32x4 a1 = *(const u32x4*)p1, a2 = *(const u32x4*)(p1 + 128); float o[8]; float ss = 0.f;
#pragma unroll
                for (int k = 0; k < 4; ++k) { o[2 * k] = bf_lo(a1[k]) - lam * bf_lo(a2[k]); o[2 * k + 1] = bf_hi(a1[k]) - lam * bf_hi(a2[k]); ss += o[2 * k] * o[2 * k] + o[2 * k + 1] * o[2 * k + 1]; }
                ss += sx(ss, 1, lane); ss += sx(ss, 2, lane); ss += sx(ss, 4, lane); ss += sx(ss, 8, lane);
                const float r = (1.0f - LAM_INIT) / sqrtf(ss * (1.0f / 128.0f) + 1e-5f);
                const f32x4 g0 = *(const f32x4*)(a.diff_subln + c16 * 8), g1 = *(const f32x4*)(a.diff_subln + c16 * 8 + 4);
                u32x4 w; w.x = cvtpk(o[0] * r * g0[0], o[1] * r * g0[1]); w.y = cvtpk(o[2] * r * g0[2], o[3] * r * g0[3]); w.z = cvtpk(o[4] * r * g1[0], o[5] * r * g1[1]); w.w = cvtpk(o[6] * r * g1[2], o[7] * r * g1[3]);
                *(u32x4*)(S1 + row * 3072 + hh * 128 + c16 * 8) = w;
            }
        } else if (s == 3 && L == 3) {
#pragma unroll 1
            for (int n = bid; n < 2048; n += G) {
                const int chunk = n >> 3, gg = n & 7; const size_t row0 = (size_t)chunk * 128;
                LAS float* rsv = (LAS float*)(lds + 65536);
                if (tid < 128) { const f32x4* sp = (const f32x4*)(ssqV + (row0 + tid) * 32); float sm = 0.f;
#pragma unroll
                    for (int j = 0; j < 8; ++j) { const f32x4 v = sp[j]; sm += (v[0] + v[1]) + (v[2] + v[3]); }
                    rsv[tid] = 1.0f / sqrtf(sm * (1.0f / 2048.0f) + NORM_EPS); }
                __syncthreads();
#pragma unroll 2
                for (int k = 0; k < 8; ++k) {
                    const int item = tid + 512 * k, sr = item >> 5, ch = item & 31;
                    const u32x4 vv = *(const u32x4*)(S1 + (row0 + sr) * 4096 + 2048 + gg * 256 + ch * 8);
                    const f32x4 n0 = *(const f32x4*)(a.sgu_norm_v + gg * 256 + ch * 8), n1 = *(const f32x4*)(a.sgu_norm_v + gg * 256 + ch * 8 + 4); const float r = rsv[sr];
                    u32x4 w; w.x = cvtpk(bf_lo(vv.x) * r * n0[0], bf_hi(vv.x) * r * n0[1]); w.y = cvtpk(bf_lo(vv.y) * r * n0[2], bf_hi(vv.y) * r * n0[3]);
                    w.z = cvtpk(bf_lo(vv.z) * r * n1[0], bf_hi(vv.z) * r * n1[1]); w.w = cvtpk(bf_lo(vv.w) * r * n1[2], bf_hi(vv.w) * r * n1[3]);
                    *(LAS u32x4*)(lds + (sr >> 2) * 2048 + (ch >> 2) * 256 + (sr & 3) * 64 + (ch & 3) * 16) = w;
                }
                __syncthreads();
                {
                    const int r32 = lane & 31, hi = lane >> 5, tb = wave & 3, chalf = wave >> 2, g16 = (lane >> 4) & 1, i16 = lane & 15;
                    const int trow = 32 * tb + r32; const float* wrow = a.sgu_w_s + ((size_t)gg * 128 + trow) * 128;
                    f32x16 acc[4] = {};
                    const int vrd = (2 * hi) * 2048 + (i16 >> 2) * 64 + g16 * 32 + (i16 & 3) * 8;
#pragma unroll 1
                    for (int ks = 0; ks <= 2 * tb + 1; ++ks) {
                        const int s0 = 16 * ks + 8 * hi; const f32x4 w0 = *(const f32x4*)(wrow + s0), w1 = *(const f32x4*)(wrow + s0 + 4); float wv[8];
#pragma unroll
                        for (int j = 0; j < 4; ++j) { wv[j] = (s0 + j <= trow) ? w0[j] : 0.f; wv[4 + j] = (s0 + 4 + j <= trow) ? w1[j] : 0.f; }
                        u32x4 pw; pw.x = cvtpk(wv[0], wv[1]); pw.y = cvtpk(wv[2], wv[3]); pw.z = cvtpk(wv[4], wv[5]); pw.w = cvtpk(wv[6], wv[7]);
                        const bf16x8 pa = __builtin_bit_cast(bf16x8, pw);
#pragma unroll
                        for (int cbl = 0; cbl < 4; ++cbl) {
                            const LAS unsigned char* vp = lds + vrd + ks * 8192 + (chalf * 4 + cbl) * 256;
                            const s16x4 lo = __builtin_bit_cast(s16x4, __builtin_amdgcn_ds_read_tr16_b64_v4i16((LAS s16x4*)vp));
                            const s16x4 hh = __builtin_bit_cast(s16x4, __builtin_amdgcn_ds_read_tr16_b64_v4i16((LAS s16x4*)(vp + 2048)));
                            const bf16x8 vf = (bf16x8){lo[0], lo[1], lo[2], lo[3], hh[0], hh[1], hh[2], hh[3]};
                            acc[cbl] = __builtin_amdgcn_mfma_f32_32x32x16_bf16(pa, vf, acc[cbl], 0, 0, 0);
                        }
                    }
#pragma unroll
                    for (int cbl = 0; cbl < 4; ++cbl)
#pragma unroll
                        for (int r = 0; r < 16; ++r) {
                            const int t = 32 * tb + crow(r, hi); bf16_t* up = S1 + (row0 + t) * 4096 + gg * 256 + (chalf * 4 + cbl) * 32 + r32;
                            const float uval = __uint_as_float((unsigned)(*up) << 16); const float mixed = acc[cbl][r] + a.sgu_b_s[gg * 128 + t];
                            *up = (bf16_t)(cvtpk(uval * mixed, 0.f) & 0xffffu);
                        }
                }
                __syncthreads();
            }
        }
        { FRESH_TID(tid2) grid_bar((unsigned*)(ws + WS_BAR), (unsigned)G, tid2, (unsigned)qq + 1u); }
    }
    PHASE_VARS
#pragma unroll 1
    for (int m = gw; m < MTOK; m += NGW) {
        float sm = lane < 16 ? ssqX[(size_t)m * 16 + lane] : 0.f; sm = wave_sum(sm, lane);
        const float r = 1.0f / sqrtf(sm * (1.0f / DM) + NORM_EPS);
        f32x4* xr = (f32x4*)(h + (size_t)m * DM) + lane; const f32x4* gr = (const f32x4*)a.norm_final + lane;
#pragma unroll
        for (int j = 0; j < 4; ++j) { const f32x4 v = xr[64 * j]; const f32x4 gg = gr[64 * j]; xr[64 * j] = v * r * gg; }
    }
}

extern "C" void kernel_launch(void* const* d_in, const int* in_sizes, int n_in, void* d_out, int out_size, void* d_ws, size_t ws_size, hipStream_t stream) {
    static int grid = 0;
    if (grid == 0) {
        int dev = 0, cus = 0, per_cu = 0;
        hipGetDevice(&dev);
        hipDeviceGetAttribute(&cus, hipDeviceAttributeMultiprocessorCount, dev);
        hipFuncSetAttribute((const void*)mega, hipFuncAttributeMaxDynamicSharedMemorySize, LDS_BYTES);
        hipOccupancyMaxActiveBlocksPerMultiprocessor(&per_cu, (const void*)mega, 512, LDS_BYTES);
        if (per_cu < 1) per_cu = 1;
        grid = cus * per_cu;
        if (ws_size < WS_END) fprintf(stderr, "kernel_launch: workspace too small: %zu < %zu\n", ws_size, (size_t)WS_END);
    }
    hipMemsetAsync((unsigned char*)d_ws + WS_BAR, 0, 1024, stream);
    Args a{};
    const float** pa = (const float**)&a;
    for (int i = 0; i < 28; ++i) pa[i] = (const float*)d_in[i];
    a.out = (float*)d_out; a.ws = (unsigned char*)d_ws;
    void* args[] = {&a};
    hipError_t e = hipLaunchCooperativeKernel((const void*)mega, dim3(grid), dim3(512), args, LDS_BYTES, stream);
    if (e != hipSuccess) fprintf(stderr, "cooperative launch failed: %s (grid %d)\n", hipGetErrorString(e), grid);
}
```

```cpp
#include <hip/hip_runtime.h>
#include <hip/hip_cooperative_groups.h>
#include <cstdint>
#include <cstdio>
namespace cg = cooperative_groups;

#define LAS __attribute__((address_space(3)))
typedef unsigned short bf16_t;
typedef short bf16x8 __attribute__((ext_vector_type(8)));
typedef short s16x4 __attribute__((ext_vector_type(4)));
typedef float f32x4 __attribute__((ext_vector_type(4)));
typedef float f32x2 __attribute__((ext_vector_type(2)));
typedef float f32x16 __attribute__((ext_vector_type(16)));
typedef unsigned u32x4 __attribute__((ext_vector_type(4)));
typedef unsigned u32x2 __attribute__((ext_vector_type(2)));
typedef __bf16 bf16x2_t __attribute__((ext_vector_type(2)));
typedef __attribute__((address_space(1))) unsigned char gbyte_t;

constexpr int MTOK = 32768, SEQ = 4096, DM = 1024, DFF = 2816, PLE = 256;
constexpr float NORM_EPS = 1e-6f;
constexpr float LOG2E = 1.4426950408889634f, LN2 = 0.6931471805599453f;
constexpr float QSCALE = 0.125f * LOG2E;
constexpr float LAM_INIT = 0.47071301834358414f;

constexpr size_t MiB = 1u << 20;
constexpr size_t WS_SSQX = 0, WS_SSQY = 2 * MiB, WS_SSQV = 4 * MiB, WS_LSE = 8 * MiB, WS_FLOG = 14 * MiB, WS_ROPE = 16 * MiB, WS_MISC = 16 * MiB + 512 * 1024, WS_BAR = 16 * MiB + 768 * 1024;
constexpr size_t WS_PBF = 17 * MiB, WS_HB = 33 * MiB, WS_W = 97 * MiB, WS_S1 = 280 * MiB, WS_END = 600 * MiB;
constexpr size_t L_FFN1IN = 0, L_FFN1OUT = 5767168, L_FFN2IN = 8650752, L_FFN2OUT = 14417920, L_PLEG = 17301504, L_PLEP = 18350080, L_SIZE = 18612224;
constexpr size_t W_FOXIN = 4 * L_SIZE, W_FOXOUT = W_FOXIN + 3407872, W_DILIN = W_FOXOUT + 1048576, W_DILOUT = W_DILIN + 5242880, W_DIFFIN = W_DILOUT + 1048576,
                 W_DIFFOUT = W_DIFFIN + 3145728, W_SGUIN = W_DIFFOUT + 1048576, W_SGUOUT = W_SGUIN + 4194304, W_TOTAL = W_SGUOUT + 2097152;
static_assert(WS_W + W_TOTAL * 2 <= WS_S1, "weights fit");

#ifndef PROBE_REP
#define PROBE_REP 0
#endif
#ifndef TSEL
#define TSEL 0
#endif
constexpr unsigned BARMUL = (PROBE_REP == 9) ? 2u : 1u;
constexpr int NSLOTS = (PROBE_REP == 1) ? 11 : (PROBE_REP == 7 || PROBE_REP == 8) ? 10 : 9;
constexpr int LDS_BYTES = 147456;
constexpr int RTAB_OFF = 131072;

__device__ __forceinline__ unsigned cvtpk(float lo, float hi) { f32x2 v = {lo, hi}; bf16x2_t b = __builtin_convertvector(v, bf16x2_t); return __builtin_bit_cast(unsigned, b); }
typedef _Float16 half8 __attribute__((ext_vector_type(8)));
typedef _Float16 half2_t __attribute__((ext_vector_type(2)));
__device__ __forceinline__ unsigned cvtpk_h(float lo, float hi) { half2_t h = {(_Float16)lo, (_Float16)hi}; return __builtin_bit_cast(unsigned, h); }
__device__ __forceinline__ float h_lo(unsigned w) { return (float)__builtin_bit_cast(half2_t, w)[0]; }
__device__ __forceinline__ float h_hi(unsigned w) { return (float)__builtin_bit_cast(half2_t, w)[1]; }
__device__ __forceinline__ float bf_lo(unsigned w) { return __uint_as_float(w << 16); }
__device__ __forceinline__ float bf_hi(unsigned w) { return __uint_as_float(w & 0xffff0000u); }
__device__ __forceinline__ float sx(float v, int o, int lane) { return __int_as_float(__builtin_amdgcn_ds_bpermute((lane ^ o) << 2, __float_as_int(v))); }
__device__ __forceinline__ float wave_sum(float v, int lane) {
#pragma unroll
    for (int o = 1; o < 64; o <<= 1) v += sx(v, o, lane);
    return v;
}
__device__ __forceinline__ float fast_exp2(float x) { return __builtin_amdgcn_exp2f(x); }
__device__ __forceinline__ float fast_rcp(float x) { return __builtin_amdgcn_rcpf(x); }
__device__ __forceinline__ float sigmoidf_(float x) { return fast_rcp(1.0f + fast_exp2(-x * LOG2E)); }

namespace pg8 {
constexpr int BM = 256, BK = 64, HALF = 128, HTB = HALF * BK * 2, STAGE_BYTES = 8 * HTB, NXCD = 8, WGM = 8;
__host__ __device__ __forceinline__ int lds_byte(int r, int c) { const int st = (r >> 4) * 2 + (c >> 5), rr = r & 15, cc = c & 31, ob = rr * 64 + cc * 2; return st * 1024 + (ob ^ (((ob >> 9) & 1) << 5)); }
__host__ __device__ __forceinline__ void stage_rc(int b, int& R, int& C) { const int st = b / 1024, sb = b % 1024, swz = sb ^ (((sb >> 9) & 1) << 5); R = (st >> 1) * 16 + swz / 64; C = (st & 1) * 32 + (swz % 64) / 2; }
__host__ __device__ __forceinline__ int perm32(int rho) { const int n = rho >> 4, i = rho & 15; return 8 * (i >> 2) + 4 * n + (i & 3); }
struct Unit { int pm, pn, ui; };
struct Gemm { const bf16_t* A; const bf16_t* Bt; int M, N, K, lda; };
struct StaticOrder {
    int nM, nN, nwg, G, c;
    __device__ void init(int M, int N, int G_, int c_) { nM = M / BM; nN = N / BM; nwg = nM * nN; G = G_; c = c_; }
    __device__ bool next(int i, Unit& u) const {
        const long L = (long)i * G + c; if (L >= nwg) return false;
        int wgid = (int)L; { const int q = nwg / NXCD, r = nwg % NXCD, xcd = wgid % NXCD, off = wgid / NXCD; wgid = (xcd < r ? xcd * (q + 1) : r * (q + 1) + (xcd - r) * q) + off; }
        const int nig = WGM * nN, gid = wgid / nig, fm = gid * WGM, gsz = (nM - fm) < WGM ? (nM - fm) : WGM;
        u.pm = fm + ((wgid % nig) % gsz); u.pn = (wgid % nig) / gsz; u.ui = i; return true;
    }
};
template <class Epi, bool F16 = false>
__device__ __forceinline__ void gemm_phase(LAS unsigned char* lds, const int tid, const Gemm g, const StaticOrder& S, const Epi& E) {
    const int wid = __builtin_amdgcn_readfirstlane(tid >> 6), lane = tid & 63, wr = wid >> 2, wc = wid & 3, fr = lane & 15, fq = lane >> 4;
    const int K = g.K, nt = K / BK, lda = g.lda;
    unsigned voffA[2], voffB[2];
#pragma unroll
    for (int i = 0; i < 2; ++i) { int R, C; stage_rc(tid * 16 + i * 8192, R, C); const int Rb = Epi::PERM ? ((R & ~31) + perm32(R & 31)) : R;
        voffA[i] = (unsigned)(R * lda + C) * 2u; voffB[i] = (unsigned)(Rb * K + C) * 2u; }
    const size_t kstep = (size_t)(BK * 2);
    const size_t hstepA = (size_t)HALF * lda * 2, hstepB = (size_t)HALF * K * 2;
    const size_t tstepA = 2 * hstepA, tstepB = 2 * hstepB;
    const unsigned ldsw = (unsigned)wid * 1024u;
    const int aoff = lds_byte(wr * 64 + fr, fq * 8), boff = lds_byte(wc * 32 + fr, fq * 8);
#define PG8_SA(b, h) (((b) * 2 + (h)) * HTB)
#define PG8_SB(b, h) ((4 + (b) * 2 + (h)) * HTB)
#define PG8_STAGE(bufoff, gbase, voff) do { _Pragma("unroll") for (int _i = 0; _i < 2; ++_i) \
        __builtin_amdgcn_global_load_lds((const unsigned*)((const char*)(gbase) + (voff)[_i]), (LAS unsigned*)(lds + (bufoff) + ldsw + _i * 8192), 16, 0, 0); } while (0)
#define PG8_LDA(dst, b, h) do { _Pragma("unroll") for (int m = 0; m < 4; ++m) _Pragma("unroll") for (int k = 0; k < 2; ++k) dst[m][k] = *(const LAS bf16x8*)(lds + PG8_SA(b, h) + aoff + m * 2048 + k * 1024); } while (0)
#define PG8_LDB(dst, b, h) do { _Pragma("unroll") for (int n = 0; n < 2; ++n) _Pragma("unroll") for (int k = 0; k < 2; ++k) dst[n][k] = *(const LAS bf16x8*)(lds + PG8_SB(b, h) + boff + n * 2048 + k * 1024); } while (0)
#define PG8_MMA(ai, bj, At, Bt) do { __builtin_amdgcn_s_setprio(1); _Pragma("unroll") for (int m = 0; m < 4; ++m) _Pragma("unroll") for (int n = 0; n < 2; ++n) _Pragma("unroll") for (int k = 0; k < 2; ++k) \
        acc[ai][bj][m][n] = F16 ? __builtin_amdgcn_mfma_f32_16x16x32_f16(__builtin_bit_cast(half8, Bt[n][k]), __builtin_bit_cast(half8, At[m][k]), acc[ai][bj][m][n], 0, 0, 0) \
                                : __builtin_amdgcn_mfma_f32_16x16x32_bf16(Bt[n][k], At[m][k], acc[ai][bj][m][n], 0, 0, 0); __builtin_amdgcn_s_setprio(0); } while (0)
#define PG8_WAIT_V(n) asm volatile("s_waitcnt vmcnt(" #n ")" ::: "memory")
#define PG8_WAIT_L(n) asm volatile("s_waitcnt lgkmcnt(" #n ")" ::: "memory")
#define PG8_BAR __builtin_amdgcn_s_barrier()
#define PG8_SCHED __builtin_amdgcn_sched_barrier(0)
    Unit cur, nxt; int ui = 0;
    if (!S.next(0, cur)) return;
    f32x4 acc[2][2][4][2];
#pragma unroll
    for (int a = 0; a < 2; ++a)
#pragma unroll
        for (int b = 0; b < 2; ++b)
#pragma unroll
            for (int m = 0; m < 4; ++m)
#pragma unroll
                for (int n = 0; n < 2; ++n) acc[a][b][m][n] = (f32x4){0.f, 0.f, 0.f, 0.f};
    bf16x8 At[4][2], B0[2][2], B1[2][2];
    const char* cA = (const char*)g.A + (size_t)cur.pm * tstepA; const char* cB = (const char*)g.Bt + (size_t)cur.pn * tstepB;
    PG8_STAGE(PG8_SB(0, 0), cB, voffB); PG8_STAGE(PG8_SB(0, 1), cB + hstepB, voffB); PG8_STAGE(PG8_SA(0, 0), cA, voffA); PG8_STAGE(PG8_SA(0, 1), cA + hstepA, voffA);
    if (wr == 1) PG8_BAR;
    PG8_WAIT_V(2); PG8_BAR;
    PG8_STAGE(PG8_SB(1, 0), cB + kstep, voffB); PG8_STAGE(PG8_SA(1, 0), cA + kstep, voffA); PG8_STAGE(PG8_SB(1, 1), cB + hstepB + kstep, voffB);
    PG8_WAIT_V(6); PG8_BAR;
    for (;;) {
        const bool has_next = S.next(ui + 1, nxt);
        const char* nA = has_next ? (const char*)g.A + (size_t)nxt.pm * tstepA : cA; const char* nB = has_next ? (const char*)g.Bt + (size_t)nxt.pn * tstepB : cB;
        for (int t = 0; t < nt; t += 2) {
            const bool last = (t == nt - 2);
            const char* a1 = cA + (size_t)(t + 1) * kstep;
            const char* a2 = last ? nA : cA + (size_t)(t + 2) * kstep; const char* b2 = last ? nB : cB + (size_t)(t + 2) * kstep;
            const char* a3 = a2 + kstep; const char* b3 = b2 + kstep;
            PG8_LDB(B0, 0, 0); PG8_LDB(B1, 0, 1); PG8_SCHED; PG8_LDA(At, 0, 0); PG8_STAGE(PG8_SA(1, 1), a1 + hstepA, voffA);
            PG8_WAIT_V(8); PG8_WAIT_L(0); PG8_BAR; PG8_MMA(0, 0, At, B0); PG8_MMA(0, 1, At, B1); PG8_BAR; PG8_SCHED;
            PG8_LDA(At, 0, 1); PG8_STAGE(PG8_SB(0, 0), b2, voffB); PG8_STAGE(PG8_SB(0, 1), b2 + hstepB, voffB); PG8_STAGE(PG8_SA(0, 0), a2, voffA);
            PG8_WAIT_V(8); PG8_WAIT_L(0); PG8_BAR; PG8_MMA(1, 0, At, B0); PG8_MMA(1, 1, At, B1); PG8_BAR; PG8_SCHED;
            PG8_LDB(B0, 1, 0); PG8_LDB(B1, 1, 1); PG8_SCHED; PG8_LDA(At, 1, 0); PG8_STAGE(PG8_SA(0, 1), a2 + hstepA, voffA);
            PG8_WAIT_V(8); PG8_WAIT_L(0); PG8_BAR; PG8_MMA(0, 0, At, B0); PG8_MMA(0, 1, At, B1); PG8_BAR; PG8_SCHED;
            PG8_LDA(At, 1, 1); PG8_STAGE(PG8_SB(1, 0), b3, voffB); PG8_STAGE(PG8_SB(1, 1), b3 + hstepB, voffB); PG8_STAGE(PG8_SA(1, 0), a3, voffA);
            PG8_WAIT_V(8); PG8_WAIT_L(0); PG8_BAR; PG8_MMA(1, 0, At, B0); PG8_MMA(1, 1, At, B1); PG8_BAR; PG8_SCHED;
        }
        if (wr == 0) PG8_BAR;
        E(acc, cur, wr, wc, fr, fq);
        if (!has_next) break;
#pragma unroll
        for (int a = 0; a < 2; ++a)
#pragma unroll
            for (int b = 0; b < 2; ++b)
#pragma unroll
                for (int m = 0; m < 4; ++m)
#pragma unroll
                    for (int n = 0; n < 2; ++n) acc[a][b][m][n] = (f32x4){0.f, 0.f, 0.f, 0.f};
        cur = nxt; cA = nA; cB = nB; ++ui;
        if (wr == 1) PG8_BAR;
    }
    PG8_WAIT_V(0);
    PG8_BAR;
#undef PG8_SA
#undef PG8_SB
#undef PG8_STAGE
#undef PG8_LDA
#undef PG8_LDB
#undef PG8_MMA
#undef PG8_WAIT_V
#undef PG8_WAIT_L
#undef PG8_BAR
#undef PG8_SCHED
}
}
using pg8::Unit;

__device__ __forceinline__ void row_rstd8(const float* ssq, int row0, int fq, int lane, float (&rs)[8]) {
#pragma unroll
    for (int ai = 0; ai < 2; ++ai)
#pragma unroll
        for (int m = 0; m < 4; ++m) {
            const f32x4 v = *(const f32x4*)(ssq + (size_t)(row0 + 128 * ai + 16 * m) * 16 + 4 * fq);
            float s = (v[0] + v[1]) + (v[2] + v[3]); s += sx(s, 16, lane); s += sx(s, 32, lane);
            rs[ai * 4 + m] = 1.0f / sqrtf(s * (1.0f / DM) + NORM_EPS);
        }
}
__device__ __forceinline__ void row_rstd8_lds(const LAS float* rtab, int ui, int lrow0, float (&rs)[8]) {
#pragma unroll
    for (int ai = 0; ai < 2; ++ai)
#pragma unroll
        for (int m = 0; m < 4; ++m) rs[ai * 4 + m] = rtab[ui * 256 + lrow0 + 128 * ai + 16 * m];
}
__device__ __forceinline__ float gelu_erf(float v) {
    const float av = fabsf(v), t = fast_rcp(av * 0.2316418882f + 1.0f);
    float q = t * 0.5307027145f + (-0.7265760135f); q = q * t + 0.7107068705f; q = q * t + (-0.142248368f); q = q * t + 0.127414796f; q = q * t;
    const float e = fast_exp2((v * v) * (-0.72134752044f));
    const float m = v * (q * e);
    return v < 0.f ? m : v - m;
}

struct EpiSwiglu {
    static constexpr bool PERM = true;
    const LAS float* rtab; bf16_t* H;
    __device__ __forceinline__ void operator()(const f32x4 (&acc)[2][2][4][2], const Unit& u, int wr, int wc, int fr_, int fq_) const {
        (void)fr_; (void)fq_; unsigned o_ = ~0u; asm volatile("" : "+s"(o_)); const int lane = (int)__builtin_amdgcn_mbcnt_hi(o_, __builtin_amdgcn_mbcnt_lo(o_, 0u)); const int fr = lane & 15, fq = lane >> 4;
        const int row0 = u.pm * 256 + wr * 64 + fr, col0 = u.pn * 128 + wc * 32 + 8 * fq;
        float rs[8]; row_rstd8_lds(rtab, u.ui, wr * 64 + fr, rs);
#pragma unroll
        for (int ai = 0; ai < 2; ++ai)
#pragma unroll
            for (int m = 0; m < 4; ++m) {
                const float r = rs[ai * 4 + m]; float o[8];
#pragma unroll
                for (int n = 0; n < 2; ++n)
#pragma unroll
                    for (int i = 0; i < 4; ++i) { const float gt = acc[ai][0][m][n][i] * r, up = acc[ai][1][m][n][i] * r; o[n * 4 + i] = gt * sigmoidf_(gt) * up; }
                u32x4 w; w.x = cvtpk(o[0], o[1]); w.y = cvtpk(o[2], o[3]); w.z = cvtpk(o[4], o[5]); w.w = cvtpk(o[6], o[7]);
                *(u32x4*)(H + (size_t)(row0 + 128 * ai + 16 * m) * DFF + col0) = w;
            }
    }
};
struct EpiResid {
    static constexpr bool PERM = false;
    const bf16_t* hin; bf16_t* hout; float* ssq; float scale;
    __device__ __forceinline__ void operator()(const f32x4 (&acc)[2][2][4][2], const Unit& u, int wr, int wc, int fr_, int fq_) const {
        (void)fr_; (void)fq_; unsigned o_ = ~0u; asm volatile("" : "+s"(o_)); const int lane = (int)__builtin_amdgcn_mbcnt_hi(o_, __builtin_amdgcn_mbcnt_lo(o_, 0u)); const int fr = lane & 15, fq = lane >> 4;
        const int row0 = u.pm * 256 + wr * 64 + fr, col0 = u.pn * 256 + wc * 32 + 4 * fq;
#pragma unroll
        for (int ai = 0; ai < 2; ++ai) {
            u32x2 bs[4][2][2];
#pragma unroll
            for (int m = 0; m < 4; ++m)
#pragma unroll
                for (int bj = 0; bj < 2; ++bj)
#pragma unroll
                    for (int n = 0; n < 2; ++n) bs[m][bj][n] = *(const u32x2*)(hin + (size_t)(row0 + 128 * ai + 16 * m) * DM + col0 + bj * 128 + n * 16);
            asm volatile("" ::: "memory");
#pragma unroll
            for (int m = 0; m < 4; ++m) {
                const int row = row0 + 128 * ai + 16 * m; const size_t off = (size_t)row * DM + col0; float ss = 0.f;
#pragma unroll
                for (int bj = 0; bj < 2; ++bj)
#pragma unroll
                    for (int n = 0; n < 2; ++n) {
                        const size_t o2 = off + bj * 128 + n * 16; const u32x2 b = bs[m][bj][n];
                        const f32x4 bf = {h_lo(b.x), h_hi(b.x), h_lo(b.y), h_hi(b.y)};
                        const f32x4 o = bf + acc[ai][bj][m][n] * scale;
                        ss += (o[0] * o[0] + o[1] * o[1]) + (o[2] * o[2] + o[3] * o[3]);
                        u32x2 w; w.x = cvtpk_h(o[0], o[1]); w.y = cvtpk_h(o[2], o[3]); *(u32x2*)(hout + o2) = w;
                    }
                ss += sx(ss, 16, lane); ss += sx(ss, 32, lane);
                if (fq == 0) ssq[(size_t)row * 16 + u.pn * 4 + wc] = ss;
            }
            asm volatile("" ::: "memory");
        }
    }
};
struct EpiPleGate {
    static constexpr bool PERM = false;
    const LAS float* rtab; const bf16_t* hin; bf16_t* hout; float* ssq_out; const float* bg; const bf16_t* pp;
    __device__ __forceinline__ void operator()(const f32x4 (&acc)[2][2][4][2], const Unit& u, int wr, int wc, int fr_, int fq_) const {
        (void)fr_; (void)fq_; unsigned o_ = ~0u; asm volatile("" : "+s"(o_)); const int lane = (int)__builtin_amdgcn_mbcnt_hi(o_, __builtin_amdgcn_mbcnt_lo(o_, 0u)); const int fr = lane & 15, fq = lane >> 4;
        const int row0 = u.pm * 256 + wr * 64 + fr, col0 = u.pn * 256 + wc * 32 + 4 * fq;
        float rs[8]; row_rstd8_lds(rtab, u.ui, wr * 64 + fr, rs);
#pragma unroll
        for (int ai = 0; ai < 2; ++ai)
#pragma unroll
        for (int mp = 0; mp < 2; ++mp) {
            u32x2 bs[2][2][2], pw[2][2][2];
#pragma unroll
            for (int mm = 0; mm < 2; ++mm)
#pragma unroll
                for (int bj = 0; bj < 2; ++bj)
#pragma unroll
                    for (int n = 0; n < 2; ++n) { const size_t o2 = (size_t)(row0 + 128 * ai + 16 * (2 * mp + mm)) * DM + col0 + bj * 128 + n * 16; bs[mm][bj][n] = *(const u32x2*)(hin + o2); pw[mm][bj][n] = *(const u32x2*)(pp + o2); }
            asm volatile("" ::: "memory");
#pragma unroll
            for (int mm = 0; mm < 2; ++mm) {
                const int m = 2 * mp + mm;
                const int row = row0 + 128 * ai + 16 * m; const size_t off = (size_t)row * DM + col0; float ss = 0.f; const float r = rs[ai * 4 + m];
#pragma unroll
                for (int bj = 0; bj < 2; ++bj)
#pragma unroll
                    for (int n = 0; n < 2; ++n) {
                        const size_t o2 = off + bj * 128 + n * 16; const u32x2 b = bs[mm][bj][n]; const u32x2 p2 = pw[mm][bj][n];
                        const f32x4 bbv = *(const f32x4*)(bg + col0 + bj * 128 + n * 16);
                        f32x4 o;
                        o[0] = h_lo(b.x) + sigmoidf_(acc[ai][bj][m][n][0] * r + bbv[0]) * bf_lo(p2.x);
                        o[1] = h_hi(b.x) + sigmoidf_(acc[ai][bj][m][n][1] * r + bbv[1]) * bf_hi(p2.x);
                        o[2] = h_lo(b.y) + sigmoidf_(acc[ai][bj][m][n][2] * r + bbv[2]) * bf_lo(p2.y);
                        o[3] = h_hi(b.y) + sigmoidf_(acc[ai][bj][m][n][3] * r + bbv[3]) * bf_hi(p2.y);
                        ss += (o[0] * o[0] + o[1] * o[1]) + (o[2] * o[2] + o[3] * o[3]);
                        u32x2 w; w.x = cvtpk_h(o[0], o[1]); w.y = cvtpk_h(o[2], o[3]); *(u32x2*)(hout + o2) = w;
                    }
                ss += sx(ss, 16, lane); ss += sx(ss, 32, lane);
                if (fq == 0) ssq_out[(size_t)row * 16 + u.pn * 4 + wc] = ss;
            }
            asm volatile("" ::: "memory");
        }
    }
};
struct EpiBf16 {
    static constexpr bool PERM = true;
    bf16_t* O; int ldo;
    __device__ __forceinline__ void operator()(const f32x4 (&acc)[2][2][4][2], const Unit& u, int wr, int wc, int fr_, int fq_) const {
        (void)fr_; (void)fq_; unsigned o_ = ~0u; asm volatile("" : "+s"(o_)); const int lane = (int)__builtin_amdgcn_mbcnt_hi(o_, __builtin_amdgcn_mbcnt_lo(o_, 0u)); const int fr = lane & 15, fq = lane >> 4;
        const int row0 = u.pm * 256 + wr * 64 + fr, col0 = u.pn * 256 + wc * 32 + 8 * fq;
#pragma unroll
        for (int ai = 0; ai < 2; ++ai)
#pragma unroll
            for (int m = 0; m < 4; ++m)
#pragma unroll
                for (int bj = 0; bj < 2; ++bj) {
                    const f32x4 v0 = acc[ai][bj][m][0], v1 = acc[ai][bj][m][1];
                    u32x4 w; w.x = cvtpk(v0[0], v0[1]); w.y = cvtpk(v0[2], v0[3]); w.z = cvtpk(v1[0], v1[1]); w.w = cvtpk(v1[2], v1[3]);
                    *(u32x4*)(O + (size_t)(row0 + 128 * ai + 16 * m) * ldo + col0 + bj * 128) = w;
                }
    }
};
struct EpiQkv {
    static constexpr bool PERM = true;
    const LAS float* rtab; bf16_t* O; int ldo; int qs_end, rope_end, fg_tile; const f32x2* rope; const float* bf; float* flog;
    __device__ __forceinline__ void operator()(const f32x4 (&acc)[2][2][4][2], const Unit& u, int wr, int wc, int fr_, int fq_) const {
        (void)fr_; (void)fq_; unsigned o_ = ~0u; asm volatile("" : "+s"(o_)); const int lane = (int)__builtin_amdgcn_mbcnt_hi(o_, __builtin_amdgcn_mbcnt_lo(o_, 0u)); const int fr = lane & 15, fq = lane >> 4;
        const int row0 = u.pm * 256 + wr * 64 + fr, colt = u.pn * 256;
        float rs[8]; row_rstd8_lds(rtab, u.ui, wr * 64 + fr, rs);
        if (u.pn == fg_tile) {
            if (wc == 0 && fq < 2) {
                const f32x4 b0 = *(const f32x4*)(bf + 8 * fq), b1 = *(const f32x4*)(bf + 8 * fq + 4);
#pragma unroll
                for (int ai = 0; ai < 2; ++ai)
#pragma unroll
                    for (int m = 0; m < 4; ++m) {
                        const float r = rs[ai * 4 + m]; f32x4 o0, o1;
#pragma unroll
                        for (int i = 0; i < 4; ++i) {
                            const float x0 = acc[ai][0][m][0][i] * r + b0[i], x1 = acc[ai][0][m][1][i] * r + b1[i];
                            o0[i] = fminf(x0, 0.f) - logf(1.0f + expf(-fabsf(x0))); o1[i] = fminf(x1, 0.f) - logf(1.0f + expf(-fabsf(x1)));
                        }
                        float* p = flog + (size_t)(row0 + 128 * ai + 16 * m) * 16 + 8 * fq;
                        *(f32x4*)p = o0; *(f32x4*)(p + 4) = o1;
                    }
            }
            return;
        }
        const float sc = colt < qs_end ? QSCALE : 1.0f;
        const bool do_rope = (colt < rope_end) && ((wc & 1) == 0);
        const float sgn = fq == 0 ? -1.0f : 1.0f;
#pragma unroll
        for (int ai = 0; ai < 2; ++ai) {
            f32x4 csa[4][4] = {};
            if (do_rope) {
#pragma unroll
                for (int m = 0; m < 4; ++m) { const f32x4* tp = (const f32x4*)(rope + (size_t)((row0 + 128 * ai + 16 * m) & (SEQ - 1)) * 8);
#pragma unroll
                    for (int j = 0; j < 4; ++j) csa[m][j] = tp[j]; }
            }
#pragma unroll
            for (int m = 0; m < 4; ++m) {
                const int row = row0 + 128 * ai + 16 * m; const float r = rs[ai * 4 + m] * sc;
#pragma unroll
                for (int bj = 0; bj < 2; ++bj) {
                    f32x4 v0 = acc[ai][bj][m][0] * r, v1 = acc[ai][bj][m][1] * r;
                    if (do_rope) {
                        const f32x4 (&cs)[4] = csa[m];
                        f32x4 p0, p1;
#pragma unroll
                        for (int i = 0; i < 4; ++i) { p0[i] = sx(v0[i], 16, lane); p1[i] = sx(v1[i], 16, lane); }
                        if (fq < 2) {
                            v0[0] = v0[0] * cs[0][0] + sgn * p0[0] * cs[0][1]; v0[1] = v0[1] * cs[0][2] + sgn * p0[1] * cs[0][3];
                            v0[2] = v0[2] * cs[1][0] + sgn * p0[2] * cs[1][1]; v0[3] = v0[3] * cs[1][2] + sgn * p0[3] * cs[1][3];
                            v1[0] = v1[0] * cs[2][0] + sgn * p1[0] * cs[2][1]; v1[1] = v1[1] * cs[2][2] + sgn * p1[1] * cs[2][3];
                            v1[2] = v1[2] * cs[3][0] + sgn * p1[2] * cs[3][1]; v1[3] = v1[3] * cs[3][2] + sgn * p1[3] * cs[3][3];
                        }
                    }
                    u32x4 w; w.x = cvtpk(v0[0], v0[1]); w.y = cvtpk(v0[2], v0[3]); w.z = cvtpk(v1[0], v1[1]); w.w = cvtpk(v1[2], v1[3]);
                    *(u32x4*)(O + (size_t)row * ldo + colt + bj * 128 + wc * 32 + 8 * fq) = w;
                }
            }
        }
    }
};
struct EpiSguIn {
    static constexpr bool PERM = true;
    const LAS float* rtab; bf16_t* O; float* ssqv;
    __device__ __forceinline__ void operator()(const f32x4 (&acc)[2][2][4][2], const Unit& u, int wr, int wc, int fr_, int fq_) const {
        (void)fr_; (void)fq_; unsigned o_ = ~0u; asm volatile("" : "+s"(o_)); const int lane = (int)__builtin_amdgcn_mbcnt_hi(o_, __builtin_amdgcn_mbcnt_lo(o_, 0u)); const int fr = lane & 15, fq = lane >> 4;
        const int row0 = u.pm * 256 + wr * 64 + fr, col0 = u.pn * 256 + wc * 32 + 8 * fq;
        float rs[8]; row_rstd8_lds(rtab, u.ui, wr * 64 + fr, rs);
#pragma unroll
        for (int ai = 0; ai < 2; ++ai)
#pragma unroll
            for (int m = 0; m < 4; ++m) {
                const int row = row0 + 128 * ai + 16 * m; const float r = rs[ai * 4 + m]; float ss = 0.f;
#pragma unroll
                for (int bj = 0; bj < 2; ++bj) {
                    float o[8];
#pragma unroll
                    for (int n = 0; n < 2; ++n)
#pragma unroll
                        for (int i = 0; i < 4; ++i) { const float gv = gelu_erf(acc[ai][bj][m][n][i] * r); o[n * 4 + i] = gv; ss += gv * gv; }
                    u32x4 w; w.x = cvtpk(o[0], o[1]); w.y = cvtpk(o[2], o[3]); w.z = cvtpk(o[4], o[5]); w.w = cvtpk(o[6], o[7]);
                    *(u32x4*)(O + (size_t)row * 4096 + col0 + bj * 128) = w;
                }
                if (u.pn >= 8) { ss += sx(ss, 16, lane); ss += sx(ss, 32, lane); if (fq == 0) ssqv[(size_t)row * 32 + (u.pn - 8) * 4 + wc] = ss; }
            }
    }
};

struct AttnJob {
    const bf16_t* Q; const bf16_t* K; const bf16_t* V; bf16_t* O;
    long pitch, opitch;
    const float* bias; int bstride;
    float* lse; int lstride;
    int q0, window;
};
constexpr int A_K = 0, A_V = 32768, A_B = 98304, A_WS = 114688, A_NB = 4;
__device__ __forceinline__ int crow(int r, int hi) { return (r & 3) + 8 * (r >> 2) + 4 * hi; }
__device__ __forceinline__ float max3f(float a, float b, float c) { float r; asm("v_max3_f32 %0, %1, %2, %3" : "=v"(r) : "v"(a), "v"(b), "v"(c)); return r; }
#define A_WAITV(n) asm volatile("s_waitcnt vmcnt(" #n ")" ::: "memory")
__device__ __forceinline__ void glds16(const void* gsrc, unsigned lds_dst) { unsigned keep;
    asm volatile("s_mov_b32 %0, m0\n\ts_mov_b32 m0, %2\n\ts_nop 0\n\tglobal_load_lds_dwordx4 %1, off\n\ts_mov_b32 m0, %0" : "=&s"(keep) : "v"(gsrc), "s"(lds_dst) : "memory"); }

#ifndef ATT_SGB
#define ATT_SGB 1
#endif
#ifndef ATT_SGB2
#define ATT_SGB2 0
#endif
template <int NDB, bool BIAS>
__device__ __forceinline__ void attn_unit(LAS unsigned char* lds, const int tid, const AttnJob& J) {
    constexpr int VGRP = NDB * 256, VBUF = 16 * VGRP, NVD = NDB / 2;
    const int lane = tid & 63, r32 = lane & 31, hi = lane >> 5; const int wid = __builtin_amdgcn_readfirstlane(tid >> 6);
    const int q0 = J.q0, W = J.window;
    const int t_lo = (q0 - W > 0 ? q0 - W : 0) >> 6, t_hi = (q0 + 255) >> 6, nt = t_hi - t_lo + 1;
    const int qw = q0 + 32 * wid;
    const int tw_lo = (qw - W > 0 ? qw - W : 0) >> 6, tw_hi = (qw + 31) >> 6;
    const int qrow = qw + r32;
    const bf16_t* kg = J.K + (long)(8 * wid + (lane >> 3)) * J.pitch + (((lane & 7) ^ (lane >> 3)) * 8);
    const bf16_t* vg[NVD];
#pragma unroll
    for (int j = 0; j < NVD; ++j) { const int B = (wid + 8 * j) * 1024 + lane * 16; const int kv = 4 * (B / VGRP) + ((B >> 6) & 3), d = 32 * ((B % VGRP) >> 8) + 8 * ((B >> 4) & 3);
        vg[j] = J.V + (long)kv * J.pitch + d; }
    const long tstride = 64 * J.pitch;
    const unsigned lds0 = (unsigned)(uintptr_t)lds;
#define A_DMA(t_) do { const int t__ = (t_); const int bf__ = t__ & 3; \
        glds16(kg + (long)t__ * tstride, (unsigned)__builtin_amdgcn_readfirstlane(lds0 + A_K + bf__ * 8192 + wid * 1024)); \
        _Pragma("unroll") for (int j_ = 0; j_ < NVD; ++j_) \
            glds16(vg[j_] + (long)t__ * tstride, (unsigned)__builtin_amdgcn_readfirstlane(lds0 + A_V + bf__ * VBUF + (wid + 8 * j_) * 1024)); } while (0)
    LAS float* wsf = (LAS float*)(lds + A_WS) + wid * 64;
    A_DMA(t_lo); if (nt > 1) A_DMA(t_lo + 1);
    bf16x8 qr[4];
    { const bf16_t* qp = J.Q + (long)qrow * J.pitch + hi * 8;
#pragma unroll
      for (int d0 = 0; d0 < 4; ++d0) qr[d0] = *(const bf16x8*)(qp + d0 * 16); }
    if (BIAS) { for (int k = t_lo * 64 + tid; k < (t_hi + 1) * 64; k += 512) *(LAS float*)(lds + A_B + (k - t_lo * 64) * 4) = J.bias[(long)k * J.bstride] * (-1.0f / QSCALE); }
    asm volatile("" :: "v"(qr[0]), "v"(qr[1]), "v"(qr[2]), "v"(qr[3]));
    float m_run = -1e30f, l_run = 0.f, alpha_prev = 1.0f; f32x16 o[NDB], pe0 = {}, pe1 = {};
#pragma unroll
    for (int db = 0; db < NDB; ++db) o[db] = (f32x16){};
    const int g16 = (lane >> 4) & 1, i16 = lane & 15;
    const int vrd = A_V + hi * VGRP + (i16 >> 2) * 64 + g16 * 32 + (i16 & 3) * 8;
    const int krd = A_K + r32 * 128;
    const int ksw = r32 & 7;
#define A_RESCALE() do { if (__any(alpha_prev != 1.0f)) { if (hi == 0) wsf[r32] = alpha_prev; \
        _Pragma("unroll") for (int g = 0; g < 4; ++g) { const f32x4 a_ = *(const LAS f32x4*)(wsf + 8 * g + 4 * hi); \
            _Pragma("unroll") for (int db = 0; db < NDB; ++db) _Pragma("unroll") for (int i = 0; i < 4; ++i) o[db][4 * g + i] *= a_[i]; } } } while (0)
#define A_SUMPACK(ls_, pa_) do { f32x2 a2_ = {0.f, 0.f}, b2_ = {0.f, 0.f}; _Pragma("unroll") for (int r = 0; r < 8; ++r) { a2_ += (f32x2){pe0[2 * r], pe0[2 * r + 1]}; b2_ += (f32x2){pe1[2 * r], pe1[2 * r + 1]}; } a2_ += b2_; ls_ = a2_[0] + a2_[1]; \
        _Pragma("unroll") for (int s_ = 0; s_ < 2; ++s_) { u32x4 w0, w1; \
            w0.x = cvtpk(pe0[8 * s_ + 0], pe0[8 * s_ + 1]); w0.y = cvtpk(pe0[8 * s_ + 2], pe0[8 * s_ + 3]); w0.z = cvtpk(pe0[8 * s_ + 4], pe0[8 * s_ + 5]); w0.w = cvtpk(pe0[8 * s_ + 6], pe0[8 * s_ + 7]); \
            w1.x = cvtpk(pe1[8 * s_ + 0], pe1[8 * s_ + 1]); w1.y = cvtpk(pe1[8 * s_ + 2], pe1[8 * s_ + 3]); w1.z = cvtpk(pe1[8 * s_ + 4], pe1[8 * s_ + 5]); w1.w = cvtpk(pe1[8 * s_ + 6], pe1[8 * s_ + 7]); \
            pa_[s_] = __builtin_bit_cast(bf16x8, w0); pa_[2 + s_] = __builtin_bit_cast(bf16x8, w1); } } while (0)
#define A_PV(pa_, vb_) do { _Pragma("unroll") for (int s_ = 0; s_ < 4; ++s_) { bf16x8 vf_[NDB]; \
        _Pragma("unroll") for (int db = 0; db < NDB; ++db) { const LAS unsigned char* vp = lds + vrd + (vb_) * VBUF + s_ * 4 * VGRP + db * 256; \
            const s16x4 lo_ = __builtin_bit_cast(s16x4, __builtin_amdgcn_ds_read_tr16_b64_v4i16((LAS s16x4*)vp)); \
            const s16x4 hh_ = __builtin_bit_cast(s16x4, __builtin_amdgcn_ds_read_tr16_b64_v4i16((LAS s16x4*)(vp + 2 * VGRP))); \
            vf_[db] = (bf16x8){lo_[0], lo_[1], lo_[2], lo_[3], hh_[0], hh_[1], hh_[2], hh_[3]}; } \
        _Pragma("unroll") for (int db = 0; db < NDB; ++db) o[db] = __builtin_amdgcn_mfma_f32_32x32x16_bf16(pa_[s_], vf_[db], o[db], 0, 0, 0); } } while (0)
#pragma unroll 1
    for (int it = 0; it < nt; ++it) {
        const int t = t_lo + it, cur = t & 3;
        if (it + 1 < nt) { if (NDB == 2) A_WAITV(2); else A_WAITV(3); } else A_WAITV(0);
        asm volatile("s_waitcnt lgkmcnt(0)" ::: "memory");
        __builtin_amdgcn_s_barrier();
        asm volatile("" ::: "memory");
        if (it + 2 < nt) A_DMA(t + 2);
        if (t >= tw_lo && t <= tw_hi) {
            const LAS unsigned char* Kb = lds + krd + cur * 8192;
            bf16x8 kf[8];
#pragma unroll
            for (int d0 = 0; d0 < 4; ++d0) { const int off = ((2 * d0 + hi) ^ ksw) << 4; kf[2 * d0] = *(const LAS bf16x8*)(Kb + off); kf[2 * d0 + 1] = *(const LAS bf16x8*)(Kb + 4096 + off); }
            f32x16 p0, p1;
            if (BIAS) {
                const LAS float* bb = (const LAS float*)(lds + A_B + it * 256);
#pragma unroll
                for (int g = 0; g < 4; ++g) { const f32x4 b0 = *(const LAS f32x4*)(bb + 8 * g + 4 * hi), b1 = *(const LAS f32x4*)(bb + 32 + 8 * g + 4 * hi);
#pragma unroll
                    for (int i = 0; i < 4; ++i) { p0[4 * g + i] = b0[i]; p1[4 * g + i] = b1[i]; } }
            }
            float ls; bf16x8 pa[4];
#pragma unroll
            for (int d0 = 0; d0 < 4; ++d0) {
                if (!BIAS && d0 == 0) {
                    const f32x16 z = {};
                    p0 = __builtin_amdgcn_mfma_f32_32x32x16_bf16(kf[0], qr[0], z, 0, 0, 0);
                    p1 = __builtin_amdgcn_mfma_f32_32x32x16_bf16(kf[1], qr[0], z, 0, 0, 0);
                } else {
                    p0 = __builtin_amdgcn_mfma_f32_32x32x16_bf16(kf[2 * d0], qr[d0], p0, 0, 0, 0);
                    p1 = __builtin_amdgcn_mfma_f32_32x32x16_bf16(kf[2 * d0 + 1], qr[d0], p1, 0, 0, 0);
                }
            }
            A_SUMPACK(ls, pa);
#if ATT_SGB
#pragma unroll
            for (int i = 0; i < 8; ++i) { __builtin_amdgcn_sched_group_barrier(0x008, 1, 0); __builtin_amdgcn_sched_group_barrier(0x002, 4, 0); }
#endif
            l_run += ls;
            const bool first = (t == tw_lo);
            const float mold = first ? 0.f : m_run; const f32x2 mo2 = {-mold, -mold};
            f32x2 q0[8], q1[8];
#pragma unroll
            for (int r = 0; r < 8; ++r) { q0[r] = (f32x2){p0[2 * r], p0[2 * r + 1]} * QSCALE + mo2; q1[r] = (f32x2){p1[2 * r], p1[2 * r + 1]} * QSCALE + mo2; }
            const int kv0 = t * 64;
            const bool need_mask = (kv0 + 63 > qw) || (qw + 31 - kv0 > W);
            if (need_mask) {
#pragma unroll
                for (int r = 0; r < 16; ++r) { const int kv = kv0 + crow(r, hi);
                    if (kv > qrow || qrow - kv > W) q0[r >> 1][r & 1] = -INFINITY;
                    if (kv + 32 > qrow || qrow - kv - 32 > W) q1[r >> 1][r & 1] = -INFINITY; }
            }
            float mxa = max3f(q0[0][0], q0[0][1], q1[0][0]), mxb = max3f(q1[0][1], q0[1][0], q0[1][1]);
            mxa = max3f(mxa, q1[1][0], q1[1][1]);
#pragma unroll
            for (int r = 2; r < 8; ++r) { mxa = max3f(mxa, q0[r][0], q0[r][1]); mxb = max3f(mxb, q1[r][0], q1[r][1]); }
            float mx = fmaxf(mxa, mxb); mx = fmaxf(mx, sx(mx, 32, lane));
            float alpha = 1.0f;
            if (first || __any(mx > 8.0f)) {
                const float dl = first ? mx : fmaxf(mx, 0.f); const f32x2 dl2 = {dl, dl};
                m_run = mold + dl; alpha = first ? 0.f : fast_exp2(-dl); l_run *= alpha;
#pragma unroll
                for (int r = 0; r < 8; ++r) { q0[r] -= dl2; q1[r] -= dl2; }
            }
            if (t > tw_lo) {
                A_RESCALE();
                A_PV(pa, (t - 1) & 3);
#pragma unroll
                for (int r = 0; r < 8; ++r) { pe0[2 * r] = fast_exp2(q0[r][0]); pe0[2 * r + 1] = fast_exp2(q0[r][1]); pe1[2 * r] = fast_exp2(q1[r][0]); pe1[2 * r + 1] = fast_exp2(q1[r][1]); }
#if ATT_SGB && ATT_SGB2
#pragma unroll
                for (int i = 0; i < NDB * 4; ++i) { __builtin_amdgcn_sched_group_barrier(0x100, 2, 0); __builtin_amdgcn_sched_group_barrier(0x008, 1, 0); __builtin_amdgcn_sched_group_barrier(0x002, 32 / (NDB * 4), 0); }
#endif
            } else {
#pragma unroll
                for (int r = 0; r < 8; ++r) { pe0[2 * r] = fast_exp2(q0[r][0]); pe0[2 * r + 1] = fast_exp2(q0[r][1]); pe1[2 * r] = fast_exp2(q1[r][0]); pe1[2 * r + 1] = fast_exp2(q1[r][1]); }
            }
            alpha_prev = alpha;
            if (t == tw_hi) {
                float ls2; bf16x8 pa2[4];
                A_SUMPACK(ls2, pa2); l_run += ls2;
                A_RESCALE();
                A_PV(pa2, cur);
            }
        }
    }
    asm volatile("s_waitcnt lgkmcnt(0)" ::: "memory");
    __builtin_amdgcn_s_barrier();
    asm volatile("" ::: "memory");
    const float l_tot = l_run + sx(l_run, 32, lane);
    if (J.lse && hi == 0) J.lse[(long)qrow * J.lstride] = (m_run + log2f(l_tot)) * LN2;
    if (hi == 0) wsf[r32] = 1.0f / l_tot;
    LAS bf16_t* stg = (LAS bf16_t*)(lds) + wid * (NDB * 1024);
#pragma unroll
    for (int g = 0; g < 4; ++g) { const f32x4 a = *(const LAS f32x4*)(wsf + 8 * g + 4 * hi);
#pragma unroll
        for (int i = 0; i < 4; ++i) { const int orow = 8 * g + 4 * hi + i;
#pragma unroll
            for (int db = 0; db < NDB; ++db) stg[orow * (NDB * 32) + db * 32 + r32] = (bf16_t)(cvtpk(o[db][4 * g + i] * a[i], 0.f) & 0xffffu); } }
    bf16_t* Ow = J.O + (long)qw * J.opitch;
#pragma unroll
    for (int i = 0; i < NDB * 2; ++i) { const int idx = i * 64 + lane, row = idx / (NDB * 4), ch = idx % (NDB * 4);
        const u32x4 v = *(const LAS u32x4*)(stg + row * (NDB * 32) + ch * 8); *(u32x4*)(Ow + (long)row * J.opitch + ch * 8) = v; }
    __syncthreads();
#undef A_DMA
#undef A_RESCALE
#undef A_SUMPACK
#undef A_PV
}

#define XB_TMO      128
#define XB_XCNT(j)  (256  + 64 * (j))
#define XB_XSUB(j)  (1280 + 64 * (j))
#define XB_XGEN(j)  (2304 + 64 * (j))
#define XB_TOP      3328
#define XB_TOPGEN   3392
#define XCD_BAR_WORDS 3456
#define XB_SPIN_CAP (1u << 18)
constexpr int XB_ST_OFF = 147440;
__device__ __forceinline__ unsigned xb_ld(unsigned* p)              { return __hip_atomic_load(p, __ATOMIC_RELAXED, __HIP_MEMORY_SCOPE_AGENT); }
__device__ __forceinline__ unsigned xb_add(unsigned* p, unsigned v) { return __hip_atomic_fetch_add(p, v, __ATOMIC_RELAXED, __HIP_MEMORY_SCOPE_AGENT); }
__device__ __forceinline__ unsigned xb_xcc_id() { return (unsigned)__builtin_amdgcn_s_getreg((3 << 11) | 20) & 0xFu; }
#define XB_SPIN(cond, bar) do { unsigned _sp = 0; while (cond) { __builtin_amdgcn_s_sleep(1); \
    if ((++_sp & 255u) == 0u) { if (xb_ld(&(bar)[XB_TMO])) break; if (_sp > XB_SPIN_CAP) { atomicAdd(&(bar)[XB_TMO], 1u); break; } } } } while (0)
__device__ __forceinline__ void xcd_barrier_complete(unsigned* bar, unsigned x, unsigned G, unsigned& nloc, unsigned& nx) {
    unsigned sum, cnt, mine, sp = 0u;
    for (;;) {
        sum = 0u; cnt = 0u; mine = 0u;
#pragma unroll
        for (unsigned j = 0; j < 16; ++j) { const unsigned c = xb_ld(&bar[XB_XCNT(j)]); sum += c; cnt += (c > 0u) ? 1u : 0u; mine = (j == x) ? c : mine; }
        if (sum == G) break;
        __builtin_amdgcn_s_sleep(1);
        if ((++sp & 255u) == 0u) { if (xb_ld(&bar[XB_TMO])) break; if (sp > XB_SPIN_CAP) { atomicAdd(&bar[XB_TMO], 1u); break; } }
    }
    nloc = mine > 0u ? mine : 1u; nx = cnt > 0u ? cnt : 1u;
}
__device__ __forceinline__ void grid_bar(unsigned* bar, LAS unsigned char* lds, unsigned G, int tid) {
    asm volatile("s_waitcnt vmcnt(0)" ::: "memory");
    __syncthreads();
    if (tid == 0) {
        volatile LAS unsigned* st = (volatile LAS unsigned*)(lds + XB_ST_OFF);
        const unsigned x = xb_xcc_id();
        __builtin_amdgcn_s_waitcnt(0);
        unsigned nloc = st[0], nx = st[1];
        if (nloc == 0u) { xcd_barrier_complete(bar, x, G, nloc, nx); st[0] = nloc; st[1] = nx; }
        const unsigned old = xb_add(&bar[XB_XSUB(x)], 1u);
        const unsigned gen = old / nloc;
        if (old + 1u == (gen + 1u) * nloc) {
            __builtin_amdgcn_fence(__ATOMIC_RELEASE, "agent");
            asm volatile("s_waitcnt vmcnt(0)" ::: "memory");
            const unsigned og = xb_add(&bar[XB_TOP], 1u);
            const unsigned tg = og / nx;
            if (og + 1u == (tg + 1u) * nx) xb_add(&bar[XB_TOPGEN], 1u);
            else XB_SPIN(xb_ld(&bar[XB_TOPGEN]) == tg, bar);
            __builtin_amdgcn_fence(__ATOMIC_ACQUIRE, "agent");
            xb_add(&bar[XB_XGEN(x)], 1u);
            asm volatile("s_waitcnt vmcnt(0)" ::: "memory");
        } else {
            XB_SPIN(xb_ld(&bar[XB_XGEN(x)]) == gen, bar);
            __builtin_amdgcn_fence(__ATOMIC_ACQUIRE, "agent");
            asm volatile("s_waitcnt vmcnt(0)" ::: "memory");
        }
    }
    __syncthreads();
}

__device__ __forceinline__ void fill_rtab(LAS unsigned char* lds, const pg8::StaticOrder& SO, const float* ssq, int tid) {
    LAS float* rtab = (LAS float*)(lds + RTAB_OFF);
    f32x4 v[6][4]; bool ok[6];
#pragma unroll
    for (int j = 0; j < 6; ++j) { pg8::Unit uu; ok[j] = SO.next(2 * j + (tid >> 8), uu);
        if (ok[j]) { const f32x4* sp = (const f32x4*)(ssq + ((size_t)uu.pm * 256 + (tid & 255)) * 16);
#pragma unroll
            for (int q = 0; q < 4; ++q) v[j][q] = sp[q]; } }
#pragma unroll
    for (int j = 0; j < 6; ++j) if (ok[j]) { float sm = 0.f;
#pragma unroll
        for (int q = 0; q < 4; ++q) sm += (v[j][q][0] + v[j][q][1]) + (v[j][q][2] + v[j][q][3]);
        rtab[(2 * j + (tid >> 8)) * 256 + (tid & 255)] = 1.0f / sqrtf(sm * (1.0f / DM) + NORM_EPS); }
    __syncthreads();
}

struct Args {
    const float *x, *p, *norm_ffn1, *w_ffn1_in, *w_ffn1_out, *norm_mix, *norm_ffn2, *w_ffn2_in, *w_ffn2_out, *norm_ple, *w_ple_gate, *b_ple_gate, *w_ple_proj,
        *fox_w_in, *fox_b_f, *fox_w_out, *dil_w_in, *dil_w_out, *diff_w_in, *diff_lambda, *diff_subln, *diff_w_out, *sgu_w_in, *sgu_norm_v, *sgu_w_s, *sgu_b_s, *sgu_w_out, *norm_final;
    float* out; unsigned char* ws;
};

__device__ __forceinline__ void transpose_item(const float* W, int K, int N, bf16_t* WT, const float* gain, int mode, LAS float* scr, int item, int lane) {
    const int nblk = (N + 31) / 32, kb = item / nblk, nb = item % nblk, k0 = 64 * kb, n0 = 32 * nb;
    const int ncol = n0 + (lane & 31); const bool okc = ncol < N;
    float vv[32];
#pragma unroll
    for (int i = 0; i < 32; ++i) { const int kk = 2 * i + (lane >> 5); vv[i] = okc ? W[(size_t)(k0 + kk) * N + ncol] : 0.f; }
    if (gain) {
#pragma unroll
        for (int i = 0; i < 32; ++i) vv[i] *= gain[k0 + 2 * i + (lane >> 5)];
    }
#pragma unroll
    for (int i = 0; i < 32; ++i) scr[(2 * i + (lane >> 5)) * 33 + (lane & 31)] = vv[i];
    asm volatile("s_waitcnt lgkmcnt(0)" ::: "memory");
    int d0 = n0;
    if (mode & 1) { if (n0 < DFF) d0 = (n0 / 128) * 256 + (n0 % 128); else { const int mm = n0 - DFF; d0 = (mm / 128) * 256 + 128 + (mm % 128); } }
    const int c = lane & 7;
#pragma unroll
    for (int j = 0; j < 4; ++j) { const int n = (lane >> 3) + 8 * j; const LAS float* s = scr + (8 * c) * 33 + n;
        u32x4 o;
        if (mode & 2) {
            const unsigned b0 = cvtpk(s[0 * 33], s[1 * 33]), b1 = cvtpk(s[2 * 33], s[3 * 33]), b2 = cvtpk(s[4 * 33], s[5 * 33]), b3 = cvtpk(s[6 * 33], s[7 * 33]);
            o.x = cvtpk_h(bf_lo(b0), bf_hi(b0)); o.y = cvtpk_h(bf_lo(b1), bf_hi(b1)); o.z = cvtpk_h(bf_lo(b2), bf_hi(b2)); o.w = cvtpk_h(bf_lo(b3), bf_hi(b3)); }
        else { o.x = cvtpk(s[0 * 33], s[1 * 33]); o.y = cvtpk(s[2 * 33], s[3 * 33]); o.z = cvtpk(s[4 * 33], s[5 * 33]); o.w = cvtpk(s[6 * 33], s[7 * 33]); }
        *(u32x4*)(WT + (size_t)(d0 + n) * K + k0 + 8 * c) = o; }
    asm volatile("s_waitcnt lgkmcnt(0)" ::: "memory");
}

__device__ __forceinline__ void get_mat(const Args& a, bf16_t* Wt, int mi, const float*& src, int& K, int& N, bf16_t*& dst, const float*& gain, int& mode) {
    gain = nullptr; mode = 0;
    if (mi < 24) {
        const int L = mi / 6, k = mi % 6; bf16_t* wl = Wt + (size_t)L * L_SIZE;
        if (k == 0)      { src = a.w_ffn1_in + (size_t)L * DM * 2 * DFF; K = DM; N = 2 * DFF; dst = wl + L_FFN1IN; gain = a.norm_ffn1 + L * DM; mode = 3; }
        else if (k == 1) { src = a.w_ffn1_out + (size_t)L * DFF * DM; K = DFF; N = DM; dst = wl + L_FFN1OUT; }
        else if (k == 2) { src = a.w_ffn2_in + (size_t)L * DM * 2 * DFF; K = DM; N = 2 * DFF; dst = wl + L_FFN2IN; gain = a.norm_ffn2 + L * DM; mode = 3; }
        else if (k == 3) { src = a.w_ffn2_out + (size_t)L * DFF * DM; K = DFF; N = DM; dst = wl + L_FFN2OUT; }
        else if (k == 4) { src = a.w_ple_gate + (size_t)L * DM * DM; K = DM; N = DM; dst = wl + L_PLEG; gain = a.norm_ple + L * DM; mode = 2; }
        else             { src = a.w_ple_proj + (size_t)L * PLE * DM; K = PLE; N = DM; dst = wl + L_PLEP; }
    } else {
        const int k = mi - 24;
        if (k == 0)      { src = a.fox_w_in; K = DM; N = 3 * DM + 16; dst = Wt + W_FOXIN; gain = a.norm_mix; mode = 2; }
        else if (k == 1) { src = a.fox_w_out; K = DM; N = DM; dst = Wt + W_FOXOUT; }
        else if (k == 2) { src = a.dil_w_in; K = DM; N = 5 * DM; dst = Wt + W_DILIN; gain = a.norm_mix + DM; mode = 2; }
        else if (k == 3) { src = a.dil_w_out; K = DM; N = DM; dst = Wt + W_DILOUT; }
        else if (k == 4) { src = a.diff_w_in; K = DM; N = 3 * DM; dst = Wt + W_DIFFIN; gain = a.norm_mix + 2 * DM; mode = 2; }
        else if (k == 5) { src = a.diff_w_out; K = DM; N = DM; dst = Wt + W_DIFFOUT; }
        else if (k == 6) { src = a.sgu_w_in; K = DM; N = 4 * DM; dst = Wt + W_SGUIN; gain = a.norm_mix + 3 * DM; mode = 2; }
        else             { src = a.sgu_w_out; K = 2 * DM; N = DM; dst = Wt + W_SGUOUT; }
    }
}

__global__ void __launch_bounds__(512, 2) mega(Args a) {
    extern __shared__ __attribute__((aligned(16))) unsigned char lds_raw[];
    LAS unsigned char* lds = (LAS unsigned char*)lds_raw;
#if TSEL == 13 || TSEL == 15
    if (blockIdx.x == 0 && threadIdx.x == 0) *(unsigned long long*)((float*)(a.ws + WS_MISC) + 10) = __builtin_amdgcn_s_memrealtime();
#endif
    if (threadIdx.x == 0) { ((LAS unsigned*)(lds + XB_ST_OFF))[0] = 0u; ((LAS unsigned*)(lds + XB_ST_OFF))[1] = 0u; (void)xb_add(&((unsigned*)(a.ws + WS_BAR))[XB_XCNT(xb_xcc_id())], 1u); }
    __syncthreads();
    cg::this_grid().sync();
    const int wave0 = __builtin_amdgcn_readfirstlane((int)threadIdx.x >> 6);
#define gt ((long)bid * 512 + tid)
#define ssqX ((float*)(ws + WS_SSQX))
#define ssqY ((float*)(ws + WS_SSQY))
#define ssqV ((float*)(ws + WS_SSQV))
#define lseb ((float*)(ws + WS_LSE))
#define flog ((float*)(ws + WS_FLOG))
#define rope ((f32x2*)(ws + WS_ROPE))
#define misc ((float*)(ws + WS_MISC))
#define pbf ((bf16_t*)(ws + WS_PBF))
#define hb ((bf16_t*)(ws + WS_HB))
#define Wt ((bf16_t*)(ws + WS_W))
#define S1 ((bf16_t*)(ws + WS_S1))
#define FRESH_TID(name) int name; { int w_ = wave0; asm volatile("" : "+s"(w_)); unsigned o_ = ~0u; asm volatile("" : "+s"(o_)); name = w_ * 64 + (int)__builtin_amdgcn_mbcnt_hi(o_, __builtin_amdgcn_mbcnt_lo(o_, 0u)); asm volatile("" : "+v"(name)); }
#define PHASE_VARS \
    int wave_ = wave0; asm volatile("" : "+s"(wave_)); \
    unsigned ones_ = ~0u; asm volatile("" : "+s"(ones_)); \
    int tid = wave_ * 64 + (int)__builtin_amdgcn_mbcnt_hi(ones_, __builtin_amdgcn_mbcnt_lo(ones_, 0u)); asm volatile("" : "+v"(tid)); \
    int bid = blockIdx.x; asm volatile("" : "+s"(bid)); \
    int G = gridDim.x; asm volatile("" : "+s"(G)); \
    const int lane = tid & 63, wave = wave_; \
    const int gw = bid * 8 + wave, NGW = G * 8; \
    const long NGT = (long)G * 512; \
    gbyte_t* wsg_ = (gbyte_t*)a.ws; asm volatile("" : "+s"(wsg_)); unsigned char* ws = (unsigned char*)wsg_; \
    float* h = a.out; \
    (void)lane; (void)wave; (void)gw; (void)NGW; (void)NGT; (void)h; (void)ws;

    {
#if TSEL == 12
        const unsigned long long tkp_ = __builtin_amdgcn_s_memrealtime();
#endif
        PHASE_VARS
        LAS float* scr = (LAS float*)(lds + wave * 16384);
#pragma unroll 1
        for (int rep = 0; rep < (PROBE_REP == 6 ? 2 : 1); ++rep) {
        int it0 = 0;
#pragma unroll 1
        for (int mi = 0; mi < 32; ++mi) {
            const float* src; int K_, N_; bf16_t* dst; const float* gain; int mode;
            get_mat(a, Wt, mi, src, K_, N_, dst, gain, mode);
            const int nitems = (K_ / 64) * ((N_ + 31) / 32);
            const int first = it0 + (((gw - it0) % NGW) + NGW) % NGW;
#pragma unroll 1
            for (int gi = first; gi < it0 + nitems; gi += NGW) transpose_item(src, K_, N_, dst, gain, mode, scr, gi - it0, lane);
            it0 += nitems;
        }
#pragma unroll 1
        for (int m0 = gw; m0 < MTOK; m0 += 4 * NGW) {
            f32x4 v[4][4];
#pragma unroll
            for (int q = 0; q < 4; ++q)
#pragma unroll
                for (int j = 0; j < 4; ++j) v[q][j] = ((const f32x4*)(a.x + (size_t)(m0 + q * NGW) * DM) + lane)[64 * j];
#pragma unroll
            for (int q = 0; q < 4; ++q) { const int m = m0 + q * NGW; u32x2* o8 = (u32x2*)(hb + (size_t)m * DM) + lane; float ss = 0.f;
#pragma unroll
                for (int j = 0; j < 4; ++j) { const f32x4 t = v[q][j]; ss += (t[0] * t[0] + t[1] * t[1]) + (t[2] * t[2] + t[3] * t[3]); u32x2 w; w.x = cvtpk_h(t[0], t[1]); w.y = cvtpk_h(t[2], t[3]); o8[64 * j] = w; }
                ss = wave_sum(ss, lane);
                if (lane < 16) ssqX[(size_t)m * 16 + lane] = ss * (1.0f / 16.0f); }
        }
#pragma unroll 1
        for (long i = gt; i < (long)MTOK * PLE / 4; i += NGT) { const f32x4 v = ((const f32x4*)a.p)[i]; u32x2 w; w.x = cvtpk(v[0], v[1]); w.y = cvtpk(v[2], v[3]); ((u32x2*)pbf)[i] = w; }
        if (gt < SEQ * 8) {
            const int pos = (int)(gt >> 3), j = (int)(gt & 7);
            const float invf = j == 0 ? 1.0f : j == 1 ? 0.1939227432012558f : j == 2 ? 0.03760603070259094f : j == 3 ? 0.007292664609849453f : j == 4 ? 0.0014142135623842478f
                             : j == 5 ? 0.00027424818836152554f : j == 6 ? 5.318296098266728e-05f : 1.0313386155758053e-05f;
            const float angf = (float)pos * invf; const double ang = (double)angf;
            const double kk = rint(ang * 0.15915494309189535); const double r = (ang - kk * 6.283185307179586) - kk * 2.4492935982947064e-16; const double r2 = r * r;
            double s = 1.0, c = 1.0;
#pragma unroll
            for (int n = 13; n >= 1; --n) { s = 1.0 - s * r2 * (1.0 / (double)((2 * n) * (2 * n + 1))); c = 1.0 - c * r2 * (1.0 / (double)((2 * n - 1) * (2 * n))); }
            rope[gt] = (f32x2){(float)c, (float)(r * s)};
        }
        if (gt == 0) {
            float s1 = 0.f, s2 = 0.f;
#pragma unroll 1
            for (int i = 0; i < 64; ++i) { s1 += a.diff_lambda[i] * a.diff_lambda[64 + i]; s2 += a.diff_lambda[128 + i] * a.diff_lambda[192 + i]; }
            misc[0] = expf(s1) - expf(s2) + LAM_INIT; misc[8] = 0.f;
        }
        }
        grid_bar((unsigned*)(ws + WS_BAR), lds, (unsigned)G, tid);
#if TSEL == 12
        if (blockIdx.x == 0 && threadIdx.x == 0) misc[8] += (float)(__builtin_amdgcn_s_memrealtime() - tkp_) * 0.01f;
#endif
    }

#pragma unroll 1
    for (int qq = 0; qq < 4 * NSLOTS; ++qq) {
        PHASE_VARS
        pg8::StaticOrder SO;
        bf16_t* const pp = S1 + (size_t)96 * MiB;
        bf16_t* const hb2 = S1 + (size_t)128 * MiB;
        const int L = qq / NSLOTS, sl = qq % NSLOTS;
#if TSEL
        unsigned long long tk0_ = __builtin_amdgcn_s_memrealtime();
#endif
#if PROBE_REP == 1
        const int s = (sl <= 1) ? 0 : (sl <= 7) ? sl - 1 : (sl == 8) ? 6 : sl - 2;
#elif PROBE_REP == 7
        const int s = (sl <= 2) ? sl : sl - 1;
#elif PROBE_REP == 8
        const int s = (sl <= 8) ? sl : 8;
#else
        const int s = sl;
#endif
        const bf16_t* wl = Wt + (size_t)L * L_SIZE;
        if (s == 0 || s == 6) {
            pg8::Gemm g{hb, wl + (s == 0 ? L_FFN1IN : L_FFN2IN), MTOK, 2 * DFF, DM, DM}; SO.init(MTOK, 2 * DFF, G, bid); fill_rtab(lds, SO, ssqX, tid); EpiSwiglu E{(const LAS float*)(lds + RTAB_OFF), S1}; { FRESH_TID(tidg) pg8::gemm_phase<EpiSwiglu, true>(lds, tidg, g, SO, E); }

        } else if (s == 1 || s == 5 || s == 7) {
            const bf16_t* Bt; int K_, lda_; float sc; float* sq;
            if (s == 1) { Bt = wl + L_FFN1OUT; K_ = DFF; lda_ = DFF; sc = 0.5f; sq = ssqY; }
            else if (s == 7) { Bt = wl + L_FFN2OUT; K_ = DFF; lda_ = DFF; sc = 0.5f; sq = ssqY; }
            else { sc = 1.0f; sq = ssqX; K_ = DM;
                if (L == 0) { Bt = Wt + W_FOXOUT; lda_ = 3072; } else if (L == 1) { Bt = Wt + W_DILOUT; lda_ = 5120; } else if (L == 2) { Bt = Wt + W_DIFFOUT; lda_ = 3072; } else { Bt = Wt + W_SGUOUT; K_ = 2 * DM; lda_ = 4096; } }
            { pg8::Gemm g{S1, Bt, MTOK, DM, K_, lda_}; SO.init(MTOK, DM, G, bid); EpiResid E{hb, s == 7 ? hb2 : hb, sq, sc}; pg8::gemm_phase(lds, tid, g, SO, E); }
            if (s == 7) { FRESH_TID(tid4) pg8::Gemm g{pbf, wl + L_PLEP, MTOK, DM, PLE, PLE}; SO.init(MTOK, DM, G, bid); EpiBf16 E{pp, DM}; pg8::gemm_phase(lds, tid4, g, SO, E); }
        } else if (s == 2) {
            if (L < 3) {
                const bf16_t* Bt; int N_, ldo, qs, re, fg;
                if (L == 0) { Bt = Wt + W_FOXIN; N_ = 3328; ldo = 3072; qs = 0; re = 0; fg = 12; }
                else if (L == 1) { Bt = Wt + W_DILIN; N_ = 5120; ldo = 5120; qs = 0; re = 4096; fg = -1; }
                else { Bt = Wt + W_DIFFIN; N_ = 3072; ldo = 3072; qs = 0; re = 2048; fg = -1; }
                pg8::Gemm g{hb, Bt, MTOK, N_, DM, DM}; SO.init(MTOK, N_, G, bid); fill_rtab(lds, SO, ssqY, tid); EpiQkv E{(const LAS float*)(lds + RTAB_OFF), S1, ldo, qs, re, fg, rope, a.fox_b_f, flog}; { FRESH_TID(tidg) pg8::gemm_phase<EpiQkv, true>(lds, tidg, g, SO, E); }
            } else {
                pg8::Gemm g{hb, Wt + W_SGUIN, MTOK, 4096, DM, DM}; SO.init(MTOK, 4096, G, bid); fill_rtab(lds, SO, ssqY, tid); EpiSguIn E{(const LAS float*)(lds + RTAB_OFF), S1, ssqV}; { FRESH_TID(tidg) pg8::gemm_phase<EpiSguIn, true>(lds, tidg, g, SO, E); }
            }
        } else if (s == 8) {
            { pg8::Gemm g{hb2, wl + L_PLEG, MTOK, DM, DM, DM}; SO.init(MTOK, DM, G, bid); fill_rtab(lds, SO, ssqY, tid); EpiPleGate E{(const LAS float*)(lds + RTAB_OFF), hb2, hb, ssqX, a.b_ple_gate + L * DM, pp}; { FRESH_TID(tidg) pg8::gemm_phase<EpiPleGate, true>(lds, tidg, g, SO, E); } }
            if (L < 3) {
                const f32x4* ps = (const f32x4*)(a.p + (size_t)(L + 1) * MTOK * PLE);
                FRESH_TID(tid3)
#pragma unroll 1
                for (long i = (long)bid * 512 + tid3; i < (long)MTOK * PLE / 4; i += NGT) { const f32x4 v = ps[i]; u32x2 w; w.x = cvtpk(v[0], v[1]); w.y = cvtpk(v[2], v[3]); ((u32x2*)pbf)[i] = w; }
            }
        } else if ((s == 4 && L == 0) || (s == 3 && (L == 1 || L == 2))) {
            const int total = L == 1 ? 6144 : 2048;
#pragma unroll 1
            for (int n = bid; n < total; n += G) {
                AttnJob J; bf16_t* dumO = nullptr; (void)dumO;
                if (L == 0) {
                    const int v = n & 255, i = n >> 8, bh = v >> 1, s2 = (v & 1) * 4 + (i >> 1), qb = (i & 1) ? 15 - s2 : s2, b = bh >> 4, hh = bh & 15;
                    bf16_t* base = S1 + (size_t)b * SEQ * 3072 + hh * 64;
                    J = AttnJob{base, base + 1024, base + 2048, base, 3072, 3072, flog + (size_t)b * SEQ * 16 + hh, 16, nullptr, 0, qb * 256, 1 << 20};
                } else if (L == 1) {
                    const int gi = n / 2048, idx = n % 2048, bh = idx & 127, sub = idx >> 7, b = bh >> 4, hh = bh & 15;
                    const int d = gi == 0 ? 1 : gi == 1 ? 4 : 16; const int res = sub % d, ub = sub / d;
                    bf16_t* base = S1 + ((size_t)b * SEQ + res) * 5120 + hh * 64; dumO = hb + ((size_t)b * SEQ + res) * 1024 + hh * 64;
                    J = AttnJob{base + gi * 1024, base + 3072, base + 4096, base + gi * 1024, (long)5120 * d, (long)5120 * d, nullptr, 0,
                                lseb + (size_t)gi * MTOK * 16 + ((size_t)b * SEQ + res) * 16 + hh, 16 * d, ub * 256, 128};
                } else {
                    const int v = n & 255, i = n >> 8, bm = v >> 1, s2 = (v & 1) * 4 + (i >> 1), qb = (i & 1) ? 15 - s2 : s2, b = bm >> 4, mm = bm & 15;
                    bf16_t* base = S1 + (size_t)b * SEQ * 3072; bf16_t* OM = S1 + (size_t)MTOK * 3072;
                    J = AttnJob{base + mm * 64, base + 1024 + mm * 64, base + 2048 + (mm >> 1) * 128, OM + (size_t)b * SEQ * 2048 + mm * 128, 3072, 2048, nullptr, 0, nullptr, 0, qb * 256, 1 << 20};
                }
#pragma unroll 1
                for (int rep = ((PROBE_REP == 3 && L != 1) || (PROBE_REP == 10 && L == 1)) ? 0 : 1; rep < 2; ++rep) {
                    AttnJob J2 = J;
                    if (PROBE_REP == 10 && rep == 0) { J2.O = dumO; J2.opitch = J.pitch / 5; J2.lse = nullptr; }
                    if (rep == 0 && L == 0) { const size_t off = (size_t)(J.Q - S1); J2.O = S1 + (size_t)96 * MiB + (off / ((size_t)SEQ * 3072)) * SEQ * 1024 + (off % 3072); J2.opitch = 1024; }
                    if (L == 2) attn_unit<4, false>(lds, tid, J2); else if (L == 0) attn_unit<2, true>(lds, tid, J2); else attn_unit<2, false>(lds, tid, J2);
                }
            }
        } else if (s == 3 && L == 0) {
#pragma unroll 1
            for (int sq = bid; sq < 128; sq += G) {
                const int b = sq >> 4, hh = sq & 15; float* fp = flog + ((size_t)b * SEQ + tid * 8) * 16 + hh; float v[8];
#pragma unroll
                for (int i = 0; i < 8; ++i) v[i] = fp[i * 16];
#pragma unroll
                for (int i = 1; i < 8; ++i) v[i] += v[i - 1];
                float incl = v[7];
#pragma unroll
                for (int o = 1; o < 64; o <<= 1) { const float nb = __int_as_float(__builtin_amdgcn_ds_bpermute(((lane - o) & 63) << 2, __float_as_int(incl))); if (lane >= o) incl += nb; }
                LAS float* sc = (LAS float*)lds; if (lane == 63) sc[wave] = incl; __syncthreads();
                float pre = incl - v[7];
                for (int w = 0; w < wave; ++w) pre += sc[w];
#pragma unroll
                for (int i = 0; i < 8; ++i) fp[i * 16] = (v[i] + pre) * LOG2E;
                __syncthreads();
            }
        } else if (s == 4 && L == 1) {
#pragma unroll 4
            for (long it = gt; it < (long)MTOK * 128; it += NGT) {
                const long row = it >> 7; const int hh = (int)(it >> 3) & 15, ch = (int)it & 7;
                const float l0 = lseb[row * 16 + hh], l1 = lseb[(size_t)MTOK * 16 + row * 16 + hh], l2 = lseb[(size_t)2 * MTOK * 16 + row * 16 + hh];
                const float mx = fmaxf(l0, fmaxf(l1, l2)); float w0 = expf(l0 - mx), w1 = expf(l1 - mx), w2 = expf(l2 - mx); const float inv = 1.0f / (w0 + w1 + w2); w0 *= inv; w1 *= inv; w2 *= inv;
                bf16_t* p0 = S1 + row * 5120 + hh * 64 + ch * 8;
                const u32x4 a0 = *(const u32x4*)p0, a1 = *(const u32x4*)(p0 + 1024), a2 = *(const u32x4*)(p0 + 2048); u32x4 o;
#pragma unroll
                for (int k = 0; k < 4; ++k) o[k] = cvtpk(w0 * bf_lo(a0[k]) + w1 * bf_lo(a1[k]) + w2 * bf_lo(a2[k]), w0 * bf_hi(a0[k]) + w1 * bf_hi(a1[k]) + w2 * bf_hi(a2[k]));
                *(u32x4*)p0 = o;
            }
        } else if (s == 4 && L == 2) {
            const float lam = misc[0]; const bf16_t* OM = S1 + (size_t)MTOK * 3072;
#pragma unroll 4
            for (long it = gt; it < (long)MTOK * 128; it += NGT) {
                const long row = it >> 7; const int hh = (int)(it >> 4) & 7, c16 = (int)it & 15;
                const bf16_t* p1 = OM + row * 2048 + (2 * hh) * 128 + c16 * 8;
                const u32x4 a1 = *(const u32x4*)p1, a2 = *(const u32x4*)(p1 + 128); float o[8]; float ss = 0.f;
#pragma unroll
                for (int k = 0; k < 4; ++k) { o[2 * k] = bf_lo(a1[k]) - lam * bf_lo(a2[k]); o[2 * k + 1] = bf_hi(a1[k]) - lam * bf_hi(a2[k]); ss += o[2 * k] * o[2 * k] + o[2 * k + 1] * o[2 * k + 1]; }
                ss += sx(ss, 1, lane); ss += sx(ss, 2, lane); ss += sx(ss, 4, lane); ss += sx(ss, 8, lane);
                const float r = (1.0f - LAM_INIT) / sqrtf(ss * (1.0f / 128.0f) + 1e-5f);
                const f32x4 g0 = *(const f32x4*)(a.diff_subln + c16 * 8), g1 = *(const f32x4*)(a.diff_subln + c16 * 8 + 4);
                u32x4 w; w.x = cvtpk(o[0] * r * g0[0], o[1] * r * g0[1]); w.y = cvtpk(o[2] * r * g0[2], o[3] * r * g0[3]); w.z = cvtpk(o[4] * r * g1[0], o[5] * r * g1[1]); w.w = cvtpk(o[6] * r * g1[2], o[7] * r * g1[3]);
                *(u32x4*)(S1 + row * 3072 + hh * 128 + c16 * 8) = w;
            }
        } else if (s == 3 && L == 3) {
#pragma unroll 1
            for (int n = bid; n < 2048; n += G) {
                const int chunk = n >> 3, gg = n & 7; const size_t row0 = (size_t)chunk * 128;
                LAS float* rsv = (LAS float*)(lds + 65536);
                if (tid < 128) { const f32x4* sp = (const f32x4*)(ssqV + (row0 + tid) * 32); float sm = 0.f;
#pragma unroll
                    for (int j = 0; j < 8; ++j) { const f32x4 v = sp[j]; sm += (v[0] + v[1]) + (v[2] + v[3]); }
                    rsv[tid] = 1.0f / sqrtf(sm * (1.0f / 2048.0f) + NORM_EPS); }
                __syncthreads();
                u32x4 vin[8];
#pragma unroll
                for (int k = 0; k < 8; ++k) { const int item = tid + 512 * k, sr = item >> 5, ch = item & 31; vin[k] = *(const u32x4*)(S1 + (row0 + sr) * 4096 + 2048 + gg * 256 + ch * 8); }
#pragma unroll
                for (int k = 0; k < 8; ++k) {
                    const int item = tid + 512 * k, sr = item >> 5, ch = item & 31;
                    const u32x4 vv = vin[k];
                    const f32x4 n0 = *(const f32x4*)(a.sgu_norm_v + gg * 256 + ch * 8), n1 = *(const f32x4*)(a.sgu_norm_v + gg * 256 + ch * 8 + 4); const float r = rsv[sr];
                    u32x4 w; w.x = cvtpk(bf_lo(vv.x) * r * n0[0], bf_hi(vv.x) * r * n0[1]); w.y = cvtpk(bf_lo(vv.y) * r * n0[2], bf_hi(vv.y) * r * n0[3]);
                    w.z = cvtpk(bf_lo(vv.z) * r * n1[0], bf_hi(vv.z) * r * n1[1]); w.w = cvtpk(bf_lo(vv.w) * r * n1[2], bf_hi(vv.w) * r * n1[3]);
                    *(LAS u32x4*)(lds + (sr >> 2) * 2048 + (ch >> 2) * 256 + (sr & 3) * 64 + (ch & 3) * 16) = w;
                }
                __syncthreads();
                {
                    const int r32 = lane & 31, hi = lane >> 5, tb = wave & 3, chalf = wave >> 2, g16 = (lane >> 4) & 1, i16 = lane & 15;
                    const int trow = 32 * tb + r32; const float* wrow = a.sgu_w_s + ((size_t)gg * 128 + trow) * 128;
                    f32x16 acc[4] = {};
                    const int vrd = (2 * hi) * 2048 + (i16 >> 2) * 64 + g16 * 32 + (i16 & 3) * 8;
                    f32x4 wl0[8], wl1[8];
#pragma unroll
                    for (int ks = 0; ks < 8; ++ks) { wl0[ks] = (f32x4){0.f, 0.f, 0.f, 0.f}; wl1[ks] = wl0[ks]; if (ks <= 2 * tb + 1) { const int s0 = 16 * ks + 8 * hi; wl0[ks] = *(const f32x4*)(wrow + s0); wl1[ks] = *(const f32x4*)(wrow + s0 + 4); } }
#pragma unroll
                    for (int ks = 0; ks < 8; ++ks) if (ks <= 2 * tb + 1) {
                        const int s0 = 16 * ks + 8 * hi; const f32x4 w0 = wl0[ks], w1 = wl1[ks]; float wv[8];
#pragma unroll
                        for (int j = 0; j < 4; ++j) { wv[j] = (s0 + j <= trow) ? w0[j] : 0.f; wv[4 + j] = (s0 + 4 + j <= trow) ? w1[j] : 0.f; }
                        u32x4 pw; pw.x = cvtpk(wv[0], wv[1]); pw.y = cvtpk(wv[2], wv[3]); pw.z = cvtpk(wv[4], wv[5]); pw.w = cvtpk(wv[6], wv[7]);
                        const bf16x8 pa = __builtin_bit_cast(bf16x8, pw);
#pragma unroll
                        for (int cbl = 0; cbl < 4; ++cbl) {
                            const LAS unsigned char* vp = lds + vrd + ks * 8192 + (chalf * 4 + cbl) * 256;
                            const s16x4 lo = __builtin_bit_cast(s16x4, __builtin_amdgcn_ds_read_tr16_b64_v4i16((LAS s16x4*)vp));
                            const s16x4 hh = __builtin_bit_cast(s16x4, __builtin_amdgcn_ds_read_tr16_b64_v4i16((LAS s16x4*)(vp + 2048)));
                            const bf16x8 vf = (bf16x8){lo[0], lo[1], lo[2], lo[3], hh[0], hh[1], hh[2], hh[3]};
                            acc[cbl] = __builtin_amdgcn_mfma_f32_32x32x16_bf16(pa, vf, acc[cbl], 0, 0, 0);
                        }
                    }
                    __syncthreads();
#pragma unroll
                    for (int cbl = 0; cbl < 4; ++cbl)
#pragma unroll
                        for (int r = 0; r < 16; ++r) {
                            const int t = 32 * tb + crow(r, hi);
                            *(LAS bf16_t*)(lds + t * 528 + ((chalf * 4 + cbl) * 32 + r32) * 2) = (bf16_t)(cvtpk(acc[cbl][r] + a.sgu_b_s[gg * 128 + t], 0.f) & 0xffffu);
                        }
                }
                __syncthreads();
                u32x4 uin[8];
#pragma unroll
                for (int k = 0; k < 8; ++k) { const int item = tid + 512 * k, t = item >> 5, ch = item & 31; uin[k] = *(const u32x4*)(S1 + (row0 + t) * 4096 + gg * 256 + ch * 8); }
#pragma unroll
                for (int k = 0; k < 8; ++k) {
                    const int item = tid + 512 * k, t = item >> 5, ch = item & 31;
                    bf16_t* up = S1 + (row0 + t) * 4096 + gg * 256 + ch * 8;
                    const u32x4 uv = uin[k]; const u32x4 mv = *(const LAS u32x4*)(lds + t * 528 + ch * 16); u32x4 w;
#pragma unroll
                    for (int j = 0; j < 4; ++j) w[j] = cvtpk(bf_lo(uv[j]) * bf_lo(mv[j]), bf_hi(uv[j]) * bf_hi(mv[j]));
                    *(u32x4*)up = w;
                }
                __syncthreads();
            }
        }
#if PROBE_REP == 12
        { FRESH_TID(tid2) grid_bar((unsigned*)(ws + WS_BAR), (unsigned)G, tid2, 2u * (unsigned)qq + 1u); grid_bar((unsigned*)(ws + WS_BAR), (unsigned)G, tid2, 2u * (unsigned)qq + 2u); }
#else
        { FRESH_TID(tid2) grid_bar((unsigned*)(ws + WS_BAR), lds, (unsigned)G, tid2); }
#endif
#if TSEL
        { const bool sel_ = (TSEL == 1) ? (L == 1 && s == 3) : (TSEL == 2) ? (L == 3 && s == 3) : (TSEL == 3) ? ((L == 1 && s == 4) || (L == 2 && s == 4) || (L == 0 && s == 3)) : (TSEL == 4) ? (L == 0 && s == 4) : (TSEL == 5) ? (L == 2 && s == 3) : (TSEL == 6) ? (s == 7) : (TSEL == 7) ? (s == 0 || s == 6) : (TSEL == 8) ? (s == 1) : (TSEL == 9) ? (s == 2) : (TSEL == 10) ? (s == 5) : (TSEL == 11) ? (s == 8) : false;
          if (sel_ && blockIdx.x == 0 && threadIdx.x == 0) { const unsigned long long tk1_ = __builtin_amdgcn_s_memrealtime(); misc[8] += (float)(tk1_ - tk0_) * 0.01f; } }
#endif
    }
    PHASE_VARS
#if TSEL == 13
    if (blockIdx.x == 0 && threadIdx.x == 0) { misc[8] = (float)(__builtin_amdgcn_s_memrealtime() - *(unsigned long long*)(misc + 10)) * 0.01f; } __syncthreads();
#endif
#pragma unroll 1
    for (int m0 = gw; m0 < MTOK; m0 += 4 * NGW) {
        float sm[4]; u32x2 v[4][4];
#pragma unroll
        for (int q = 0; q < 4; ++q) { const int m = m0 + q * NGW; sm[q] = lane < 16 ? ssqX[(size_t)m * 16 + lane] : 0.f;
#pragma unroll
            for (int j = 0; j < 4; ++j) v[q][j] = ((const u32x2*)(hb + (size_t)m * DM) + lane)[64 * j]; }
        f32x4 gg[4];
#pragma unroll
        for (int j = 0; j < 4; ++j) gg[j] = ((const f32x4*)a.norm_final + lane)[64 * j];
#pragma unroll
        for (int q = 0; q < 4; ++q) { const int m = m0 + q * NGW; const float r = 1.0f / sqrtf(wave_sum(sm[q], lane) * (1.0f / DM) + NORM_EPS);
#pragma unroll
            for (int j = 0; j < 4; ++j) { const f32x4 hv = {h_lo(v[q][j].x), h_hi(v[q][j].x), h_lo(v[q][j].y), h_hi(v[q][j].y)}; const f32x4 ov = hv * r * gg[j];
                ((f32x4*)(h + (size_t)m * DM) + lane)[64 * j] = ov; } }
    }
#if TSEL == 15
    if (blockIdx.x == 0 && wave0 == 0) { asm volatile("s_waitcnt vmcnt(0)" ::: "memory");
        const float us = (float)(__builtin_amdgcn_s_memrealtime() - *(unsigned long long*)(misc + 10)) * 0.01f; const int nn = (int)us;
        for (int e = lane; e < nn; e += 64) h[(size_t)(e >> 10) * 2048 * DM + (e & 1023)] += 0.0625f; }
#endif
}

extern "C" void kernel_launch(void* const* d_in, const int* in_sizes, int n_in, void* d_out, int out_size, void* d_ws, size_t ws_size, hipStream_t stream) {
    static int grid = 0;
    if (grid == 0) {
        int dev = 0, cus = 0, per_cu = 0;
        hipGetDevice(&dev);
        hipDeviceGetAttribute(&cus, hipDeviceAttributeMultiprocessorCount, dev);
        hipFuncSetAttribute((const void*)mega, hipFuncAttributeMaxDynamicSharedMemorySize, LDS_BYTES);
        hipOccupancyMaxActiveBlocksPerMultiprocessor(&per_cu, (const void*)mega, 512, LDS_BYTES);
        if (per_cu < 1) per_cu = 1;
        grid = cus * per_cu;
        if (ws_size < WS_END) fprintf(stderr, "kernel_launch: workspace too small: %zu < %zu\n", ws_size, (size_t)WS_END);
    }
    hipMemsetAsync((unsigned char*)d_ws + WS_BAR, 0, 16384, stream);
    Args a{};
    const float** pa = (const float**)&a;
    for (int i = 0; i < 28; ++i) pa[i] = (const float*)d_in[i];
    a.out = (float*)d_out; a.ws = (unsigned char*)d_ws;
    void* args[] = {&a};
    hipError_t e = hipLaunchCooperativeKernel((const void*)mega, dim3(grid), dim3(512), args, LDS_BYTES, stream);
    if (e != hipSuccess) fprintf(stderr, "cooperative launch failed: %s (grid %d)\n", hipGetErrorString(e), grid);
}
```

```cpp
#include <hip/hip_runtime.h>
#include <hip/hip_cooperative_groups.h>
#include <cstdint>
#include <cstdio>
namespace cg = cooperative_groups;

#define LAS __attribute__((address_space(3)))
typedef unsigned short bf16_t;
typedef short bf16x8 __attribute__((ext_vector_type(8)));
typedef short s16x4 __attribute__((ext_vector_type(4)));
typedef float f32x4 __attribute__((ext_vector_type(4)));
typedef float f32x2 __attribute__((ext_vector_type(2)));
typedef float f32x16 __attribute__((ext_vector_type(16)));
typedef unsigned u32x4 __attribute__((ext_vector_type(4)));
typedef unsigned u32x2 __attribute__((ext_vector_type(2)));
typedef __bf16 bf16x2_t __attribute__((ext_vector_type(2)));
typedef __attribute__((address_space(1))) unsigned char gbyte_t;

constexpr int MTOK = 32768, SEQ = 4096, DM = 1024, DFF = 2816, PLE = 256;
constexpr float NORM_EPS = 1e-6f;
constexpr float LOG2E = 1.4426950408889634f, LN2 = 0.6931471805599453f;
constexpr float QSCALE = 0.125f * LOG2E;
constexpr float LAM_INIT = 0.47071301834358414f;

constexpr size_t MiB = 1u << 20;
constexpr size_t WS_SSQX = 0, WS_SSQY = 2 * MiB, WS_SSQV = 4 * MiB, WS_LSE = 8 * MiB, WS_FLOG = 14 * MiB, WS_ROPE = 16 * MiB, WS_MISC = 16 * MiB + 512 * 1024, WS_BAR = 16 * MiB + 768 * 1024;
constexpr size_t WS_PBF = 17 * MiB, WS_HB = 33 * MiB, WS_W = 97 * MiB, WS_S1 = 280 * MiB, WS_END = 600 * MiB;
constexpr size_t L_FFN1IN = 0, L_FFN1OUT = 5767168, L_FFN2IN = 8650752, L_FFN2OUT = 14417920, L_PLEG = 17301504, L_PLEP = 18350080, L_SIZE = 18612224;
constexpr size_t W_FOXIN = 4 * L_SIZE, W_FOXOUT = W_FOXIN + 3407872, W_DILIN = W_FOXOUT + 1048576, W_DILOUT = W_DILIN + 5242880, W_DIFFIN = W_DILOUT + 1048576,
                 W_DIFFOUT = W_DIFFIN + 3145728, W_SGUIN = W_DIFFOUT + 1048576, W_SGUOUT = W_SGUIN + 4194304, W_TOTAL = W_SGUOUT + 2097152;
static_assert(WS_W + W_TOTAL * 2 <= WS_S1, "weights fit");

#ifndef PROBE_REP
#define PROBE_REP 0
#endif
#ifndef TSEL
#define TSEL 0
#endif
constexpr unsigned BARMUL = (PROBE_REP == 9) ? 2u : 1u;
constexpr int NSLOTS = (PROBE_REP == 1) ? 11 : (PROBE_REP == 7 || PROBE_REP == 8) ? 10 : 9;
constexpr int LDS_BYTES = 147456;
constexpr int RTAB_OFF = 131072;

__device__ __forceinline__ unsigned cvtpk(float lo, float hi) { f32x2 v = {lo, hi}; bf16x2_t b = __builtin_convertvector(v, bf16x2_t); return __builtin_bit_cast(unsigned, b); }
typedef _Float16 half8 __attribute__((ext_vector_type(8)));
typedef _Float16 half2_t __attribute__((ext_vector_type(2)));
__device__ __forceinline__ unsigned cvtpk_h(float lo, float hi) { half2_t h = {(_Float16)lo, (_Float16)hi}; return __builtin_bit_cast(unsigned, h); }
__device__ __forceinline__ float h_lo(unsigned w) { return (float)__builtin_bit_cast(half2_t, w)[0]; }
__device__ __forceinline__ float h_hi(unsigned w) { return (float)__builtin_bit_cast(half2_t, w)[1]; }
__device__ __forceinline__ float bf_lo(unsigned w) { return __uint_as_float(w << 16); }
__device__ __forceinline__ float bf_hi(unsigned w) { return __uint_as_float(w & 0xffff0000u); }
__device__ __forceinline__ float sx(float v, int o, int lane) { return __int_as_float(__builtin_amdgcn_ds_bpermute((lane ^ o) << 2, __float_as_int(v))); }
__device__ __forceinline__ float wave_sum(float v, int lane) {
#pragma unroll
    for (int o = 1; o < 64; o <<= 1) v += sx(v, o, lane);
    return v;
}
__device__ __forceinline__ float fast_exp2(float x) { return __builtin_amdgcn_exp2f(x); }
__device__ __forceinline__ float fast_rcp(float x) { return __builtin_amdgcn_rcpf(x); }
__device__ __forceinline__ float sigmoidf_(float x) { return fast_rcp(1.0f + fast_exp2(-x * LOG2E)); }

namespace pg8 {
constexpr int BM = 256, BK = 64, HALF = 128, HTB = HALF * BK * 2, STAGE_BYTES = 8 * HTB, NXCD = 8, WGM = 8;
__host__ __device__ __forceinline__ int lds_byte(int r, int c) { const int st = (r >> 4) * 2 + (c >> 5), rr = r & 15, cc = c & 31, ob = rr * 64 + cc * 2; return st * 1024 + (ob ^ (((ob >> 9) & 1) << 5)); }
__host__ __device__ __forceinline__ void stage_rc(int b, int& R, int& C) { const int st = b / 1024, sb = b % 1024, swz = sb ^ (((sb >> 9) & 1) << 5); R = (st >> 1) * 16 + swz / 64; C = (st & 1) * 32 + (swz % 64) / 2; }
__host__ __device__ __forceinline__ int perm32(int rho) { const int n = rho >> 4, i = rho & 15; return 8 * (i >> 2) + 4 * n + (i & 3); }
struct Unit { int pm, pn, ui; };
struct Gemm { const bf16_t* A; const bf16_t* Bt; int M, N, K, lda; };
struct StaticOrder {
    int nM, nN, nwg, G, c;
    __device__ void init(int M, int N, int G_, int c_) { nM = M / BM; nN = N / BM; nwg = nM * nN; G = G_; c = c_; }
    __device__ bool next(int i, Unit& u) const {
        const long L = (long)i * G + c; if (L >= nwg) return false;
        int wgid = (int)L; { const int q = nwg / NXCD, r = nwg % NXCD, xcd = wgid % NXCD, off = wgid / NXCD; wgid = (xcd < r ? xcd * (q + 1) : r * (q + 1) + (xcd - r) * q) + off; }
        const int nig = WGM * nN, gid = wgid / nig, fm = gid * WGM, gsz = (nM - fm) < WGM ? (nM - fm) : WGM;
        u.pm = fm + ((wgid % nig) % gsz); u.pn = (wgid % nig) / gsz; u.ui = i; return true;
    }
};
template <class Epi, bool F16 = false>
__device__ __forceinline__ void gemm_phase(LAS unsigned char* lds, const int tid, const Gemm g, const StaticOrder& S, const Epi& E) {
    const int wid = __builtin_amdgcn_readfirstlane(tid >> 6), lane = tid & 63, wr = wid >> 2, wc = wid & 3, fr = lane & 15, fq = lane >> 4;
    const int K = g.K, nt = K / BK, lda = g.lda;
    unsigned voffA[2], voffB[2];
#pragma unroll
    for (int i = 0; i < 2; ++i) { int R, C; stage_rc(tid * 16 + i * 8192, R, C); const int Rb = Epi::PERM ? ((R & ~31) + perm32(R & 31)) : R;
        voffA[i] = (unsigned)(R * lda + C) * 2u; voffB[i] = (unsigned)(Rb * K + C) * 2u; }
    const size_t kstep = (size_t)(BK * 2);
    const size_t hstepA = (size_t)HALF * lda * 2, hstepB = (size_t)HALF * K * 2;
    const size_t tstepA = 2 * hstepA, tstepB = 2 * hstepB;
    const unsigned ldsw = (unsigned)wid * 1024u;
    const int aoff = lds_byte(wr * 64 + fr, fq * 8), boff = lds_byte(wc * 32 + fr, fq * 8);
#define PG8_SA(b, h) (((b) * 2 + (h)) * HTB)
#define PG8_SB(b, h) ((4 + (b) * 2 + (h)) * HTB)
#define PG8_STAGE(bufoff, gbase, voff) do { _Pragma("unroll") for (int _i = 0; _i < 2; ++_i) \
        __builtin_amdgcn_global_load_lds((const unsigned*)((const char*)(gbase) + (voff)[_i]), (LAS unsigned*)(lds + (bufoff) + ldsw + _i * 8192), 16, 0, 0); } while (0)
#define PG8_LDA(dst, b, h) do { _Pragma("unroll") for (int m = 0; m < 4; ++m) _Pragma("unroll") for (int k = 0; k < 2; ++k) dst[m][k] = *(const LAS bf16x8*)(lds + PG8_SA(b, h) + aoff + m * 2048 + k * 1024); } while (0)
#define PG8_LDB(dst, b, h) do { _Pragma("unroll") for (int n = 0; n < 2; ++n) _Pragma("unroll") for (int k = 0; k < 2; ++k) dst[n][k] = *(const LAS bf16x8*)(lds + PG8_SB(b, h) + boff + n * 2048 + k * 1024); } while (0)
#define PG8_MMA(ai, bj, At, Bt) do { __builtin_amdgcn_s_setprio(1); _Pragma("unroll") for (int m = 0; m < 4; ++m) _Pragma("unroll") for (int n = 0; n < 2; ++n) _Pragma("unroll") for (int k = 0; k < 2; ++k) \
        acc[ai][bj][m][n] = F16 ? __builtin_amdgcn_mfma_f32_16x16x32_f16(__builtin_bit_cast(half8, Bt[n][k]), __builtin_bit_cast(half8, At[m][k]), acc[ai][bj][m][n], 0, 0, 0) \
                                : __builtin_amdgcn_mfma_f32_16x16x32_bf16(Bt[n][k], At[m][k], acc[ai][bj][m][n], 0, 0, 0); __builtin_amdgcn_s_setprio(0); } while (0)
#define PG8_WAIT_V(n) asm volatile("s_waitcnt vmcnt(" #n ")" ::: "memory")
#define PG8_WAIT_L(n) asm volatile("s_waitcnt lgkmcnt(" #n ")" ::: "memory")
#define PG8_BAR __builtin_amdgcn_s_barrier()
#define PG8_SCHED __builtin_amdgcn_sched_barrier(0)
    Unit cur, nxt; int ui = 0;
    if (!S.next(0, cur)) return;
    f32x4 acc[2][2][4][2];
#pragma unroll
    for (int a = 0; a < 2; ++a)
#pragma unroll
        for (int b = 0; b < 2; ++b)
#pragma unroll
            for (int m = 0; m < 4; ++m)
#pragma unroll
                for (int n = 0; n < 2; ++n) acc[a][b][m][n] = (f32x4){0.f, 0.f, 0.f, 0.f};
    bf16x8 At[4][2], B0[2][2], B1[2][2];
    const char* cA = (const char*)g.A + (size_t)cur.pm * tstepA; const char* cB = (const char*)g.Bt + (size_t)cur.pn * tstepB;
    PG8_STAGE(PG8_SB(0, 0), cB, voffB); PG8_STAGE(PG8_SB(0, 1), cB + hstepB, voffB); PG8_STAGE(PG8_SA(0, 0), cA, voffA); PG8_STAGE(PG8_SA(0, 1), cA + hstepA, voffA);
    if (wr == 1) PG8_BAR;
    PG8_WAIT_V(2); PG8_BAR;
    PG8_STAGE(PG8_SB(1, 0), cB + kstep, voffB); PG8_STAGE(PG8_SA(1, 0), cA + kstep, voffA); PG8_STAGE(PG8_SB(1, 1), cB + hstepB + kstep, voffB);
    PG8_WAIT_V(6); PG8_BAR;
    for (;;) {
        const bool has_next = S.next(ui + 1, nxt);
        const char* nA = has_next ? (const char*)g.A + (size_t)nxt.pm * tstepA : cA; const char* nB = has_next ? (const char*)g.Bt + (size_t)nxt.pn * tstepB : cB;
        for (int t = 0; t < nt; t += 2) {
            const bool last = (t == nt - 2);
            const char* a1 = cA + (size_t)(t + 1) * kstep;
            const char* a2 = last ? nA : cA + (size_t)(t + 2) * kstep; const char* b2 = last ? nB : cB + (size_t)(t + 2) * kstep;
            const char* a3 = a2 + kstep; const char* b3 = b2 + kstep;
            PG8_LDB(B0, 0, 0); PG8_LDB(B1, 0, 1); PG8_SCHED; PG8_LDA(At, 0, 0); PG8_STAGE(PG8_SA(1, 1), a1 + hstepA, voffA);
            PG8_WAIT_V(8); PG8_WAIT_L(0); PG8_BAR; PG8_MMA(0, 0, At, B0); PG8_MMA(0, 1, At, B1); PG8_BAR; PG8_SCHED;
            PG8_LDA(At, 0, 1); PG8_STAGE(PG8_SB(0, 0), b2, voffB); PG8_STAGE(PG8_SB(0, 1), b2 + hstepB, voffB); PG8_STAGE(PG8_SA(0, 0), a2, voffA);
            PG8_WAIT_V(8); PG8_WAIT_L(0); PG8_BAR; PG8_MMA(1, 0, At, B0); PG8_MMA(1, 1, At, B1); PG8_BAR; PG8_SCHED;
            PG8_LDB(B0, 1, 0); PG8_LDB(B1, 1, 1); PG8_SCHED; PG8_LDA(At, 1, 0); PG8_STAGE(PG8_SA(0, 1), a2 + hstepA, voffA);
            PG8_WAIT_V(8); PG8_WAIT_L(0); PG8_BAR; PG8_MMA(0, 0, At, B0); PG8_MMA(0, 1, At, B1); PG8_BAR; PG8_SCHED;
            PG8_LDA(At, 1, 1); PG8_STAGE(PG8_SB(1, 0), b3, voffB); PG8_STAGE(PG8_SB(1, 1), b3 + hstepB, voffB); PG8_STAGE(PG8_SA(1, 0), a3, voffA);
            PG8_WAIT_V(8); PG8_WAIT_L(0); PG8_BAR; PG8_MMA(1, 0, At, B0); PG8_MMA(1, 1, At, B1); PG8_BAR; PG8_SCHED;
        }
        if (wr == 0) PG8_BAR;
        E(acc, cur, wr, wc, fr, fq);
        if (!has_next) break;
#pragma unroll
        for (int a = 0; a < 2; ++a)
#pragma unroll
            for (int b = 0; b < 2; ++b)
#pragma unroll
                for (int m = 0; m < 4; ++m)
#pragma unroll
                    for (int n = 0; n < 2; ++n) acc[a][b][m][n] = (f32x4){0.f, 0.f, 0.f, 0.f};
        cur = nxt; cA = nA; cB = nB; ++ui;
        if (wr == 1) PG8_BAR;
    }
    PG8_WAIT_V(0);
    PG8_BAR;
#undef PG8_SA
#undef PG8_SB
#undef PG8_STAGE
#undef PG8_LDA
#undef PG8_LDB
#undef PG8_MMA
#undef PG8_WAIT_V
#undef PG8_WAIT_L
#undef PG8_BAR
#undef PG8_SCHED
}
}
using pg8::Unit;

__device__ __forceinline__ void row_rstd8(const float* ssq, int row0, int fq, int lane, float (&rs)[8]) {
#pragma unroll
    for (int ai = 0; ai < 2; ++ai)
#pragma unroll
        for (int m = 0; m < 4; ++m) {
            const f32x4 v = *(const f32x4*)(ssq + (size_t)(row0 + 128 * ai + 16 * m) * 16 + 4 * fq);
            float s = (v[0] + v[1]) + (v[2] + v[3]); s += sx(s, 16, lane); s += sx(s, 32, lane);
            rs[ai * 4 + m] = 1.0f / sqrtf(s * (1.0f / DM) + NORM_EPS);
        }
}
__device__ __forceinline__ void row_rstd8_lds(const LAS float* rtab, int ui, int lrow0, float (&rs)[8]) {
#pragma unroll
    for (int ai = 0; ai < 2; ++ai)
#pragma unroll
        for (int m = 0; m < 4; ++m) rs[ai * 4 + m] = rtab[ui * 256 + lrow0 + 128 * ai + 16 * m];
}
__device__ __forceinline__ float gelu_erf(float v) {
    const float av = fabsf(v), t = fast_rcp(av * 0.2316418882f + 1.0f);
    float q = t * 0.5307027145f + (-0.7265760135f); q = q * t + 0.7107068705f; q = q * t + (-0.142248368f); q = q * t + 0.127414796f; q = q * t;
    const float e = fast_exp2((v * v) * (-0.72134752044f));
    const float m = v * (q * e);
    return v < 0.f ? m : v - m;
}

struct EpiSwiglu {
    static constexpr bool PERM = true;
    const LAS float* rtab; bf16_t* H;
    __device__ __forceinline__ void operator()(const f32x4 (&acc)[2][2][4][2], const Unit& u, int wr, int wc, int fr_, int fq_) const {
        (void)fr_; (void)fq_; unsigned o_ = ~0u; asm volatile("" : "+s"(o_)); const int lane = (int)__builtin_amdgcn_mbcnt_hi(o_, __builtin_amdgcn_mbcnt_lo(o_, 0u)); const int fr = lane & 15, fq = lane >> 4;
        const int row0 = u.pm * 256 + wr * 64 + fr, col0 = u.pn * 128 + wc * 32 + 8 * fq;
        float rs[8]; row_rstd8_lds(rtab, u.ui, wr * 64 + fr, rs);
#pragma unroll
        for (int ai = 0; ai < 2; ++ai)
#pragma unroll
            for (int m = 0; m < 4; ++m) {
                const float r = rs[ai * 4 + m]; float o[8];
#pragma unroll
                for (int n = 0; n < 2; ++n)
#pragma unroll
                    for (int i = 0; i < 4; ++i) { const float gt = acc[ai][0][m][n][i] * r, up = acc[ai][1][m][n][i] * r; o[n * 4 + i] = gt * sigmoidf_(gt) * up; }
                u32x4 w; w.x = cvtpk(o[0], o[1]); w.y = cvtpk(o[2], o[3]); w.z = cvtpk(o[4], o[5]); w.w = cvtpk(o[6], o[7]);
                *(u32x4*)(H + (size_t)(row0 + 128 * ai + 16 * m) * DFF + col0) = w;
            }
    }
};
struct EpiResid {
    static constexpr bool PERM = true;
    const bf16_t* hin; bf16_t* hout; float* ssq; float scale;
    __device__ __forceinline__ void operator()(const f32x4 (&acc)[2][2][4][2], const Unit& u, int wr, int wc, int fr_, int fq_) const {
        (void)fr_; (void)fq_; unsigned o_ = ~0u; asm volatile("" : "+s"(o_)); const int lane = (int)__builtin_amdgcn_mbcnt_hi(o_, __builtin_amdgcn_mbcnt_lo(o_, 0u)); const int fr = lane & 15, fq = lane >> 4;
        const int row0 = u.pm * 256 + wr * 64 + fr, col0 = u.pn * 256 + wc * 32 + 8 * fq;
#pragma unroll
        for (int ai = 0; ai < 2; ++ai) {
            u32x4 bs[4][2];
#pragma unroll
            for (int m = 0; m < 4; ++m)
#pragma unroll
                for (int bj = 0; bj < 2; ++bj) bs[m][bj] = *(const u32x4*)(hin + (size_t)(row0 + 128 * ai + 16 * m) * DM + col0 + bj * 128);
            asm volatile("" ::: "memory");
#pragma unroll
            for (int m = 0; m < 4; ++m) {
                const int row = row0 + 128 * ai + 16 * m; const size_t off = (size_t)row * DM + col0; float ss = 0.f;
#pragma unroll
                for (int bj = 0; bj < 2; ++bj) {
                    const u32x4 b = bs[m][bj];
                    const f32x4 b0 = {bf_lo(b.x), bf_hi(b.x), bf_lo(b.y), bf_hi(b.y)}, b1 = {bf_lo(b.z), bf_hi(b.z), bf_lo(b.w), bf_hi(b.w)};
                    const f32x4 o0 = b0 + acc[ai][bj][m][0] * scale, o1 = b1 + acc[ai][bj][m][1] * scale;
                    ss += (o0[0] * o0[0] + o0[1] * o0[1]) + (o0[2] * o0[2] + o0[3] * o0[3]) + (o1[0] * o1[0] + o1[1] * o1[1]) + (o1[2] * o1[2] + o1[3] * o1[3]);
                    u32x4 w; w.x = cvtpk(o0[0], o0[1]); w.y = cvtpk(o0[2], o0[3]); w.z = cvtpk(o1[0], o1[1]); w.w = cvtpk(o1[2], o1[3]);
                    *(u32x4*)(hout + off + bj * 128) = w;
                }
                ss += sx(ss, 16, lane); ss += sx(ss, 32, lane);
                if (fq == 0) ssq[(size_t)row * 16 + u.pn * 4 + wc] = ss;
            }
            asm volatile("" ::: "memory");
        }
    }
};
struct EpiPleGate {
    static constexpr bool PERM = false;
    const LAS float* rtab; const bf16_t* hin; bf16_t* hout; float* ssq_out; const float* bg; const bf16_t* pp;
    __device__ __forceinline__ void operator()(const f32x4 (&acc)[2][2][4][2], const Unit& u, int wr, int wc, int fr_, int fq_) const {
        (void)fr_; (void)fq_; unsigned o_ = ~0u; asm volatile("" : "+s"(o_)); const int lane = (int)__builtin_amdgcn_mbcnt_hi(o_, __builtin_amdgcn_mbcnt_lo(o_, 0u)); const int fr = lane & 15, fq = lane >> 4;
        const int row0 = u.pm * 256 + wr * 64 + fr, col0 = u.pn * 256 + wc * 32 + 4 * fq;
        float rs[8]; row_rstd8_lds(rtab, u.ui, wr * 64 + fr, rs);
#pragma unroll
        for (int ai = 0; ai < 2; ++ai)
#pragma unroll
        for (int mp = 0; mp < 2; ++mp) {
            u32x2 bs[2][2][2], pw[2][2][2];
#pragma unroll
            for (int mm = 0; mm < 2; ++mm)
#pragma unroll
                for (int bj = 0; bj < 2; ++bj)
#pragma unroll
                    for (int n = 0; n < 2; ++n) { const size_t o2 = (size_t)(row0 + 128 * ai + 16 * (2 * mp + mm)) * DM + col0 + bj * 128 + n * 16; bs[mm][bj][n] = *(const u32x2*)(hin + o2); pw[mm][bj][n] = *(const u32x2*)(pp + o2); }
            asm volatile("" ::: "memory");
#pragma unroll
            for (int mm = 0; mm < 2; ++mm) {
                const int m = 2 * mp + mm;
                const int row = row0 + 128 * ai + 16 * m; const size_t off = (size_t)row * DM + col0; float ss = 0.f; const float r = rs[ai * 4 + m];
#pragma unroll
                for (int bj = 0; bj < 2; ++bj)
#pragma unroll
                    for (int n = 0; n < 2; ++n) {
                        const size_t o2 = off + bj * 128 + n * 16; const u32x2 b = bs[mm][bj][n]; const u32x2 p2 = pw[mm][bj][n];
                        const f32x4 bbv = *(const f32x4*)(bg + col0 + bj * 128 + n * 16);
                        f32x4 o;
                        o[0] = bf_lo(b.x) + sigmoidf_(acc[ai][bj][m][n][0] * r + bbv[0]) * bf_lo(p2.x);
                        o[1] = bf_hi(b.x) + sigmoidf_(acc[ai][bj][m][n][1] * r + bbv[1]) * bf_hi(p2.x);
                        o[2] = bf_lo(b.y) + sigmoidf_(acc[ai][bj][m][n][2] * r + bbv[2]) * bf_lo(p2.y);
                        o[3] = bf_hi(b.y) + sigmoidf_(acc[ai][bj][m][n][3] * r + bbv[3]) * bf_hi(p2.y);
                        ss += (o[0] * o[0] + o[1] * o[1]) + (o[2] * o[2] + o[3] * o[3]);
                        u32x2 w; w.x = cvtpk(o[0], o[1]); w.y = cvtpk(o[2], o[3]); *(u32x2*)(hout + o2) = w;
                    }
                ss += sx(ss, 16, lane); ss += sx(ss, 32, lane);
                if (fq == 0) ssq_out[(size_t)row * 16 + u.pn * 4 + wc] = ss;
            }
            asm volatile("" ::: "memory");
        }
    }
};
struct EpiBf16 {
    static constexpr bool PERM = true;
    bf16_t* O; int ldo;
    __device__ __forceinline__ void operator()(const f32x4 (&acc)[2][2][4][2], const Unit& u, int wr, int wc, int fr_, int fq_) const {
        (void)fr_; (void)fq_; unsigned o_ = ~0u; asm volatile("" : "+s"(o_)); const int lane = (int)__builtin_amdgcn_mbcnt_hi(o_, __builtin_amdgcn_mbcnt_lo(o_, 0u)); const int fr = lane & 15, fq = lane >> 4;
        const int row0 = u.pm * 256 + wr * 64 + fr, col0 = u.pn * 256 + wc * 32 + 8 * fq;
#pragma unroll
        for (int ai = 0; ai < 2; ++ai)
#pragma unroll
            for (int m = 0; m < 4; ++m)
#pragma unroll
                for (int bj = 0; bj < 2; ++bj) {
                    const f32x4 v0 = acc[ai][bj][m][0], v1 = acc[ai][bj][m][1];
                    u32x4 w; w.x = cvtpk(v0[0], v0[1]); w.y = cvtpk(v0[2], v0[3]); w.z = cvtpk(v1[0], v1[1]); w.w = cvtpk(v1[2], v1[3]);
                    *(u32x4*)(O + (size_t)(row0 + 128 * ai + 16 * m) * ldo + col0 + bj * 128) = w;
                }
    }
};
struct EpiQkv {
    static constexpr bool PERM = true;
    const LAS float* rtab; bf16_t* O; int ldo; int qs_end, rope_end, fg_tile; const f32x2* rope; const float* bf; float* flog;
    __device__ __forceinline__ void operator()(const f32x4 (&acc)[2][2][4][2], const Unit& u, int wr, int wc, int fr_, int fq_) const {
        (void)fr_; (void)fq_; unsigned o_ = ~0u; asm volatile("" : "+s"(o_)); const int lane = (int)__builtin_amdgcn_mbcnt_hi(o_, __builtin_amdgcn_mbcnt_lo(o_, 0u)); const int fr = lane & 15, fq = lane >> 4;
        const int row0 = u.pm * 256 + wr * 64 + fr, colt = u.pn * 256;
        float rs[8]; row_rstd8_lds(rtab, u.ui, wr * 64 + fr, rs);
        if (u.pn == fg_tile) {
            if (wc == 0 && fq < 2) {
                const f32x4 b0 = *(const f32x4*)(bf + 8 * fq), b1 = *(const f32x4*)(bf + 8 * fq + 4);
#pragma unroll
                for (int ai = 0; ai < 2; ++ai)
#pragma unroll
                    for (int m = 0; m < 4; ++m) {
                        const float r = rs[ai * 4 + m]; f32x4 o0, o1;
#pragma unroll
                        for (int i = 0; i < 4; ++i) {
                            const float x0 = acc[ai][0][m][0][i] * r + b0[i], x1 = acc[ai][0][m][1][i] * r + b1[i];
                            o0[i] = fminf(x0, 0.f) - logf(1.0f + expf(-fabsf(x0))); o1[i] = fminf(x1, 0.f) - logf(1.0f + expf(-fabsf(x1)));
                        }
                        float* p = flog + (size_t)(row0 + 128 * ai + 16 * m) * 16 + 8 * fq;
                        *(f32x4*)p = o0; *(f32x4*)(p + 4) = o1;
                    }
            }
            return;
        }
        const float sc = colt < qs_end ? QSCALE : 1.0f;
        const bool do_rope = (colt < rope_end) && ((wc & 1) == 0);
        const float sgn = fq == 0 ? -1.0f : 1.0f;
#pragma unroll
        for (int ai = 0; ai < 2; ++ai) {
            f32x4 csa[4][4] = {};
            if (do_rope) {
#pragma unroll
                for (int m = 0; m < 4; ++m) { const f32x4* tp = (const f32x4*)(rope + (size_t)((row0 + 128 * ai + 16 * m) & (SEQ - 1)) * 8);
#pragma unroll
                    for (int j = 0; j < 4; ++j) csa[m][j] = tp[j]; }
            }
#pragma unroll
            for (int m = 0; m < 4; ++m) {
                const int row = row0 + 128 * ai + 16 * m; const float r = rs[ai * 4 + m] * sc;
#pragma unroll
                for (int bj = 0; bj < 2; ++bj) {
                    f32x4 v0 = acc[ai][bj][m][0] * r, v1 = acc[ai][bj][m][1] * r;
                    if (do_rope) {
                        const f32x4 (&cs)[4] = csa[m];
                        f32x4 p0, p1;
#pragma unroll
                        for (int i = 0; i < 4; ++i) { p0[i] = sx(v0[i], 16, lane); p1[i] = sx(v1[i], 16, lane); }
                        if (fq < 2) {
                            v0[0] = v0[0] * cs[0][0] + sgn * p0[0] * cs[0][1]; v0[1] = v0[1] * cs[0][2] + sgn * p0[1] * cs[0][3];
                            v0[2] = v0[2] * cs[1][0] + sgn * p0[2] * cs[1][1]; v0[3] = v0[3] * cs[1][2] + sgn * p0[3] * cs[1][3];
                            v1[0] = v1[0] * cs[2][0] + sgn * p1[0] * cs[2][1]; v1[1] = v1[1] * cs[2][2] + sgn * p1[1] * cs[2][3];
                            v1[2] = v1[2] * cs[3][0] + sgn * p1[2] * cs[3][1]; v1[3] = v1[3] * cs[3][2] + sgn * p1[3] * cs[3][3];
                        }
                    }
                    u32x4 w; w.x = cvtpk(v0[0], v0[1]); w.y = cvtpk(v0[2], v0[3]); w.z = cvtpk(v1[0], v1[1]); w.w = cvtpk(v1[2], v1[3]);
                    *(u32x4*)(O + (size_t)row * ldo + colt + bj * 128 + wc * 32 + 8 * fq) = w;
                }
            }
        }
    }
};
struct EpiSguIn {
    static constexpr bool PERM = true;
    const LAS float* rtab; bf16_t* O; float* ssqv;
    __device__ __forceinline__ void operator()(const f32x4 (&acc)[2][2][4][2], const Unit& u, int wr, int wc, int fr_, int fq_) const {
        (void)fr_; (void)fq_; unsigned o_ = ~0u; asm volatile("" : "+s"(o_)); const int lane = (int)__builtin_amdgcn_mbcnt_hi(o_, __builtin_amdgcn_mbcnt_lo(o_, 0u)); const int fr = lane & 15, fq = lane >> 4;
        const int row0 = u.pm * 256 + wr * 64 + fr, col0 = u.pn * 256 + wc * 32 + 8 * fq;
        float rs[8]; row_rstd8_lds(rtab, u.ui, wr * 64 + fr, rs);
#pragma unroll
        for (int ai = 0; ai < 2; ++ai)
#pragma unroll
            for (int m = 0; m < 4; ++m) {
                const int row = row0 + 128 * ai + 16 * m; const float r = rs[ai * 4 + m]; float ss = 0.f;
#pragma unroll
                for (int bj = 0; bj < 2; ++bj) {
                    float o[8];
#pragma unroll
                    for (int n = 0; n < 2; ++n)
#pragma unroll
                        for (int i = 0; i < 4; ++i) { const float gv = gelu_erf(acc[ai][bj][m][n][i] * r); o[n * 4 + i] = gv; ss += gv * gv; }
                    u32x4 w; w.x = cvtpk(o[0], o[1]); w.y = cvtpk(o[2], o[3]); w.z = cvtpk(o[4], o[5]); w.w = cvtpk(o[6], o[7]);
                    *(u32x4*)(O + (size_t)row * 4096 + col0 + bj * 128) = w;
                }
                if (u.pn >= 8) { ss += sx(ss, 16, lane); ss += sx(ss, 32, lane); if (fq == 0) ssqv[(size_t)row * 32 + (u.pn - 8) * 4 + wc] = ss; }
            }
    }
};

struct AttnJob {
    const bf16_t* Q; const bf16_t* K; const bf16_t* V; bf16_t* O;
    long pitch, opitch;
    const float* bias; int bstride;
    float* lse; int lstride;
    int q0, window;
};
constexpr int A_K = 0, A_V = 32768, A_B = 98304, A_WS = 114688, A_NB = 4;
__device__ __forceinline__ int crow(int r, int hi) { return (r & 3) + 8 * (r >> 2) + 4 * hi; }
__device__ __forceinline__ float max3f(float a, float b, float c) { float r; asm("v_max3_f32 %0, %1, %2, %3" : "=v"(r) : "v"(a), "v"(b), "v"(c)); return r; }
#define A_WAITV(n) asm volatile("s_waitcnt vmcnt(" #n ")" ::: "memory")
__device__ __forceinline__ void glds16(const void* gsrc, unsigned lds_dst) { unsigned keep;
    asm volatile("s_mov_b32 %0, m0\n\ts_mov_b32 m0, %2\n\ts_nop 0\n\tglobal_load_lds_dwordx4 %1, off\n\ts_mov_b32 m0, %0" : "=&s"(keep) : "v"(gsrc), "s"(lds_dst) : "memory"); }

#ifndef ATT_SGB
#define ATT_SGB 1
#endif
#ifndef ATT_SGB2
#define ATT_SGB2 0
#endif
template <int NDB, bool BIAS>
__device__ __forceinline__ void attn_unit(LAS unsigned char* lds, const int tid, const AttnJob& J) {
    constexpr int VGRP = NDB * 256, VBUF = 16 * VGRP, NVD = NDB / 2;
    const int lane = tid & 63, r32 = lane & 31, hi = lane >> 5; const int wid = __builtin_amdgcn_readfirstlane(tid >> 6);
    const int q0 = J.q0, W = J.window;
    const int t_lo = (q0 - W > 0 ? q0 - W : 0) >> 6, t_hi = (q0 + 255) >> 6, nt = t_hi - t_lo + 1;
    const int qw = q0 + 32 * wid;
    const int tw_lo = (qw - W > 0 ? qw - W : 0) >> 6, tw_hi = (qw + 31) >> 6;
    const int qrow = qw + r32;
    const bf16_t* kg = J.K + (long)(8 * wid + (lane >> 3)) * J.pitch + (((lane & 7) ^ (lane >> 3)) * 8);
    const bf16_t* vg[NVD];
#pragma unroll
    for (int j = 0; j < NVD; ++j) { const int B = (wid + 8 * j) * 1024 + lane * 16; const int kv = 4 * (B / VGRP) + ((B >> 6) & 3), d = 32 * ((B % VGRP) >> 8) + 8 * ((B >> 4) & 3);
        vg[j] = J.V + (long)kv * J.pitch + d; }
    const long tstride = 64 * J.pitch;
    const unsigned lds0 = (unsigned)(uintptr_t)lds;
#define A_DMA(t_) do { const int t__ = (t_); const int bf__ = t__ & 3; \
        glds16(kg + (long)t__ * tstride, (unsigned)__builtin_amdgcn_readfirstlane(lds0 + A_K + bf__ * 8192 + wid * 1024)); \
        _Pragma("unroll") for (int j_ = 0; j_ < NVD; ++j_) \
            glds16(vg[j_] + (long)t__ * tstride, (unsigned)__builtin_amdgcn_readfirstlane(lds0 + A_V + bf__ * VBUF + (wid + 8 * j_) * 1024)); } while (0)
    LAS float* wsf = (LAS float*)(lds + A_WS) + wid * 64;
    A_DMA(t_lo); if (nt > 1) A_DMA(t_lo + 1);
    bf16x8 qr[4];
    { const bf16_t* qp = J.Q + (long)qrow * J.pitch + hi * 8;
#pragma unroll
      for (int d0 = 0; d0 < 4; ++d0) qr[d0] = *(const bf16x8*)(qp + d0 * 16); }
    if (BIAS) { for (int k = t_lo * 64 + tid; k < (t_hi + 1) * 64; k += 512) *(LAS float*)(lds + A_B + (k - t_lo * 64) * 4) = J.bias[(long)k * J.bstride] * (-1.0f / QSCALE); }
    asm volatile("" :: "v"(qr[0]), "v"(qr[1]), "v"(qr[2]), "v"(qr[3]));
    float m_run = -1e30f, l_run = 0.f, alpha_prev = 1.0f; f32x16 o[NDB], pe0 = {}, pe1 = {};
#pragma unroll
    for (int db = 0; db < NDB; ++db) o[db] = (f32x16){};
    const int g16 = (lane >> 4) & 1, i16 = lane & 15;
    const int vrd = A_V + hi * VGRP + (i16 >> 2) * 64 + g16 * 32 + (i16 & 3) * 8;
    const int krd = A_K + r32 * 128;
    const int ksw = r32 & 7;
#define A_RESCALE() do { if (__any(alpha_prev != 1.0f)) { if (hi == 0) wsf[r32] = alpha_prev; \
        _Pragma("unroll") for (int g = 0; g < 4; ++g) { const f32x4 a_ = *(const LAS f32x4*)(wsf + 8 * g + 4 * hi); \
            _Pragma("unroll") for (int db = 0; db < NDB; ++db) _Pragma("unroll") for (int i = 0; i < 4; ++i) o[db][4 * g + i] *= a_[i]; } } } while (0)
#define A_SUMPACK(ls_, pa_) do { f32x2 a2_ = {0.f, 0.f}, b2_ = {0.f, 0.f}; _Pragma("unroll") for (int r = 0; r < 8; ++r) { a2_ += (f32x2){pe0[2 * r], pe0[2 * r + 1]}; b2_ += (f32x2){pe1[2 * r], pe1[2 * r + 1]}; } a2_ += b2_; ls_ = a2_[0] + a2_[1]; \
        _Pragma("unroll") for (int s_ = 0; s_ < 2; ++s_) { u32x4 w0, w1; \
            w0.x = cvtpk(pe0[8 * s_ + 0], pe0[8 * s_ + 1]); w0.y = cvtpk(pe0[8 * s_ + 2], pe0[8 * s_ + 3]); w0.z = cvtpk(pe0[8 * s_ + 4], pe0[8 * s_ + 5]); w0.w = cvtpk(pe0[8 * s_ + 6], pe0[8 * s_ + 7]); \
            w1.x = cvtpk(pe1[8 * s_ + 0], pe1[8 * s_ + 1]); w1.y = cvtpk(pe1[8 * s_ + 2], pe1[8 * s_ + 3]); w1.z = cvtpk(pe1[8 * s_ + 4], pe1[8 * s_ + 5]); w1.w = cvtpk(pe1[8 * s_ + 6], pe1[8 * s_ + 7]); \
            pa_[s_] = __builtin_bit_cast(bf16x8, w0); pa_[2 + s_] = __builtin_bit_cast(bf16x8, w1); } } while (0)
#define A_PV(pa_, vb_) do { _Pragma("unroll") for (int s_ = 0; s_ < 4; ++s_) { bf16x8 vf_[NDB]; \
        _Pragma("unroll") for (int db = 0; db < NDB; ++db) { const LAS unsigned char* vp = lds + vrd + (vb_) * VBUF + s_ * 4 * VGRP + db * 256; \
            const s16x4 lo_ = __builtin_bit_cast(s16x4, __builtin_amdgcn_ds_read_tr16_b64_v4i16((LAS s16x4*)vp)); \
            const s16x4 hh_ = __builtin_bit_cast(s16x4, __builtin_amdgcn_ds_read_tr16_b64_v4i16((LAS s16x4*)(vp + 2 * VGRP))); \
            vf_[db] = (bf16x8){lo_[0], lo_[1], lo_[2], lo_[3], hh_[0], hh_[1], hh_[2], hh_[3]}; } \
        _Pragma("unroll") for (int db = 0; db < NDB; ++db) o[db] = __builtin_amdgcn_mfma_f32_32x32x16_bf16(pa_[s_], vf_[db], o[db], 0, 0, 0); } } while (0)
#pragma unroll 1
    for (int it = 0; it < nt; ++it) {
        const int t = t_lo + it, cur = t & 3;
        if (it + 1 < nt) { if (NDB == 2) A_WAITV(2); else A_WAITV(3); } else A_WAITV(0);
        asm volatile("s_waitcnt lgkmcnt(0)" ::: "memory");
        __builtin_amdgcn_s_barrier();
        asm volatile("" ::: "memory");
        if (it + 2 < nt) A_DMA(t + 2);
        if (t >= tw_lo && t <= tw_hi) {
            const LAS unsigned char* Kb = lds + krd + cur * 8192;
            bf16x8 kf[8];
#pragma unroll
            for (int d0 = 0; d0 < 4; ++d0) { const int off = ((2 * d0 + hi) ^ ksw) << 4; kf[2 * d0] = *(const LAS bf16x8*)(Kb + off); kf[2 * d0 + 1] = *(const LAS bf16x8*)(Kb + 4096 + off); }
            f32x16 p0, p1;
            if (BIAS) {
                const LAS float* bb = (const LAS float*)(lds + A_B + it * 256);
#pragma unroll
                for (int g = 0; g < 4; ++g) { const f32x4 b0 = *(const LAS f32x4*)(bb + 8 * g + 4 * hi), b1 = *(const LAS f32x4*)(bb + 32 + 8 * g + 4 * hi);
#pragma unroll
                    for (int i = 0; i < 4; ++i) { p0[4 * g + i] = b0[i]; p1[4 * g + i] = b1[i]; } }
            }
            float ls; bf16x8 pa[4];
#pragma unroll
            for (int d0 = 0; d0 < 4; ++d0) {
                if (!BIAS && d0 == 0) {
                    const f32x16 z = {};
                    p0 = __builtin_amdgcn_mfma_f32_32x32x16_bf16(kf[0], qr[0], z, 0, 0, 0);
                    p1 = __builtin_amdgcn_mfma_f32_32x32x16_bf16(kf[1], qr[0], z, 0, 0, 0);
                } else {
                    p0 = __builtin_amdgcn_mfma_f32_32x32x16_bf16(kf[2 * d0], qr[d0], p0, 0, 0, 0);
                    p1 = __builtin_amdgcn_mfma_f32_32x32x16_bf16(kf[2 * d0 + 1], qr[d0], p1, 0, 0, 0);
                }
            }
            A_SUMPACK(ls, pa);
#if ATT_SGB
#pragma unroll
            for (int i = 0; i < 8; ++i) { __builtin_amdgcn_sched_group_barrier(0x008, 1, 0); __builtin_amdgcn_sched_group_barrier(0x002, 4, 0); }
#endif
            l_run += ls;
            const bool first = (t == tw_lo);
            const float mold = first ? 0.f : m_run; const f32x2 mo2 = {-mold, -mold};
            f32x2 q0[8], q1[8];
#pragma unroll
            for (int r = 0; r < 8; ++r) { q0[r] = (f32x2){p0[2 * r], p0[2 * r + 1]} * QSCALE + mo2; q1[r] = (f32x2){p1[2 * r], p1[2 * r + 1]} * QSCALE + mo2; }
            const int kv0 = t * 64;
            const bool need_mask = (kv0 + 63 > qw) || (qw + 31 - kv0 > W);
            if (need_mask) {
#pragma unroll
                for (int r = 0; r < 16; ++r) { const int kv = kv0 + crow(r, hi);
                    if (kv > qrow || qrow - kv > W) q0[r >> 1][r & 1] = -INFINITY;
                    if (kv + 32 > qrow || qrow - kv - 32 > W) q1[r >> 1][r & 1] = -INFINITY; }
            }
            float mxa = max3f(q0[0][0], q0[0][1], q1[0][0]), mxb = max3f(q1[0][1], q0[1][0], q0[1][1]);
            mxa = max3f(mxa, q1[1][0], q1[1][1]);
#pragma unroll
            for (int r = 2; r < 8; ++r) { mxa = max3f(mxa, q0[r][0], q0[r][1]); mxb = max3f(mxb, q1[r][0], q1[r][1]); }
            float mx = fmaxf(mxa, mxb); mx = fmaxf(mx, sx(mx, 32, lane));
            float alpha = 1.0f;
            if (first || __any(mx > 8.0f)) {
                const float dl = first ? mx : fmaxf(mx, 0.f); const f32x2 dl2 = {dl, dl};
                m_run = mold + dl; alpha = first ? 0.f : fast_exp2(-dl); l_run *= alpha;
#pragma unroll
                for (int r = 0; r < 8; ++r) { q0[r] -= dl2; q1[r] -= dl2; }
            }
            if (t > tw_lo) {
                A_RESCALE();
                A_PV(pa, (t - 1) & 3);
#pragma unroll
                for (int r = 0; r < 8; ++r) { pe0[2 * r] = fast_exp2(q0[r][0]); pe0[2 * r + 1] = fast_exp2(q0[r][1]); pe1[2 * r] = fast_exp2(q1[r][0]); pe1[2 * r + 1] = fast_exp2(q1[r][1]); }
#if ATT_SGB && ATT_SGB2
#pragma unroll
                for (int i = 0; i < NDB * 4; ++i) { __builtin_amdgcn_sched_group_barrier(0x100, 2, 0); __builtin_amdgcn_sched_group_barrier(0x008, 1, 0); __builtin_amdgcn_sched_group_barrier(0x002, 32 / (NDB * 4), 0); }
#endif
            } else {
#pragma unroll
                for (int r = 0; r < 8; ++r) { pe0[2 * r] = fast_exp2(q0[r][0]); pe0[2 * r + 1] = fast_exp2(q0[r][1]); pe1[2 * r] = fast_exp2(q1[r][0]); pe1[2 * r + 1] = fast_exp2(q1[r][1]); }
            }
            alpha_prev = alpha;
            if (t == tw_hi) {
                float ls2; bf16x8 pa2[4];
                A_SUMPACK(ls2, pa2); l_run += ls2;
                A_RESCALE();
                A_PV(pa2, cur);
            }
        }
    }
    asm volatile("s_waitcnt lgkmcnt(0)" ::: "memory");
    __builtin_amdgcn_s_barrier();
    asm volatile("" ::: "memory");
    const float l_tot = l_run + sx(l_run, 32, lane);
    if (J.lse && hi == 0) J.lse[(long)qrow * J.lstride] = (m_run + log2f(l_tot)) * LN2;
    if (hi == 0) wsf[r32] = 1.0f / l_tot;
    LAS bf16_t* stg = (LAS bf16_t*)(lds) + wid * (NDB * 1024);
#pragma unroll
    for (int g = 0; g < 4; ++g) { const f32x4 a = *(const LAS f32x4*)(wsf + 8 * g + 4 * hi);
#pragma unroll
        for (int i = 0; i < 4; ++i) { const int orow = 8 * g + 4 * hi + i;
#pragma unroll
            for (int db = 0; db < NDB; ++db) stg[orow * (NDB * 32) + db * 32 + r32] = (bf16_t)(cvtpk(o[db][4 * g + i] * a[i], 0.f) & 0xffffu); } }
    bf16_t* Ow = J.O + (long)qw * J.opitch;
#pragma unroll
    for (int i = 0; i < NDB * 2; ++i) { const int idx = i * 64 + lane, row = idx / (NDB * 4), ch = idx % (NDB * 4);
        const u32x4 v = *(const LAS u32x4*)(stg + row * (NDB * 32) + ch * 8); *(u32x4*)(Ow + (long)row * J.opitch + ch * 8) = v; }
    __syncthreads();
#undef A_DMA
#undef A_RESCALE
#undef A_SUMPACK
#undef A_PV
}

#define XB_TMO      128
#define XB_XCNT(j)  (256  + 64 * (j))
#define XB_XSUB(j)  (1280 + 64 * (j))
#define XB_XGEN(j)  (2304 + 64 * (j))
#define XB_TOP      3328
#define XB_TOPGEN   3392
#define XCD_BAR_WORDS 3456
#define XB_SPIN_CAP (1u << 18)
constexpr int XB_ST_OFF = 147440;
__device__ __forceinline__ unsigned xb_ld(unsigned* p)              { return __hip_atomic_load(p, __ATOMIC_RELAXED, __HIP_MEMORY_SCOPE_AGENT); }
__device__ __forceinline__ unsigned xb_add(unsigned* p, unsigned v) { return __hip_atomic_fetch_add(p, v, __ATOMIC_RELAXED, __HIP_MEMORY_SCOPE_AGENT); }
__device__ __forceinline__ unsigned xb_xcc_id() { return (unsigned)__builtin_amdgcn_s_getreg((3 << 11) | 20) & 0xFu; }
#define XB_SPIN(cond, bar) do { unsigned _sp = 0; while (cond) { __builtin_amdgcn_s_sleep(1); \
    if ((++_sp & 255u) == 0u) { if (xb_ld(&(bar)[XB_TMO])) break; if (_sp > XB_SPIN_CAP) { atomicAdd(&(bar)[XB_TMO], 1u); break; } } } } while (0)
__device__ __forceinline__ void xcd_barrier_complete(unsigned* bar, unsigned x, unsigned G, unsigned& nloc, unsigned& nx) {
    unsigned sum, cnt, mine, sp = 0u;
    for (;;) {
        sum = 0u; cnt = 0u; mine = 0u;
#pragma unroll
        for (unsigned j = 0; j < 16; ++j) { const unsigned c = xb_ld(&bar[XB_XCNT(j)]); sum += c; cnt += (c > 0u) ? 1u : 0u; mine = (j == x) ? c : mine; }
        if (sum == G) break;
        __builtin_amdgcn_s_sleep(1);
        if ((++sp & 255u) == 0u) { if (xb_ld(&bar[XB_TMO])) break; if (sp > XB_SPIN_CAP) { atomicAdd(&bar[XB_TMO], 1u); break; } }
    }
    nloc = mine > 0u ? mine : 1u; nx = cnt > 0u ? cnt : 1u;
}
__device__ __forceinline__ void grid_bar(unsigned* bar, LAS unsigned char* lds, unsigned G, int tid) {
    asm volatile("s_waitcnt vmcnt(0)" ::: "memory");
    __syncthreads();
    if (tid == 0) {
        volatile LAS unsigned* st = (volatile LAS unsigned*)(lds + XB_ST_OFF);
        const unsigned x = xb_xcc_id();
        __builtin_amdgcn_s_waitcnt(0);
        unsigned nloc = st[0], nx = st[1];
        if (nloc == 0u) { xcd_barrier_complete(bar, x, G, nloc, nx); st[0] = nloc; st[1] = nx; }
        const unsigned old = xb_add(&bar[XB_XSUB(x)], 1u);
        const unsigned gen = old / nloc;
        if (old + 1u == (gen + 1u) * nloc) {
            __builtin_amdgcn_fence(__ATOMIC_RELEASE, "agent");
            asm volatile("s_waitcnt vmcnt(0)" ::: "memory");
            const unsigned og = xb_add(&bar[XB_TOP], 1u);
            const unsigned tg = og / nx;
            if (og + 1u == (tg + 1u) * nx) xb_add(&bar[XB_TOPGEN], 1u);
            else XB_SPIN(xb_ld(&bar[XB_TOPGEN]) == tg, bar);
            __builtin_amdgcn_fence(__ATOMIC_ACQUIRE, "agent");
            xb_add(&bar[XB_XGEN(x)], 1u);
            asm volatile("s_waitcnt vmcnt(0)" ::: "memory");
        } else {
            XB_SPIN(xb_ld(&bar[XB_XGEN(x)]) == gen, bar);
            __builtin_amdgcn_fence(__ATOMIC_ACQUIRE, "agent");
            asm volatile("s_waitcnt vmcnt(0)" ::: "memory");
        }
    }
    __syncthreads();
}

__device__ __forceinline__ void fill_rtab(LAS unsigned char* lds, const pg8::StaticOrder& SO, const float* ssq, int tid) {
    LAS float* rtab = (LAS float*)(lds + RTAB_OFF);
    f32x4 v[6][4]; bool ok[6];
#pragma unroll
    for (int j = 0; j < 6; ++j) { pg8::Unit uu; ok[j] = SO.next(2 * j + (tid >> 8), uu);
        if (ok[j]) { const f32x4* sp = (const f32x4*)(ssq + ((size_t)uu.pm * 256 + (tid & 255)) * 16);
#pragma unroll
            for (int q = 0; q < 4; ++q) v[j][q] = sp[q]; } }
#pragma unroll
    for (int j = 0; j < 6; ++j) if (ok[j]) { float sm = 0.f;
#pragma unroll
        for (int q = 0; q < 4; ++q) sm += (v[j][q][0] + v[j][q][1]) + (v[j][q][2] + v[j][q][3]);
        rtab[(2 * j + (tid >> 8)) * 256 + (tid & 255)] = 1.0f / sqrtf(sm * (1.0f / DM) + NORM_EPS); }
    __syncthreads();
}

struct Args {
    const float *x, *p, *norm_ffn1, *w_ffn1_in, *w_ffn1_out, *norm_mix, *norm_ffn2, *w_ffn2_in, *w_ffn2_out, *norm_ple, *w_ple_gate, *b_ple_gate, *w_ple_proj,
        *fox_w_in, *fox_b_f, *fox_w_out, *dil_w_in, *dil_w_out, *diff_w_in, *diff_lambda, *diff_subln, *diff_w_out, *sgu_w_in, *sgu_norm_v, *sgu_w_s, *sgu_b_s, *sgu_w_out, *norm_final;
    float* out; unsigned char* ws;
};

__device__ __forceinline__ void transpose_item(const float* W, int K, int N, bf16_t* WT, const float* gain, int mode, LAS float* scr, int item, int lane) {
    const int nblk = (N + 31) / 32, kb = item / nblk, nb = item % nblk, k0 = 64 * kb, n0 = 32 * nb;
    const int ncol = n0 + (lane & 31); const bool okc = ncol < N;
    float vv[32];
#pragma unroll
    for (int i = 0; i < 32; ++i) { const int kk = 2 * i + (lane >> 5); vv[i] = okc ? W[(size_t)(k0 + kk) * N + ncol] : 0.f; }
    if (gain) {
#pragma unroll
        for (int i = 0; i < 32; ++i) vv[i] *= gain[k0 + 2 * i + (lane >> 5)];
    }
#pragma unroll
    for (int i = 0; i < 32; ++i) scr[(2 * i + (lane >> 5)) * 33 + (lane & 31)] = vv[i];
    asm volatile("s_waitcnt lgkmcnt(0)" ::: "memory");
    int d0 = n0;
    if (mode & 1) { if (n0 < DFF) d0 = (n0 / 128) * 256 + (n0 % 128); else { const int mm = n0 - DFF; d0 = (mm / 128) * 256 + 128 + (mm % 128); } }
    const int c = lane & 7;
#pragma unroll
    for (int j = 0; j < 4; ++j) { const int n = (lane >> 3) + 8 * j; const LAS float* s = scr + (8 * c) * 33 + n;
        u32x4 o;
        if (mode & 2) {
            const unsigned b0 = cvtpk(s[0 * 33], s[1 * 33]), b1 = cvtpk(s[2 * 33], s[3 * 33]), b2 = cvtpk(s[4 * 33], s[5 * 33]), b3 = cvtpk(s[6 * 33], s[7 * 33]);
            o.x = cvtpk_h(bf_lo(b0), bf_hi(b0)); o.y = cvtpk_h(bf_lo(b1), bf_hi(b1)); o.z = cvtpk_h(bf_lo(b2), bf_hi(b2)); o.w = cvtpk_h(bf_lo(b3), bf_hi(b3)); }
        else { o.x = cvtpk(s[0 * 33], s[1 * 33]); o.y = cvtpk(s[2 * 33], s[3 * 33]); o.z = cvtpk(s[4 * 33], s[5 * 33]); o.w = cvtpk(s[6 * 33], s[7 * 33]); }
        *(u32x4*)(WT + (size_t)(d0 + n) * K + k0 + 8 * c) = o; }
    asm volatile("s_waitcnt lgkmcnt(0)" ::: "memory");
}

__device__ __forceinline__ void get_mat(const Args& a, bf16_t* Wt, int mi, const float*& src, int& K, int& N, bf16_t*& dst, const float*& gain, int& mode) {
    gain = nullptr; mode = 0;
    if (mi < 24) {
        const int L = mi / 6, k = mi % 6; bf16_t* wl = Wt + (size_t)L * L_SIZE;
        if (k == 0)      { src = a.w_ffn1_in + (size_t)L * DM * 2 * DFF; K = DM; N = 2 * DFF; dst = wl + L_FFN1IN; gain = a.norm_ffn1 + L * DM; mode = 1; }
        else if (k == 1) { src = a.w_ffn1_out + (size_t)L * DFF * DM; K = DFF; N = DM; dst = wl + L_FFN1OUT; }
        else if (k == 2) { src = a.w_ffn2_in + (size_t)L * DM * 2 * DFF; K = DM; N = 2 * DFF; dst = wl + L_FFN2IN; gain = a.norm_ffn2 + L * DM; mode = 1; }
        else if (k == 3) { src = a.w_ffn2_out + (size_t)L * DFF * DM; K = DFF; N = DM; dst = wl + L_FFN2OUT; }
        else if (k == 4) { src = a.w_ple_gate + (size_t)L * DM * DM; K = DM; N = DM; dst = wl + L_PLEG; gain = a.norm_ple + L * DM; mode = 0; }
        else             { src = a.w_ple_proj + (size_t)L * PLE * DM; K = PLE; N = DM; dst = wl + L_PLEP; }
    } else {
        const int k = mi - 24;
        if (k == 0)      { src = a.fox_w_in; K = DM; N = 3 * DM + 16; dst = Wt + W_FOXIN; gain = a.norm_mix; mode = 0; }
        else if (k == 1) { src = a.fox_w_out; K = DM; N = DM; dst = Wt + W_FOXOUT; }
        else if (k == 2) { src = a.dil_w_in; K = DM; N = 5 * DM; dst = Wt + W_DILIN; gain = a.norm_mix + DM; mode = 0; }
        else if (k == 3) { src = a.dil_w_out; K = DM; N = DM; dst = Wt + W_DILOUT; }
        else if (k == 4) { src = a.diff_w_in; K = DM; N = 3 * DM; dst = Wt + W_DIFFIN; gain = a.norm_mix + 2 * DM; mode = 0; }
        else if (k == 5) { src = a.diff_w_out; K = DM; N = DM; dst = Wt + W_DIFFOUT; }
        else if (k == 6) { src = a.sgu_w_in; K = DM; N = 4 * DM; dst = Wt + W_SGUIN; gain = a.norm_mix + 3 * DM; mode = 0; }
        else             { src = a.sgu_w_out; K = 2 * DM; N = DM; dst = Wt + W_SGUOUT; }
    }
}

__global__ void __launch_bounds__(512, 2) mega(Args a) {
    extern __shared__ __attribute__((aligned(16))) unsigned char lds_raw[];
    LAS unsigned char* lds = (LAS unsigned char*)lds_raw;
#if TSEL == 13 || TSEL == 15
    if (blockIdx.x == 0 && threadIdx.x == 0) *(unsigned long long*)((float*)(a.ws + WS_MISC) + 10) = __builtin_amdgcn_s_memrealtime();
#endif
    if (threadIdx.x == 0) { ((LAS unsigned*)(lds + XB_ST_OFF))[0] = 0u; ((LAS unsigned*)(lds + XB_ST_OFF))[1] = 0u; (void)xb_add(&((unsigned*)(a.ws + WS_BAR))[XB_XCNT(xb_xcc_id())], 1u); }
    __syncthreads();
    cg::this_grid().sync();
    const int wave0 = __builtin_amdgcn_readfirstlane((int)threadIdx.x >> 6);
#define gt ((long)bid * 512 + tid)
#define ssqX ((float*)(ws + WS_SSQX))
#define ssqY ((float*)(ws + WS_SSQY))
#define ssqV ((float*)(ws + WS_SSQV))
#define lseb ((float*)(ws + WS_LSE))
#define flog ((float*)(ws + WS_FLOG))
#define rope ((f32x2*)(ws + WS_ROPE))
#define misc ((float*)(ws + WS_MISC))
#define pbf ((bf16_t*)(ws + WS_PBF))
#define hb ((bf16_t*)(ws + WS_HB))
#define Wt ((bf16_t*)(ws + WS_W))
#define S1 ((bf16_t*)(ws + WS_S1))
#define FRESH_TID(name) int name; { int w_ = wave0; asm volatile("" : "+s"(w_)); unsigned o_ = ~0u; asm volatile("" : "+s"(o_)); name = w_ * 64 + (int)__builtin_amdgcn_mbcnt_hi(o_, __builtin_amdgcn_mbcnt_lo(o_, 0u)); asm volatile("" : "+v"(name)); }
#define PHASE_VARS \
    int wave_ = wave0; asm volatile("" : "+s"(wave_)); \
    unsigned ones_ = ~0u; asm volatile("" : "+s"(ones_)); \
    int tid = wave_ * 64 + (int)__builtin_amdgcn_mbcnt_hi(ones_, __builtin_amdgcn_mbcnt_lo(ones_, 0u)); asm volatile("" : "+v"(tid)); \
    int bid = blockIdx.x; asm volatile("" : "+s"(bid)); \
    int G = gridDim.x; asm volatile("" : "+s"(G)); \
    const int lane = tid & 63, wave = wave_; \
    const int gw = bid * 8 + wave, NGW = G * 8; \
    const long NGT = (long)G * 512; \
    gbyte_t* wsg_ = (gbyte_t*)a.ws; asm volatile("" : "+s"(wsg_)); unsigned char* ws = (unsigned char*)wsg_; \
    float* h = a.out; \
    (void)lane; (void)wave; (void)gw; (void)NGW; (void)NGT; (void)h; (void)ws;

    {
#if TSEL == 12
        const unsigned long long tkp_ = __builtin_amdgcn_s_memrealtime();
#endif
        PHASE_VARS
        LAS float* scr = (LAS float*)(lds + wave * 16384);
#pragma unroll 1
        for (int rep = 0; rep < (PROBE_REP == 6 ? 2 : 1); ++rep) {
        int it0 = 0;
#pragma unroll 1
        for (int mi = 0; mi < 32; ++mi) {
            const float* src; int K_, N_; bf16_t* dst; const float* gain; int mode;
            get_mat(a, Wt, mi, src, K_, N_, dst, gain, mode);
            const int nitems = (K_ / 64) * ((N_ + 31) / 32);
            const int first = it0 + (((gw - it0) % NGW) + NGW) % NGW;
#pragma unroll 1
            for (int gi = first; gi < it0 + nitems; gi += NGW) transpose_item(src, K_, N_, dst, gain, mode, scr, gi - it0, lane);
            it0 += nitems;
        }
#pragma unroll 1
        for (int m0 = gw; m0 < MTOK; m0 += 4 * NGW) {
            f32x4 v[4][4];
#pragma unroll
            for (int q = 0; q < 4; ++q)
#pragma unroll
                for (int j = 0; j < 4; ++j) v[q][j] = ((const f32x4*)(a.x + (size_t)(m0 + q * NGW) * DM) + lane)[64 * j];
#pragma unroll
            for (int q = 0; q < 4; ++q) { const int m = m0 + q * NGW; u32x2* o8 = (u32x2*)(hb + (size_t)m * DM) + lane; float ss = 0.f;
#pragma unroll
                for (int j = 0; j < 4; ++j) { const f32x4 t = v[q][j]; ss += (t[0] * t[0] + t[1] * t[1]) + (t[2] * t[2] + t[3] * t[3]); u32x2 w; w.x = cvtpk(t[0], t[1]); w.y = cvtpk(t[2], t[3]); o8[64 * j] = w; }
                ss = wave_sum(ss, lane);
                if (lane < 16) ssqX[(size_t)m * 16 + lane] = ss * (1.0f / 16.0f); }
        }
#pragma unroll 1
        for (long i = gt; i < (long)MTOK * PLE / 4; i += NGT) { const f32x4 v = ((const f32x4*)a.p)[i]; u32x2 w; w.x = cvtpk(v[0], v[1]); w.y = cvtpk(v[2], v[3]); ((u32x2*)pbf)[i] = w; }
        if (gt < SEQ * 8) {
            const int pos = (int)(gt >> 3), j = (int)(gt & 7);
            const float invf = j == 0 ? 1.0f : j == 1 ? 0.1939227432012558f : j == 2 ? 0.03760603070259094f : j == 3 ? 0.007292664609849453f : j == 4 ? 0.0014142135623842478f
                             : j == 5 ? 0.00027424818836152554f : j == 6 ? 5.318296098266728e-05f : 1.0313386155758053e-05f;
            const float angf = (float)pos * invf; const double ang = (double)angf;
            const double kk = rint(ang * 0.15915494309189535); const double r = (ang - kk * 6.283185307179586) - kk * 2.4492935982947064e-16; const double r2 = r * r;
            double s = 1.0, c = 1.0;
#pragma unroll
            for (int n = 13; n >= 1; --n) { s = 1.0 - s * r2 * (1.0 / (double)((2 * n) * (2 * n + 1))); c = 1.0 - c * r2 * (1.0 / (double)((2 * n - 1) * (2 * n))); }
            rope[gt] = (f32x2){(float)c, (float)(r * s)};
        }
        if (gt == 0) {
            float s1 = 0.f, s2 = 0.f;
#pragma unroll 1
            for (int i = 0; i < 64; ++i) { s1 += a.diff_lambda[i] * a.diff_lambda[64 + i]; s2 += a.diff_lambda[128 + i] * a.diff_lambda[192 + i]; }
            misc[0] = expf(s1) - expf(s2) + LAM_INIT; misc[8] = 0.f;
        }
        }
        grid_bar((unsigned*)(ws + WS_BAR), lds, (unsigned)G, tid);
#if TSEL == 12
        if (blockIdx.x == 0 && threadIdx.x == 0) misc[8] += (float)(__builtin_amdgcn_s_memrealtime() - tkp_) * 0.01f;
#endif
    }

#pragma unroll 1
    for (int qq = 0; qq < 4 * NSLOTS; ++qq) {
        PHASE_VARS
        pg8::StaticOrder SO;
        bf16_t* const pp = S1 + (size_t)96 * MiB;
        bf16_t* const hb2 = S1 + (size_t)128 * MiB;
        const int L = qq / NSLOTS, sl = qq % NSLOTS;
#if TSEL
        unsigned long long tk0_ = __builtin_amdgcn_s_memrealtime();
#endif
#if PROBE_REP == 1
        const int s = (sl <= 1) ? 0 : (sl <= 7) ? sl - 1 : (sl == 8) ? 6 : sl - 2;
#elif PROBE_REP == 7
        const int s = (sl <= 2) ? sl : sl - 1;
#elif PROBE_REP == 8
        const int s = (sl <= 8) ? sl : 8;
#else
        const int s = sl;
#endif
        const bf16_t* wl = Wt + (size_t)L * L_SIZE;
        if (s == 0 || s == 6) {
            pg8::Gemm g{hb, wl + (s == 0 ? L_FFN1IN : L_FFN2IN), MTOK, 2 * DFF, DM, DM}; SO.init(MTOK, 2 * DFF, G, bid); fill_rtab(lds, SO, ssqX, tid); EpiSwiglu E{(const LAS float*)(lds + RTAB_OFF), S1}; { FRESH_TID(tidg) pg8::gemm_phase<EpiSwiglu, false>(lds, tidg, g, SO, E); }

        } else if (s == 1 || s == 5 || s == 7) {
            const bf16_t* Bt; int K_, lda_; float sc; float* sq;
            if (s == 1) { Bt = wl + L_FFN1OUT; K_ = DFF; lda_ = DFF; sc = 0.5f; sq = ssqY; }
            else if (s == 7) { Bt = wl + L_FFN2OUT; K_ = DFF; lda_ = DFF; sc = 0.5f; sq = ssqY; }
            else { sc = 1.0f; sq = ssqX; K_ = DM;
                if (L == 0) { Bt = Wt + W_FOXOUT; lda_ = 3072; } else if (L == 1) { Bt = Wt + W_DILOUT; lda_ = 5120; } else if (L == 2) { Bt = Wt + W_DIFFOUT; lda_ = 3072; } else { Bt = Wt + W_SGUOUT; K_ = 2 * DM; lda_ = 4096; } }
            { pg8::Gemm g{S1, Bt, MTOK, DM, K_, lda_}; SO.init(MTOK, DM, G, bid); EpiResid E{hb, s == 7 ? hb2 : hb, sq, sc}; pg8::gemm_phase(lds, tid, g, SO, E); }
            if (s == 7) { FRESH_TID(tid4) pg8::Gemm g{pbf, wl + L_PLEP, MTOK, DM, PLE, PLE}; SO.init(MTOK, DM, G, bid); EpiBf16 E{pp, DM}; pg8::gemm_phase(lds, tid4, g, SO, E); }
        } else if (s == 2) {
            if (L < 3) {
                const bf16_t* Bt; int N_, ldo, qs, re, fg;
                if (L == 0) { Bt = Wt + W_FOXIN; N_ = 3328; ldo = 3072; qs = 0; re = 0; fg = 12; }
                else if (L == 1) { Bt = Wt + W_DILIN; N_ = 5120; ldo = 5120; qs = 0; re = 4096; fg = -1; }
                else { Bt = Wt + W_DIFFIN; N_ = 3072; ldo = 3072; qs = 0; re = 2048; fg = -1; }
                pg8::Gemm g{hb, Bt, MTOK, N_, DM, DM}; SO.init(MTOK, N_, G, bid); fill_rtab(lds, SO, ssqY, tid); EpiQkv E{(const LAS float*)(lds + RTAB_OFF), S1, ldo, qs, re, fg, rope, a.fox_b_f, flog}; { FRESH_TID(tidg) pg8::gemm_phase<EpiQkv, false>(lds, tidg, g, SO, E); }
            } else {
                pg8::Gemm g{hb, Wt + W_SGUIN, MTOK, 4096, DM, DM}; SO.init(MTOK, 4096, G, bid); fill_rtab(lds, SO, ssqY, tid); EpiSguIn E{(const LAS float*)(lds + RTAB_OFF), S1, ssqV}; { FRESH_TID(tidg) pg8::gemm_phase<EpiSguIn, false>(lds, tidg, g, SO, E); }
            }
        } else if (s == 8) {
            { pg8::Gemm g{hb2, wl + L_PLEG, MTOK, DM, DM, DM}; SO.init(MTOK, DM, G, bid); fill_rtab(lds, SO, ssqY, tid); EpiPleGate E{(const LAS float*)(lds + RTAB_OFF), hb2, hb, ssqX, a.b_ple_gate + L * DM, pp}; { FRESH_TID(tidg) pg8::gemm_phase<EpiPleGate, false>(lds, tidg, g, SO, E); } }
            if (L < 3) {
                const f32x4* ps = (const f32x4*)(a.p + (size_t)(L + 1) * MTOK * PLE);
                FRESH_TID(tid3)
#pragma unroll 1
                for (long i = (long)bid * 512 + tid3; i < (long)MTOK * PLE / 4; i += NGT) { const f32x4 v = ps[i]; u32x2 w; w.x = cvtpk(v[0], v[1]); w.y = cvtpk(v[2], v[3]); ((u32x2*)pbf)[i] = w; }
            }
        } else if ((s == 4 && L == 0) || (s == 3 && (L == 1 || L == 2))) {
            const int total = L == 1 ? 6144 : 2048;
#pragma unroll 1
            for (int n = bid; n < total; n += G) {
                AttnJob J; bf16_t* dumO = nullptr; (void)dumO;
                if (L == 0) {
                    const int v = n & 255, i = n >> 8, bh = v >> 1, s2 = (v & 1) * 4 + (i >> 1), qb = (i & 1) ? 15 - s2 : s2, b = bh >> 4, hh = bh & 15;
                    bf16_t* base = S1 + (size_t)b * SEQ * 3072 + hh * 64;
                    J = AttnJob{base, base + 1024, base + 2048, base, 3072, 3072, flog + (size_t)b * SEQ * 16 + hh, 16, nullptr, 0, qb * 256, 1 << 20};
                } else if (L == 1) {
                    const int gi = n / 2048, idx = n % 2048, bh = idx & 127, sub = idx >> 7, b = bh >> 4, hh = bh & 15;
                    const int d = gi == 0 ? 1 : gi == 1 ? 4 : 16; const int res = sub % d, ub = sub / d;
                    bf16_t* base = S1 + ((size_t)b * SEQ + res) * 5120 + hh * 64; dumO = hb + ((size_t)b * SEQ + res) * 1024 + hh * 64;
                    J = AttnJob{base + gi * 1024, base + 3072, base + 4096, base + gi * 1024, (long)5120 * d, (long)5120 * d, nullptr, 0,
                                lseb + (size_t)gi * MTOK * 16 + ((size_t)b * SEQ + res) * 16 + hh, 16 * d, ub * 256, 128};
                } else {
                    const int v = n & 255, i = n >> 8, bm = v >> 1, s2 = (v & 1) * 4 + (i >> 1), qb = (i & 1) ? 15 - s2 : s2, b = bm >> 4, mm = bm & 15;
                    bf16_t* base = S1 + (size_t)b * SEQ * 3072; bf16_t* OM = S1 + (size_t)MTOK * 3072;
                    J = AttnJob{base + mm * 64, base + 1024 + mm * 64, base + 2048 + (mm >> 1) * 128, OM + (size_t)b * SEQ * 2048 + mm * 128, 3072, 2048, nullptr, 0, nullptr, 0, qb * 256, 1 << 20};
                }
#pragma unroll 1
                for (int rep = ((PROBE_REP == 3 && L != 1) || (PROBE_REP == 10 && L == 1)) ? 0 : 1; rep < 2; ++rep) {
                    AttnJob J2 = J;
                    if (PROBE_REP == 10 && rep == 0) { J2.O = dumO; J2.opitch = J.pitch / 5; J2.lse = nullptr; }
                    if (rep == 0 && L == 0) { const size_t off = (size_t)(J.Q - S1); J2.O = S1 + (size_t)96 * MiB + (off / ((size_t)SEQ * 3072)) * SEQ * 1024 + (off % 3072); J2.opitch = 1024; }
                    if (L == 2) attn_unit<4, false>(lds, tid, J2); else if (L == 0) attn_unit<2, true>(lds, tid, J2); else attn_unit<2, false>(lds, tid, J2);
                }
            }
        } else if (s == 3 && L == 0) {
#pragma unroll 1
            for (int sq = bid; sq < 128; sq += G) {
                const int b = sq >> 4, hh = sq & 15; float* fp = flog + ((size_t)b * SEQ + tid * 8) * 16 + hh; float v[8];
#pragma unroll
                for (int i = 0; i < 8; ++i) v[i] = fp[i * 16];
#pragma unroll
                for (int i = 1; i < 8; ++i) v[i] += v[i - 1];
                float incl = v[7];
#pragma unroll
                for (int o = 1; o < 64; o <<= 1) { const float nb = __int_as_float(__builtin_amdgcn_ds_bpermute(((lane - o) & 63) << 2, __float_as_int(incl))); if (lane >= o) incl += nb; }
                LAS float* sc = (LAS float*)lds; if (lane == 63) sc[wave] = incl; __syncthreads();
                float pre = incl - v[7];
                for (int w = 0; w < wave; ++w) pre += sc[w];
#pragma unroll
                for (int i = 0; i < 8; ++i) fp[i * 16] = (v[i] + pre) * LOG2E;
                __syncthreads();
            }
        } else if (s == 4 && L == 1) {
#pragma unroll 4
            for (long it = gt; it < (long)MTOK * 128; it += NGT) {
                const long row = it >> 7; const int hh = (int)(it >> 3) & 15, ch = (int)it & 7;
                const float l0 = lseb[row * 16 + hh], l1 = lseb[(size_t)MTOK * 16 + row * 16 + hh], l2 = lseb[(size_t)2 * MTOK * 16 + row * 16 + hh];
                const float mx = fmaxf(l0, fmaxf(l1, l2)); float w0 = expf(l0 - mx), w1 = expf(l1 - mx), w2 = expf(l2 - mx); const float inv = 1.0f / (w0 + w1 + w2); w0 *= inv; w1 *= inv; w2 *= inv;
                bf16_t* p0 = S1 + row * 5120 + hh * 64 + ch * 8;
                const u32x4 a0 = *(const u32x4*)p0, a1 = *(const u32x4*)(p0 + 1024), a2 = *(const u32x4*)(p0 + 2048); u32x4 o;
#pragma unroll
                for (int k = 0; k < 4; ++k) o[k] = cvtpk(w0 * bf_lo(a0[k]) + w1 * bf_lo(a1[k]) + w2 * bf_lo(a2[k]), w0 * bf_hi(a0[k]) + w1 * bf_hi(a1[k]) + w2 * bf_hi(a2[k]));
                *(u32x4*)p0 = o;
            }
        } else if (s == 4 && L == 2) {
            const float lam = misc[0]; const bf16_t* OM = S1 + (size_t)MTOK * 3072;
#pragma unroll 4
            for (long it = gt; it < (long)MTOK * 128; it += NGT) {
                const long row = it >> 7; const int hh = (int)(it >> 4) & 7, c16 = (int)it & 15;
                const bf16_t* p1 = OM + row * 2048 + (2 * hh) * 128 + c16 * 8;
                const u32x4 a1 = *(const u32x4*)p1, a2 = *(const u32x4*)(p1 + 128); float o[8]; float ss = 0.f;
#pragma unroll
                for (int k = 0; k < 4; ++k) { o[2 * k] = bf_lo(a1[k]) - lam * bf_lo(a2[k]); o[2 * k + 1] = bf_hi(a1[k]) - lam * bf_hi(a2[k]); ss += o[2 * k] * o[2 * k] + o[2 * k + 1] * o[2 * k + 1]; }
                ss += sx(ss, 1, lane); ss += sx(ss, 2, lane); ss += sx(ss, 4, lane); ss += sx(ss, 8, lane);
                const float r = (1.0f - LAM_INIT) / sqrtf(ss * (1.0f / 128.0f) + 1e-5f);
                const f32x4 g0 = *(const f32x4*)(a.diff_subln + c16 * 8), g1 = *(const f32x4*)(a.diff_subln + c16 * 8 + 4);
                u32x4 w; w.x = cvtpk(o[0] * r * g0[0], o[1] * r * g0[1]); w.y = cvtpk(o[2] * r * g0[2], o[3] * r * g0[3]); w.z = cvtpk(o[4] * r * g1[0], o[5] * r * g1[1]); w.w = cvtpk(o[6] * r * g1[2], o[7] * r * g1[3]);
                *(u32x4*)(S1 + row * 3072 + hh * 128 + c16 * 8) = w;
            }
        } else if (s == 3 && L == 3) {
#pragma unroll 1
            for (int n = bid; n < 2048; n += G) {
                const int chunk = n >> 3, gg = n & 7; const size_t row0 = (size_t)chunk * 128;
                LAS float* rsv = (LAS float*)(lds + 65536);
                if (tid < 128) { const f32x4* sp = (const f32x4*)(ssqV + (row0 + tid) * 32); float sm = 0.f;
#pragma unroll
                    for (int j = 0; j < 8; ++j) { const f32x4 v = sp[j]; sm += (v[0] + v[1]) + (v[2] + v[3]); }
                    rsv[tid] = 1.0f / sqrtf(sm * (1.0f / 2048.0f) + NORM_EPS); }
                __syncthreads();
                u32x4 vin[8];
#pragma unroll
                for (int k = 0; k < 8; ++k) { const int item = tid + 512 * k, sr = item >> 5, ch = item & 31; vin[k] = *(const u32x4*)(S1 + (row0 + sr) * 4096 + 2048 + gg * 256 + ch * 8); }
#pragma unroll
                for (int k = 0; k < 8; ++k) {
                    const int item = tid + 512 * k, sr = item >> 5, ch = item & 31;
                    const u32x4 vv = vin[k];
                    const f32x4 n0 = *(const f32x4*)(a.sgu_norm_v + gg * 256 + ch * 8), n1 = *(const f32x4*)(a.sgu_norm_v + gg * 256 + ch * 8 + 4); const float r = rsv[sr];
                    u32x4 w; w.x = cvtpk(bf_lo(vv.x) * r * n0[0], bf_hi(vv.x) * r * n0[1]); w.y = cvtpk(bf_lo(vv.y) * r * n0[2], bf_hi(vv.y) * r * n0[3]);
                    w.z = cvtpk(bf_lo(vv.z) * r * n1[0], bf_hi(vv.z) * r * n1[1]); w.w = cvtpk(bf_lo(vv.w) * r * n1[2], bf_hi(vv.w) * r * n1[3]);
                    *(LAS u32x4*)(lds + (sr >> 2) * 2048 + (ch >> 2) * 256 + (sr & 3) * 64 + (ch & 3) * 16) = w;
                }
                __syncthreads();
                {
                    const int r32 = lane & 31, hi = lane >> 5, tb = wave & 3, chalf = wave >> 2, g16 = (lane >> 4) & 1, i16 = lane & 15;
                    const int trow = 32 * tb + r32; const float* wrow = a.sgu_w_s + ((size_t)gg * 128 + trow) * 128;
                    f32x16 acc[4] = {};
                    const int vrd = (2 * hi) * 2048 + (i16 >> 2) * 64 + g16 * 32 + (i16 & 3) * 8;
                    f32x4 wl0[8], wl1[8];
#pragma unroll
                    for (int ks = 0; ks < 8; ++ks) { wl0[ks] = (f32x4){0.f, 0.f, 0.f, 0.f}; wl1[ks] = wl0[ks]; if (ks <= 2 * tb + 1) { const int s0 = 16 * ks + 8 * hi; wl0[ks] = *(const f32x4*)(wrow + s0); wl1[ks] = *(const f32x4*)(wrow + s0 + 4); } }
#pragma unroll
                    for (int ks = 0; ks < 8; ++ks) if (ks <= 2 * tb + 1) {
                        const int s0 = 16 * ks + 8 * hi; const f32x4 w0 = wl0[ks], w1 = wl1[ks]; float wv[8];
#pragma unroll
                        for (int j = 0; j < 4; ++j) { wv[j] = (s0 + j <= trow) ? w0[j] : 0.f; wv[4 + j] = (s0 + 4 + j <= trow) ? w1[j] : 0.f; }
                        u32x4 pw; pw.x = cvtpk(wv[0], wv[1]); pw.y = cvtpk(wv[2], wv[3]); pw.z = cvtpk(wv[4], wv[5]); pw.w = cvtpk(wv[6], wv[7]);
                        const bf16x8 pa = __builtin_bit_cast(bf16x8, pw);
#pragma unroll
                        for (int cbl = 0; cbl < 4; ++cbl) {
                            const LAS unsigned char* vp = lds + vrd + ks * 8192 + (chalf * 4 + cbl) * 256;
                            const s16x4 lo = __builtin_bit_cast(s16x4, __builtin_amdgcn_ds_read_tr16_b64_v4i16((LAS s16x4*)vp));
                            const s16x4 hh = __builtin_bit_cast(s16x4, __builtin_amdgcn_ds_read_tr16_b64_v4i16((LAS s16x4*)(vp + 2048)));
                            const bf16x8 vf = (bf16x8){lo[0], lo[1], lo[2], lo[3], hh[0], hh[1], hh[2], hh[3]};
                            acc[cbl] = __builtin_amdgcn_mfma_f32_32x32x16_bf16(pa, vf, acc[cbl], 0, 0, 0);
                        }
                    }
                    __syncthreads();
#pragma unroll
                    for (int cbl = 0; cbl < 4; ++cbl)
#pragma unroll
                        for (int r = 0; r < 16; ++r) {
                            const int t = 32 * tb + crow(r, hi);
                            *(LAS bf16_t*)(lds + t * 528 + ((chalf * 4 + cbl) * 32 + r32) * 2) = (bf16_t)(cvtpk(acc[cbl][r] + a.sgu_b_s[gg * 128 + t], 0.f) & 0xffffu);
                        }
                }
                __syncthreads();
                u32x4 uin[8];
#pragma unroll
                for (int k = 0; k < 8; ++k) { const int item = tid + 512 * k, t = item >> 5, ch = item & 31; uin[k] = *(const u32x4*)(S1 + (row0 + t) * 4096 + gg * 256 + ch * 8); }
#pragma unroll
                for (int k = 0; k < 8; ++k) {
                    const int item = tid + 512 * k, t = item >> 5, ch = item & 31;
                    bf16_t* up = S1 + (row0 + t) * 4096 + gg * 256 + ch * 8;
                    const u32x4 uv = uin[k]; const u32x4 mv = *(const LAS u32x4*)(lds + t * 528 + ch * 16); u32x4 w;
#pragma unroll
                    for (int j = 0; j < 4; ++j) w[j] = cvtpk(bf_lo(uv[j]) * bf_lo(mv[j]), bf_hi(uv[j]) * bf_hi(mv[j]));
                    *(u32x4*)up = w;
                }
                __syncthreads();
            }
        }
#if PROBE_REP == 12
        { FRESH_TID(tid2) grid_bar((unsigned*)(ws + WS_BAR), (unsigned)G, tid2, 2u * (unsigned)qq + 1u); grid_bar((unsigned*)(ws + WS_BAR), (unsigned)G, tid2, 2u * (unsigned)qq + 2u); }
#else
        { FRESH_TID(tid2) grid_bar((unsigned*)(ws + WS_BAR), lds, (unsigned)G, tid2); }
#endif
#if TSEL
        { const bool sel_ = (TSEL == 1) ? (L == 1 && s == 3) : (TSEL == 2) ? (L == 3 && s == 3) : (TSEL == 3) ? ((L == 1 && s == 4) || (L == 2 && s == 4) || (L == 0 && s == 3)) : (TSEL == 4) ? (L == 0 && s == 4) : (TSEL == 5) ? (L == 2 && s == 3) : (TSEL == 6) ? (s == 7) : (TSEL == 7) ? (s == 0 || s == 6) : (TSEL == 8) ? (s == 1) : (TSEL == 9) ? (s == 2) : (TSEL == 10) ? (s == 5) : (TSEL == 11) ? (s == 8) : false;
          if (sel_ && blockIdx.x == 0 && threadIdx.x == 0) { const unsigned long long tk1_ = __builtin_amdgcn_s_memrealtime(); misc[8] += (float)(tk1_ - tk0_) * 0.01f; } }
#endif
    }
    PHASE_VARS
#if TSEL == 13
    if (blockIdx.x == 0 && threadIdx.x == 0) { misc[8] = (float)(__builtin_amdgcn_s_memrealtime() - *(unsigned long long*)(misc + 10)) * 0.01f; } __syncthreads();
#endif
#pragma unroll 1
    for (int m0 = gw; m0 < MTOK; m0 += 4 * NGW) {
        float sm[4]; u32x2 v[4][4];
#pragma unroll
        for (int q = 0; q < 4; ++q) { const int m = m0 + q * NGW; sm[q] = lane < 16 ? ssqX[(size_t)m * 16 + lane] : 0.f;
#pragma unroll
            for (int j = 0; j < 4; ++j) v[q][j] = ((const u32x2*)(hb + (size_t)m * DM) + lane)[64 * j]; }
        f32x4 gg[4];
#pragma unroll
        for (int j = 0; j < 4; ++j) gg[j] = ((const f32x4*)a.norm_final + lane)[64 * j];
#pragma unroll
        for (int q = 0; q < 4; ++q) { const int m = m0 + q * NGW; const float r = 1.0f / sqrtf(wave_sum(sm[q], lane) * (1.0f / DM) + NORM_EPS);
#pragma unroll
            for (int j = 0; j < 4; ++j) { const f32x4 hv = {bf_lo(v[q][j].x), bf_hi(v[q][j].x), bf_lo(v[q][j].y), bf_hi(v[q][j].y)}; const f32x4 ov = hv * r * gg[j];
                ((f32x4*)(h + (size_t)m * DM) + lane)[64 * j] = ov; } }
    }
#if TSEL == 15
    if (blockIdx.x == 0 && wave0 == 0) { asm volatile("s_waitcnt vmcnt(0)" ::: "memory");
        const float us = (float)(__builtin_amdgcn_s_memrealtime() - *(unsigned long long*)(misc + 10)) * 0.01f; const int nn = (int)us;
        for (int e = lane; e < nn; e += 64) h[(size_t)(e >> 10) * 2048 * DM + (e & 1023)] += 0.0625f; }
#endif
}

extern "C" void kernel_launch(void* const* d_in, const int* in_sizes, int n_in, void* d_out, int out_size, void* d_ws, size_t ws_size, hipStream_t stream) {
    static int grid = 0;
    if (grid == 0) {
        int dev = 0, cus = 0, per_cu = 0;
        hipGetDevice(&dev);
        hipDeviceGetAttribute(&cus, hipDeviceAttributeMultiprocessorCount, dev);
        hipFuncSetAttribute((const void*)mega, hipFuncAttributeMaxDynamicSharedMemorySize, LDS_BYTES);
        hipOccupancyMaxActiveBlocksPerMultiprocessor(&per_cu, (const void*)mega, 512, LDS_BYTES);
        if (per_cu < 1) per_cu = 1;
        grid = cus * per_cu;
        if (ws_size < WS_END) fprintf(stderr, "kernel_launch: workspace too small: %zu < %zu\n", ws_size, (size_t)WS_END);
    }
    hipMemsetAsync((unsigned char*)d_ws + WS_BAR, 0, 16384, stream);
    Args a{};
    const float** pa = (const float**)&a;
    for (int i = 0; i < 28; ++i) pa[i] = (const float*)d_in[i];
    a.out = (float*)d_out; a.ws = (unsigned char*)d_ws;
    void* args[] = {&a};
    hipError_t e = hipLaunchCooperativeKernel((const void*)mega, dim3(grid), dim3(512), args, LDS_BYTES, stream);
    if (e != hipSuccess) fprintf(stderr, "cooperative launch failed: %s (grid %d)\n", hipGetErrorString(e), grid);
}
```
